# Optimizing an MI355X kernel written in HIP

```python
import jax
import jax.numpy as jnp
from jax import lax
import numpy as np

D_MODEL = 1024
BATCH = 16
SEQ = 2048
DEPTH = 2

CTX_LEN = 256
GRID_W = 64
D_MIX = D_MODEL
HEAD_DIM = 64
FT_GROUPS = 4
FT_GDIM = 64
FT_CH = FT_GROUPS * FT_GDIM
ATT_HQ = 8
ATT_HKV = 2
ATT_GROUP = ATT_HQ // ATT_HKV
ATT_CH = ATT_HQ * HEAD_DIM
DN_HEADS = 4
DN_DIM = 64
DN_CH = DN_HEADS * DN_DIM
CONV_K = 3
CONV_CH = 3 * DN_CH
CHUNK = 64
QBLK = 128
D_FF = 4 * D_MODEL
ROPE_THETA = 10000.0
AXIS_DIM = HEAD_DIM // 2
ROT_PAIRS = AXIS_DIM // 2
EPS = 1e-6
_S_F = FT_CH
_S_AQ = _S_F + ATT_CH
_S_AK = _S_AQ + ATT_HKV * HEAD_DIM
_S_AV = _S_AK + ATT_HKV * HEAD_DIM
_S_DQKV = _S_AV + CONV_CH
_S_DZ = _S_DQKV + DN_CH
PROJ = _S_DZ + 4 * DN_HEADS
SPLITS = (_S_F, _S_AQ, _S_AK, _S_AV, _S_DQKV, _S_DZ)

kernel_name = 'hybrid_fourier_gqa_gdn_prefix_block'


def _rms(x, g):
    xf = x.astype(jnp.float32)
    y = xf * lax.rsqrt(jnp.mean(xf * xf, axis=-1, keepdims=True) + EPS)
    return (y * g.astype(jnp.float32)).astype(x.dtype)


def _l2(x):
    xf = x.astype(jnp.float32)
    return xf * lax.rsqrt(jnp.sum(xf * xf, axis=-1, keepdims=True) + EPS)


def _rope2d(x, cos, sin):
    xs = x.reshape(x.shape[:-1] + (2, 2, ROT_PAIRS))
    rot = jnp.stack([-xs[..., 1, :], xs[..., 0, :]], axis=-2).reshape(x.shape)
    return (x.astype(jnp.float32) * cos + rot.astype(jnp.float32) * sin).astype(x.dtype)


def _dwconv(u, w):
    return lax.conv_general_dilated(u, w[:, None, :].astype(u.dtype), window_strides=(1,),
                                    padding=[(CONV_K // 2, CONV_K // 2)],
                                    dimension_numbers=('NWC', 'WIO', 'NWC'),
                                    feature_group_count=u.shape[-1])


def _fourier(f_in):
    B, L, _ = f_in.shape
    f = f_in.astype(jnp.float32).reshape(B, L, FT_GROUPS, FT_GDIM)
    y = jnp.fft.fftn(f, axes=(1, 3), norm='ortho').real
    return y.reshape(B, L, FT_CH).astype(f_in.dtype)


def _attend(q, k, v):
    B, L, _, D = q.shape
    nb = L // QBLK
    qb = q.reshape(B, nb, QBLK, ATT_HKV, ATT_GROUP, D).transpose(1, 0, 2, 3, 4, 5)
    scale = D ** -0.5

    def blk(qi):
        s = jnp.einsum('bqhgd,bkhd->bhgqk', qi, k, preferred_element_type=jnp.float32) * scale
        p = jax.nn.softmax(s, axis=-1).astype(v.dtype)
        return jnp.einsum('bhgqk,bkhd->bqhgd', p, v)

    o = lax.map(blk, qb)
    return o.transpose(1, 0, 2, 3, 4, 5).reshape(B, L, ATT_HQ * D)


def _chunk_gdn(q, k, v, g, beta, s0):
    B, L, H, DK = q.shape
    DV = v.shape[-1]
    N = L // CHUNK
    ch = lambda t: t.astype(jnp.float32).reshape((B, N, CHUNK, H) + t.shape[3:]).swapaxes(2, 3).swapaxes(0, 1)
    qc, kc, vc = ch(q), ch(k), ch(v)
    gc = jnp.cumsum(ch(g), axis=-1)
    bc = ch(beta)
    idx = jnp.arange(CHUNK)
    tril = idx[:, None] >= idx[None, :]
    strict = idx[:, None] > idx[None, :]
    decay = jnp.exp(jnp.where(tril, gc[..., :, None] - gc[..., None, :], -jnp.inf))
    kb = kc * bc[..., None]
    vb = vc * bc[..., None]
    lmat = jnp.where(strict, jnp.einsum('nbhid,nbhjd->nbhij', kb, kc) * decay, 0.0)
    eye = jnp.eye(CHUNK, dtype=jnp.float32)
    tmat = lax.linalg.triangular_solve(eye + lmat, jnp.broadcast_to(eye, lmat.shape),
                                       left_side=True, lower=True)
    u = jnp.einsum('nbhij,nbhjd->nbhid', tmat, vb)
    w = jnp.einsum('nbhij,nbhjd->nbhid', tmat, kb * jnp.exp(gc)[..., None])
    qk = jnp.where(tril, jnp.einsum('nbhid,nbhjd->nbhij', qc, kc) * decay, 0.0)

    def step(S, inp):
        q_i, k_i, u_i, w_i, g_i, qk_i = inp
        v_new = u_i - jnp.einsum('bhcd,bhde->bhce', w_i, S)
        o = (jnp.einsum('bhcd,bhde->bhce', q_i * jnp.exp(g_i)[..., None], S)
             + jnp.einsum('bhij,bhje->bhie', qk_i, v_new))
        g_last = g_i[..., -1]
        S = (S * jnp.exp(g_last)[..., None, None]
             + jnp.einsum('bhcd,bhce->bhde', k_i * jnp.exp(g_last[..., None] - g_i)[..., None], v_new))
        return S, o

    s_fin, o = lax.scan(step, s0, (qc, kc, u, w, gc, qk))
    return o.transpose(1, 0, 3, 2, 4).reshape(B, L, H, DV), s_fin


def _bidir_gdn(P, s0_f, s0_b):
    fl = lambda t: t[:, ::-1]
    o_f, s_f = _chunk_gdn(P['dq'], P['dk'], P['dv'], P['g'][:, :, 0], P['beta'][:, :, 0], s0_f)
    o_b, s_b = _chunk_gdn(fl(P['dq']), fl(P['dk']), fl(P['dv']), fl(P['g'][:, :, 1]),
                          fl(P['beta'][:, :, 1]), s0_b)
    return o_f + fl(o_b), s_f, s_b


def _project(h, lp, rope):
    B, L, _ = h.shape
    z = h @ lp['w_in']
    f, aq, ak, av, dqkv, dz, gates = jnp.split(z, SPLITS, axis=-1)
    aq = _rms(aq.reshape(B, L, ATT_HQ, HEAD_DIM), lp['q_norm'])
    ak = _rms(ak.reshape(B, L, ATT_HKV, HEAD_DIM), lp['k_norm'])
    if rope is not None:
        aq = _rope2d(aq, rope[0], rope[1])
        ak = _rope2d(ak, rope[0], rope[1])
    dqkv = jax.nn.silu(_dwconv(dqkv, lp['conv_w'])).reshape(B, L, 3, DN_HEADS, DN_DIM)
    gates = gates.astype(jnp.float32).reshape(B, L, 4, DN_HEADS)
    beta = jax.nn.sigmoid(gates[:, :, 0:2])
    g = -jnp.exp(lp['a_log'].astype(jnp.float32)) * jax.nn.softplus(
        gates[:, :, 2:4] + lp['dt_bias'].astype(jnp.float32))
    return dict(f=f, aq=aq, ak=ak, av=av.reshape(B, L, ATT_HKV, HEAD_DIM),
                dq=_l2(dqkv[:, :, 0]) * (DN_DIM ** -0.5), dk=_l2(dqkv[:, :, 1]),
                dv=dqkv[:, :, 2].astype(jnp.float32), dz=dz, beta=beta, g=g)


def _mix_out(P, o_att, o_dn, w_out, o_norm_g):
    B, L, _ = o_att.shape
    gate = jax.nn.silu(P['dz'].astype(jnp.float32)).reshape(B, L, DN_HEADS, DN_DIM)
    dn = (_rms(o_dn, o_norm_g) * gate).reshape(B, L, DN_CH).astype(o_att.dtype)
    cat = jnp.concatenate([_fourier(P['f']), o_att, dn], axis=-1)
    return cat @ w_out


def _mlp(h, w1, w2):
    u = jnp.maximum(h @ w1, 0.0)
    return (u * u) @ w2


def _layer(x, xc, c, c_ctx, rope, lp, ctx_out):
    mod = jax.nn.silu(c) @ lp['w_mod'] + lp['b_mod']
    modc = jax.nn.silu(c_ctx) @ lp['w_mod'] + lp['b_mod']
    sh1, sc1, g1, sh2, sc2, g2 = jnp.split(mod[:, None, :], 6, axis=-1)
    csh1, csc1, cg1, csh2, csc2, cg2 = jnp.split(modc, 6)
    h = _rms(x, lp['norm1']) * (1 + sc1) + sh1
    hc = _rms(xc, lp['norm1']) * (1 + csc1) + csh1
    P = _project(h, lp, rope)
    Pc = _project(hc, lp, None)
    s0 = jnp.zeros((x.shape[0], DN_HEADS, DN_DIM, DN_DIM), jnp.float32)
    oc_dn, s_f, s_b = _bidir_gdn(Pc, s0, s0)
    k_all = jnp.concatenate([P['ak'], Pc['ak']], axis=1)
    v_all = jnp.concatenate([P['av'], Pc['av']], axis=1)
    o_att = _attend(P['aq'], k_all, v_all)
    o_dn, _, _ = _bidir_gdn(P, s_f, s_b)
    x = x + g1 * _mix_out(P, o_att, o_dn, lp['w_out'], lp['o_norm'])
    x = x + g2 * _mlp(_rms(x, lp['norm2']) * (1 + sc2) + sh2, lp['w_ff1'], lp['w_ff2'])
    if ctx_out:
        oc_att = _attend(Pc['aq'], Pc['ak'], Pc['av'])
        xc = xc + cg1 * _mix_out(Pc, oc_att, oc_dn, lp['w_out'], lp['o_norm'])
        xc = xc + cg2 * _mlp(_rms(xc, lp['norm2']) * (1 + csc2) + csh2, lp['w_ff1'], lp['w_ff2'])
    return x, xc


def setup_inputs(seed: int = 0) -> dict:
    key = jax.random.key(seed)
    ks = jax.random.split(key, 18)
    f32 = jnp.float32
    nrm = lambda k, shape, s: jax.random.normal(k, shape, f32) * s
    x = nrm(ks[0], (BATCH, SEQ, D_MODEL), 1.0)
    c = nrm(ks[1], (BATCH, D_MODEL), 1.0)
    ctx = nrm(ks[2], (BATCH, CTX_LEN, D_MODEL), 1.0)
    c_ctx = nrm(ks[3], (D_MODEL,), 1.0)
    norm1_g = 1.0 + nrm(ks[4], (DEPTH, D_MODEL), 0.02)
    norm2_g = 1.0 + nrm(ks[5], (DEPTH, D_MODEL), 0.02)
    w_mod = nrm(ks[6], (DEPTH, D_MODEL, 6 * D_MODEL), 0.5 * D_MODEL ** -0.5)
    b_mod = nrm(ks[7], (DEPTH, 6 * D_MODEL), 0.02)
    w_in = nrm(ks[8], (DEPTH, D_MODEL, PROJ), D_MODEL ** -0.5)
    conv_w = nrm(ks[9], (DEPTH, CONV_K, CONV_CH), CONV_K ** -0.5)
    q_norm_g = 1.0 + nrm(ks[10], (DEPTH, HEAD_DIM), 0.02)
    k_norm_g = 1.0 + nrm(ks[11], (DEPTH, HEAD_DIM), 0.02)
    a_log = jnp.log(jax.random.uniform(ks[12], (DEPTH, 2, DN_HEADS), f32, 1.0, 16.0))
    dt = jnp.exp(jax.random.uniform(ks[13], (DEPTH, 2, DN_HEADS), f32,
                                    float(np.log(1e-3)), float(np.log(1e-1))))
    dt_bias = dt + jnp.log(-jnp.expm1(-dt))
    o_norm_g = 1.0 + nrm(ks[14], (DEPTH, DN_DIM), 0.02)
    w_out = nrm(ks[15], (DEPTH, D_MIX, D_MODEL), D_MIX ** -0.5)
    w_ff1 = nrm(ks[16], (DEPTH, D_MODEL, D_FF), D_MODEL ** -0.5)
    w_ff2 = nrm(ks[17], (DEPTH, D_FF, D_MODEL), D_FF ** -0.5)
    return {'x': x, 'c': c, 'ctx': ctx, 'c_ctx': c_ctx, 'norm1_g': norm1_g, 'norm2_g': norm2_g,
            'w_mod': w_mod, 'b_mod': b_mod, 'w_in': w_in, 'conv_w': conv_w,
            'q_norm_g': q_norm_g, 'k_norm_g': k_norm_g, 'a_log': a_log, 'dt_bias': dt_bias,
            'o_norm_g': o_norm_g, 'w_out': w_out, 'w_ff1': w_ff1, 'w_ff2': w_ff2}


def reference(x, c, ctx, c_ctx, norm1_g, norm2_g, w_mod, b_mod, w_in, conv_w, q_norm_g, k_norm_g,
              a_log, dt_bias, o_norm_g, w_out, w_ff1, w_ff2):
    S = x.shape[1]
    rows = S // GRID_W
    t_row = jnp.repeat(jnp.arange(rows), GRID_W).astype(jnp.float32)
    t_col = jnp.tile(jnp.arange(GRID_W), rows).astype(jnp.float32)
    inv_freq = ROPE_THETA ** (-jnp.arange(ROT_PAIRS, dtype=jnp.float32) * 2.0 / AXIS_DIM)
    ang_r = t_row[:, None] * inv_freq
    ang_c = t_col[:, None] * inv_freq
    ang = jnp.concatenate([ang_r, ang_r, ang_c, ang_c], axis=-1)
    rope = (jnp.cos(ang)[:, None, :], jnp.sin(ang)[:, None, :])
    x_lat, x_ctx = x, ctx
    for l in range(DEPTH):
        lp = dict(norm1=norm1_g[l], norm2=norm2_g[l], w_mod=w_mod[l], b_mod=b_mod[l],
                  w_in=w_in[l], conv_w=conv_w[l], q_norm=q_norm_g[l], k_norm=k_norm_g[l],
                  a_log=a_log[l], dt_bias=dt_bias[l], o_norm=o_norm_g[l], w_out=w_out[l],
                  w_ff1=w_ff1[l], w_ff2=w_ff2[l])
        x_lat, x_ctx = _layer(x_lat, x_ctx, c, c_ctx, rope, lp, l < DEPTH - 1)
    return x_lat
```

```cpp
#include <hip/hip_runtime.h>
#include <hip/hip_cooperative_groups.h>
#include <cstdio>
#include <cstdint>
#include <cmath>
namespace cg = cooperative_groups;
#define NAN_SCRUB 0
#define DIAG 0
namespace pg8 {
#define PG8_LAS __attribute__((address_space(3)))
typedef unsigned short bf16_t;
typedef short bf16x8 __attribute__((ext_vector_type(8)));
typedef float f32x4 __attribute__((ext_vector_type(4)));
typedef unsigned u32x4 __attribute__((ext_vector_type(4)));
constexpr int BM = 256, BK = 64, HALF = 128, HTB = HALF * BK * 2  , STAGE_BYTES = 8 * HTB, NXCD = 8, WGM = 8;

__host__ __device__ __forceinline__ int lds_byte(int r, int c) { const int st = (r >> 4) * 2 + (c >> 5), rr = r & 15, cc = c & 31, ob = rr * 64 + cc * 2; return st * 1024 + (ob ^ (((ob >> 9) & 1) << 5)); }
__host__ __device__ __forceinline__ void stage_rc(int b, int& R, int& C) { const int st = b / 1024, sb = b % 1024, swz = sb ^ (((sb >> 9) & 1) << 5); R = (st >> 1) * 16 + swz / 64; C = (st & 1) * 32 + (swz % 64) / 2; }
__host__ __device__ __forceinline__ int perm32(int rho) { const int n = rho >> 4, i = rho & 15; return 8 * (i >> 2) + 4 * n + (i & 3); }

struct Unit { int pm, pn; };
struct Gemm { const bf16_t* A; const bf16_t* Bt; int M, N, K; };

struct StaticOrder {
    int nM, nN, nwg, G, c;
    __host__ __device__ void init(int M, int N, int G_, int c_) { nM = M / BM; nN = N / BM; nwg = nM * nN; G = G_; c = c_; }
    __host__ __device__ bool next(int i, Unit& u) const {
        const long L = (long)i * G + c; if (L >= nwg) return false;
        int wgid = (int)L; { const int q = nwg / NXCD, r = nwg % NXCD, xcd = wgid % NXCD, off = wgid / NXCD; wgid = (xcd < r ? xcd * (q + 1) : r * (q + 1) + (xcd - r) * q) + off; }
        const int nig = WGM * nN, gid = wgid / nig, fm = gid * WGM, gsz = (nM - fm) < WGM ? (nM - fm) : WGM;
        u.pm = fm + ((wgid % nig) % gsz); u.pn = (wgid % nig) / gsz; return true;
    }
    __device__ __forceinline__ void a_ready(const Unit&) const {}
    __device__ __forceinline__ void done(const Unit&) const {}
};

__device__ __forceinline__ unsigned cvt_pk_bf16(float lo, float hi) { unsigned r; asm volatile("v_cvt_pk_bf16_f32 %0, %1, %2" : "=v"(r) : "v"(lo), "v"(hi)); return r; }
typedef float f32x2 __attribute__((ext_vector_type(2)));
template <class Epi, class Sched, bool ALIGN_EPI = false, bool SP2 = false>
__device__ __forceinline__ void gemm_phase(PG8_LAS unsigned char* lds, const Gemm g, const Sched& S, const Epi& E) {
    int tid_l = threadIdx.x; asm volatile("" : "+v"(tid_l)); const int tid = tid_l, wid = __builtin_amdgcn_readfirstlane(tid >> 6), lane = tid & 63, wr = wid >> 2, wc = wid & 3, fr = lane & 15, fq = lane >> 4;
    const int K = g.K, nt = K / BK;
    unsigned voffA[2], voffB[2];
#pragma unroll
    for (int i = 0; i < 2; ++i) { int R, C; stage_rc(tid * 16 + i * 8192, R, C); const int Rb = Epi::PERM ? ((R & ~31) + perm32(R & 31)) : R;
        voffA[i] = (unsigned)(R * K + C) * 2u; voffB[i] = (unsigned)(Rb * K + C) * 2u; }
    const size_t kstep = (size_t)(BK * 2);
    const size_t hstep = (size_t)HALF * K * 2;
    const size_t tstep = 2 * hstep;
    const unsigned ldsw = (unsigned)wid * 1024u;
    const int aoff = lds_byte(wr * 64 + fr, fq * 8), boff = lds_byte(wc * 32 + fr, fq * 8);
#define PG8_SA(b, h) (((b) * 2 + (h)) * HTB)
#define PG8_SB(b, h) ((4 + (b) * 2 + (h)) * HTB)
#define PG8_STAGE(bufoff, gbase, voff) do { _Pragma("unroll") for (int _i = 0; _i < 2; ++_i) \
        __builtin_amdgcn_global_load_lds((const unsigned*)((const char*)(gbase) + (voff)[_i]), (PG8_LAS unsigned*)(lds + (bufoff) + ldsw + _i * 8192), 16, 0, 0); } while (0)
#define PG8_LDA(dst, b, h) do { _Pragma("unroll") for (int m = 0; m < 4; ++m) _Pragma("unroll") for (int k = 0; k < 2; ++k) dst[m][k] = *(const PG8_LAS bf16x8*)(lds + PG8_SA(b, h) + aoff + m * 2048 + k * 1024); } while (0)
#define PG8_LDB(dst, b, h) do { _Pragma("unroll") for (int n = 0; n < 2; ++n) _Pragma("unroll") for (int k = 0; k < 2; ++k) dst[n][k] = *(const PG8_LAS bf16x8*)(lds + PG8_SB(b, h) + boff + n * 2048 + k * 1024); } while (0)
#define PG8_MMA(ai, bj, At, Bt) do { __builtin_amdgcn_s_setprio(1); _Pragma("unroll") for (int m = 0; m < 4; ++m) _Pragma("unroll") for (int n = 0; n < 2; ++n) _Pragma("unroll") for (int k = 0; k < 2; ++k) \
        acc[ai][bj][m][n] = __builtin_amdgcn_mfma_f32_16x16x32_bf16(Bt[n][k], At[m][k], acc[ai][bj][m][n], 0, 0, 0); __builtin_amdgcn_s_setprio(0); } while (0)
#define PG8_WAIT_V(n) asm volatile("s_waitcnt vmcnt(" #n ")" ::: "memory")
#define PG8_WAIT_L(n) asm volatile("s_waitcnt lgkmcnt(" #n ")" ::: "memory")
#define PG8_BAR __builtin_amdgcn_s_barrier()
#define PG8_SCHED __builtin_amdgcn_sched_barrier(0)
    Unit cur, nxt; int ui = 0;
    if (!S.next(0, cur)) return;
    f32x4 acc[2][2][4][2];
#pragma unroll
    for (int a = 0; a < 2; ++a)
#pragma unroll
        for (int b = 0; b < 2; ++b)
#pragma unroll
            for (int m = 0; m < 4; ++m)
#pragma unroll
                for (int n = 0; n < 2; ++n) acc[a][b][m][n] = (f32x4){0.f, 0.f, 0.f, 0.f};
    bf16x8 At[4][2], B0[2][2], B1[2][2];
    const char* cA = (const char*)g.A + (size_t)cur.pm * tstep; const char* cB = (const char*)g.Bt + (size_t)cur.pn * tstep;
    S.a_ready(cur);
    if constexpr (SP2) {
        PG8_STAGE(PG8_SB(0, 0), cB, voffB); PG8_STAGE(PG8_SB(0, 1), cB + hstep, voffB); PG8_STAGE(PG8_SA(0, 0), cA, voffA); PG8_STAGE(PG8_SA(0, 1), cA + hstep, voffA);
        if (wr == 1) PG8_BAR;
        PG8_WAIT_V(2); PG8_BAR;
        PG8_STAGE(PG8_SB(1, 0), cB + kstep, voffB); PG8_STAGE(PG8_SA(1, 0), cA + kstep, voffA); PG8_STAGE(PG8_SB(1, 1), cB + hstep + kstep, voffB);
        PG8_WAIT_V(6); PG8_BAR;
    } else {
        PG8_STAGE(PG8_SB(0, 0), cB, voffB); PG8_STAGE(PG8_SA(0, 0), cA, voffA); PG8_STAGE(PG8_SB(0, 1), cB + hstep, voffB); PG8_STAGE(PG8_SA(0, 1), cA + hstep, voffA);
        if (wr == 1) PG8_BAR;
        PG8_WAIT_V(4); PG8_BAR;
        PG8_STAGE(PG8_SB(1, 0), cB + kstep, voffB); PG8_STAGE(PG8_SA(1, 0), cA + kstep, voffA); PG8_STAGE(PG8_SB(1, 1), cB + hstep + kstep, voffB);
        PG8_WAIT_V(6); PG8_BAR;
    }
    for (;;) {
        const bool has_next = S.next(ui + 1, nxt);
        const char* nA = has_next ? (const char*)g.A + (size_t)nxt.pm * tstep : cA; const char* nB = has_next ? (const char*)g.Bt + (size_t)nxt.pn * tstep : cB;
        for (int t = 0; t < nt; t += 2) {
            const bool last = (t == nt - 2);
            const char* a1 = cA + (size_t)(t + 1) * kstep;
            const char* a2 = last ? nA : cA + (size_t)(t + 2) * kstep; const char* b2 = last ? nB : cB + (size_t)(t + 2) * kstep;
            const char* a3 = a2 + kstep; const char* b3 = b2 + kstep;
            if (last && has_next) S.a_ready(nxt);
            if constexpr (SP2) {
            PG8_LDB(B0, 0, 0); PG8_LDB(B1, 0, 1); PG8_SCHED; PG8_LDA(At, 0, 0); PG8_STAGE(PG8_SA(1, 1), a1 + hstep, voffA);
            PG8_WAIT_V(8); PG8_WAIT_L(0); PG8_BAR; PG8_MMA(0, 0, At, B0); PG8_MMA(0, 1, At, B1); PG8_BAR; PG8_SCHED;
            PG8_LDA(At, 0, 1); PG8_STAGE(PG8_SB(0, 0), b2, voffB); PG8_STAGE(PG8_SB(0, 1), b2 + hstep, voffB); PG8_STAGE(PG8_SA(0, 0), a2, voffA);
            PG8_WAIT_V(8); PG8_WAIT_L(0); PG8_BAR; PG8_MMA(1, 0, At, B0); PG8_MMA(1, 1, At, B1); PG8_BAR; PG8_SCHED;
            PG8_LDB(B0, 1, 0); PG8_LDB(B1, 1, 1); PG8_SCHED; PG8_LDA(At, 1, 0); PG8_STAGE(PG8_SA(0, 1), a2 + hstep, voffA);
            PG8_WAIT_V(8); PG8_WAIT_L(0); PG8_BAR; PG8_MMA(0, 0, At, B0); PG8_MMA(0, 1, At, B1); PG8_BAR; PG8_SCHED;
            PG8_LDA(At, 1, 1); PG8_STAGE(PG8_SB(1, 0), b3, voffB); PG8_STAGE(PG8_SB(1, 1), b3 + hstep, voffB); PG8_STAGE(PG8_SA(1, 0), a3, voffA);
            PG8_WAIT_V(8); PG8_WAIT_L(0); PG8_BAR; PG8_MMA(1, 0, At, B0); PG8_MMA(1, 1, At, B1); PG8_BAR; PG8_SCHED;
            } else {
            PG8_LDB(B0, 0, 0); PG8_SCHED; PG8_LDA(At, 0, 0); PG8_STAGE(PG8_SA(1, 1), a1 + hstep, voffA);
            PG8_WAIT_L(8); PG8_BAR; PG8_WAIT_L(0); PG8_MMA(0, 0, At, B0); PG8_BAR; PG8_SCHED;
            PG8_LDB(B1, 0, 1); PG8_STAGE(PG8_SB(0, 0), b2, voffB);
            PG8_BAR; PG8_WAIT_L(0); PG8_MMA(0, 1, At, B1); PG8_BAR;
            PG8_LDA(At, 0, 1); PG8_STAGE(PG8_SA(0, 0), a2, voffA);
            PG8_BAR; PG8_WAIT_L(0); PG8_MMA(1, 0, At, B0); PG8_BAR; PG8_SCHED;
            PG8_STAGE(PG8_SB(0, 1), b2 + hstep, voffB);
            PG8_WAIT_V(6); PG8_BAR; PG8_MMA(1, 1, At, B1); PG8_BAR;
            PG8_LDB(B0, 1, 0); PG8_SCHED; PG8_LDA(At, 1, 0); PG8_STAGE(PG8_SA(0, 1), a2 + hstep, voffA);
            PG8_WAIT_L(8); PG8_BAR; PG8_WAIT_L(0); PG8_MMA(0, 0, At, B0); PG8_BAR; PG8_SCHED;
            PG8_LDB(B1, 1, 1); PG8_STAGE(PG8_SB(1, 0), b3, voffB);
            PG8_BAR; PG8_WAIT_L(0); PG8_MMA(0, 1, At, B1); PG8_BAR;
            PG8_LDA(At, 1, 1); PG8_STAGE(PG8_SA(1, 0), a3, voffA);
            PG8_BAR; PG8_WAIT_L(0); PG8_MMA(1, 0, At, B0); PG8_BAR; PG8_SCHED;
            PG8_STAGE(PG8_SB(1, 1), b3 + hstep, voffB);
            PG8_WAIT_V(6); PG8_BAR; PG8_MMA(1, 1, At, B1); PG8_BAR;
            }
        }
        if constexpr (ALIGN_EPI) { if (wr == 0) PG8_BAR; }
        if constexpr (!Epi::AFTER_DRAIN) { E(acc, cur, wr, wc, fr, fq); S.done(cur); }
        if (!has_next) break;
#pragma unroll
        for (int a = 0; a < 2; ++a)
#pragma unroll
            for (int b = 0; b < 2; ++b)
#pragma unroll
                for (int m = 0; m < 4; ++m)
#pragma unroll
                    for (int n = 0; n < 2; ++n) acc[a][b][m][n] = (f32x4){0.f, 0.f, 0.f, 0.f};
        cur = nxt; cA = nA; cB = nB; ++ui;
        if constexpr (ALIGN_EPI) { if (wr == 1) PG8_BAR; }
    }
    PG8_WAIT_V(0);
    if constexpr (!ALIGN_EPI) { if (wr == 0) PG8_BAR; }
    PG8_BAR;
    if constexpr (Epi::AFTER_DRAIN) { E.fused(acc, cur, wr, wc, fr, fq, lds, wid, lane); S.done(cur); }
#undef PG8_SA
#undef PG8_SB
#undef PG8_STAGE
#undef PG8_LDA
#undef PG8_LDB
#undef PG8_MMA
#undef PG8_WAIT_V
#undef PG8_WAIT_L
#undef PG8_BAR
#undef PG8_SCHED
}
}

#define LAS __attribute__((address_space(3)))
typedef unsigned short bf16_t;
typedef unsigned char uchar;
typedef short bf16x8 __attribute__((ext_vector_type(8)));
typedef float f32x4 __attribute__((ext_vector_type(4)));
typedef float f32x16 __attribute__((ext_vector_type(16)));
typedef unsigned u32x2 __attribute__((ext_vector_type(2)));
typedef unsigned u32x4 __attribute__((ext_vector_type(4)));

constexpr int TL = 32768, TC = 4096, TT = 36864;
constexpr size_t MiB = 1u << 20;
constexpr size_t OFF_ROPE = 64 * 1024, OFF_MOD = 128 * 1024;
constexpr size_t OFF_WB = 1 * MiB;
constexpr size_t WB_W1 = 0, WB_WO = (size_t)2304 * 1024 * 2, WB_F1 = WB_WO + (size_t)1024 * 1024 * 2, WB_F2 = WB_F1 + (size_t)4096 * 1024 * 2, WB_LAYER = WB_F2 + (size_t)4096 * 1024 * 2;
constexpr size_t OFF_DFTL = 46 * MiB, OFF_DFTC = 62 * MiB, OFF_XC = 63 * MiB, OFF_H = 79 * MiB, OFF_M1 = 79 * MiB, OFF_M2 = 115 * MiB;
constexpr size_t OFF_GTL = 151 * MiB, OFF_GTC = 183 * MiB, OFF_Q = 187 * MiB, OFF_K = 223 * MiB, OFF_VTL = 232 * MiB, OFF_VTC = 240 * MiB, OFF_DQKV = 241 * MiB,
                 OFF_DZ = 295 * MiB, OFF_GB = 313 * MiB, OFF_O0T = 316 * MiB, OFF_S0T = 352 * MiB, OFF_ST = 388 * MiB, OFF_CAT = 424 * MiB, OFF_U = 151 * MiB, WS_END = 496 * MiB;
static_assert(OFF_WB + 2 * WB_LAYER <= OFF_DFTL, "ws map");
constexpr int LDS_BYTES = 147456, LDS_MISC = 131072;

struct Params { const float* in[18]; float* out; unsigned char* ws; };

typedef float f32x2_t __attribute__((ext_vector_type(2))); typedef __bf16 bf16x2_t __attribute__((ext_vector_type(2)));
__device__ __forceinline__ unsigned pk(float lo, float hi) { f32x2_t v = {lo, hi}; bf16x2_t b = __builtin_convertvector(v, bf16x2_t); return __builtin_bit_cast(unsigned, b); }
__device__ __forceinline__ bf16_t f2bf(float x) { return (bf16_t)(pk(x, 0.f) & 0xffffu); }
__device__ __forceinline__ float bf2f(unsigned h) { return __uint_as_float(h << 16); }
__device__ __forceinline__ float bflo(unsigned w) { return __uint_as_float(w << 16); }
__device__ __forceinline__ float bfhi(unsigned w) { return __uint_as_float(w & 0xffff0000u); }
__device__ __forceinline__ float silu_f(float x) { return x / (1.f + __expf(-x)); }
__device__ __forceinline__ float wave_sum(float v) {
#pragma unroll
    for (int o = 1; o < 64; o <<= 1) v += __shfl_xor(v, o);
    return v;
}
__device__ __forceinline__ f32x4 mfma16(bf16x8 a, bf16x8 b, f32x4 c) { return __builtin_amdgcn_mfma_f32_16x16x32_bf16(a, b, c, 0, 0, 0); }
__device__ __forceinline__ f32x16 mfma32(bf16x8 a, bf16x8 b, f32x16 c) { return __builtin_amdgcn_mfma_f32_32x32x16_bf16(a, b, c, 0, 0, 0); }

struct EpiProj {
    static constexpr bool PERM = false, AFTER_DRAIN = false;
    unsigned char* ws; const float *qg, *kg;
    __device__ __forceinline__ void operator()(const f32x4 (&acc)[2][2][4][2], const pg8::Unit& u, int wr, int wc, int fr, int fq) const {
        asm volatile("" : "+v"(fr), "+v"(fq));
        bf16_t* const GTl = (bf16_t*)(ws + OFF_GTL); bf16_t* const GTc = (bf16_t*)(ws + OFF_GTC); bf16_t* const Qb = (bf16_t*)(ws + OFF_Q); bf16_t* const Kb = (bf16_t*)(ws + OFF_K);
        bf16_t* const VTl = (bf16_t*)(ws + OFF_VTL); bf16_t* const VTc = (bf16_t*)(ws + OFF_VTC); bf16_t* const DQKV = (bf16_t*)(ws + OFF_DQKV); bf16_t* const DZ = (bf16_t*)(ws + OFF_DZ);
        const float2* const rope = (const float2*)(ws + OFF_ROPE);
        const int pn = u.pn, rowt = u.pm * 256;
        const bool ctx = rowt >= TL;
        const int b = ctx ? (rowt - TL) >> 8 : rowt >> 11;
        const int s0 = ctx ? 0 : (rowt & 2047);
        const int Ls = ctx ? 256 : 2048;
        if (pn < 2) {
            bf16_t* G = (ctx ? GTc : GTl);
#pragma unroll
            for (int ai = 0; ai < 2; ++ai)
#pragma unroll
                for (int m = 0; m < 4; ++m) {
                    const int s = s0 + ai * 128 + wr * 64 + m * 16 + fr;
#pragma unroll
                    for (int bj = 0; bj < 2; ++bj)
#pragma unroll
                        for (int n = 0; n < 2; ++n)
#pragma unroll
                            for (int j = 0; j < 4; ++j) {
                                const int c = bj * 128 + wc * 32 + n * 16 + fq * 4 + j;
                                G[((size_t)((b * 256 + c) * 2 + pn)) * Ls + s] = f2bf(acc[ai][bj][m][n][j]);
                            }
                }
        } else if (pn < 5) {
            const bool isv = (pn == 4) && (wc >= 2);
            if (isv) {
                const int kvh = wc - 2; bf16_t* V = ctx ? VTc : VTl;
#pragma unroll
                for (int ai = 0; ai < 2; ++ai)
#pragma unroll
                    for (int m = 0; m < 4; ++m) {
                        const int s = s0 + ai * 128 + wr * 64 + m * 16 + fr;
#pragma unroll
                        for (int bj = 0; bj < 2; ++bj)
#pragma unroll
                            for (int n = 0; n < 2; ++n)
#pragma unroll
                                for (int j = 0; j < 4; ++j) {
                                    const int d = bj * 32 + n * 16 + fq * 4 + j;
                                    V[((size_t)((b * 2 + kvh) * 64 + d)) * Ls + s] = f2bf(acc[ai][bj][m][n][j]);
                                }
                    }
            } else {
                const bool isq = pn < 4;
                const float* gw = isq ? qg : kg;
                const float osc = isq ? 0.125f : 1.0f;
                f32x4 gv[2][2];
#pragma unroll
                for (int bj = 0; bj < 2; ++bj)
#pragma unroll
                    for (int n = 0; n < 2; ++n) gv[bj][n] = *(const f32x4*)(gw + bj * 32 + n * 16 + fq * 4);
#pragma unroll
                for (int ai = 0; ai < 2; ++ai)
#pragma unroll
                    for (int m = 0; m < 4; ++m) {
                        const int rl = ai * 128 + wr * 64 + m * 16 + fr;
                        const int s = s0 + rl; const size_t row = (size_t)rowt + rl;
                        float ss = 0.f;
#pragma unroll
                        for (int bj = 0; bj < 2; ++bj)
#pragma unroll
                            for (int n = 0; n < 2; ++n) { const f32x4 v = acc[ai][bj][m][n]; ss += (v[0] * v[0] + v[1] * v[1]) + (v[2] * v[2] + v[3] * v[3]); }
                        ss += __shfl_xor(ss, 16); ss += __shfl_xor(ss, 32);
                        const float rinv = rsqrtf(ss * (1.f / 64.f) + 1e-6f);
                        bf16_t* dst = isq ? (Qb + row * 512 + ((pn - 2) * 4 + wc) * 64) : (Kb + row * 128 + wc * 64);
#pragma unroll
                        for (int bj = 0; bj < 2; ++bj) {
                            f32x4 x0 = acc[ai][bj][m][0] * rinv * gv[bj][0], x1 = acc[ai][bj][m][1] * rinv * gv[bj][1];
                            if (!ctx) {
                                const int pos = bj == 0 ? (s >> 6) : (s & 63);
                                const float2* rp = rope + pos * 16 + fq * 4;
                                f32x4 o0, o1;
#pragma unroll
                                for (int j = 0; j < 4; ++j) { const float2 cs = rp[j]; o0[j] = x0[j] * cs.x - x1[j] * cs.y; o1[j] = x1[j] * cs.x + x0[j] * cs.y; }
                                x0 = o0; x1 = o1;
                            }
                            x0 = x0 * osc; x1 = x1 * osc;
                            u32x2 w0, w1; w0.x = pk(x0[0], x0[1]); w0.y = pk(x0[2], x0[3]); w1.x = pk(x1[0], x1[1]); w1.y = pk(x1[2], x1[3]);
                            *(u32x2*)(dst + bj * 32 + fq * 4) = w0; *(u32x2*)(dst + bj * 32 + 16 + fq * 4) = w1;
                        }
                    }
            }
        } else {
            bf16_t* O = pn < 8 ? DQKV : DZ; const int ldo = pn < 8 ? 768 : 256; const int cb = pn < 8 ? (pn - 5) * 256 : 0;
#pragma unroll
            for (int ai = 0; ai < 2; ++ai)
#pragma unroll
                for (int m = 0; m < 4; ++m) {
                    bf16_t* rowp = O + ((size_t)rowt + ai * 128 + wr * 64 + m * 16 + fr) * ldo + cb + wc * 32 + fq * 4;
#pragma unroll
                    for (int bj = 0; bj < 2; ++bj)
#pragma unroll
                        for (int n = 0; n < 2; ++n) { const f32x4 v = acc[ai][bj][m][n]; u32x2 w; w.x = pk(v[0], v[1]); w.y = pk(v[2], v[3]); *(u32x2*)(rowp + bj * 128 + n * 16) = w; }
                }
        }
    }
};

struct EpiResid {
    static constexpr bool PERM = false, AFTER_DRAIN = false;
    const float* srcl; float* dstl; const float* srcc; float* dstc; const float* gate;
    __device__ __forceinline__ void operator()(const f32x4 (&acc)[2][2][4][2], const pg8::Unit& u, int wr, int wc, int fr, int fq) const {
        const int rowt = u.pm * 256; const bool ctx = rowt >= TL;
        const int bb = ctx ? 16 : rowt >> 11;
        const float* src = ctx ? srcc + (size_t)(rowt - TL) * 1024 : srcl + (size_t)rowt * 1024;
        float* dst = ctx ? dstc + (size_t)(rowt - TL) * 1024 : dstl + (size_t)rowt * 1024;
        const int col0 = u.pn * 256 + wc * 32 + fq * 4;
        f32x4 gv[2][2];
#pragma unroll
        for (int bj = 0; bj < 2; ++bj)
#pragma unroll
            for (int n = 0; n < 2; ++n) gv[bj][n] = *(const f32x4*)(gate + bb * 6144 + col0 + bj * 128 + n * 16);
#pragma unroll
        for (int ai = 0; ai < 2; ++ai)
#pragma unroll
            for (int m = 0; m < 4; ++m) {
                const size_t off = (size_t)(ai * 128 + wr * 64 + m * 16 + fr) * 1024 + col0;
#pragma unroll
                for (int bj = 0; bj < 2; ++bj)
#pragma unroll
                    for (int n = 0; n < 2; ++n) { const f32x4 sv = *(const f32x4*)(src + off + bj * 128 + n * 16); *(f32x4*)(dst + off + bj * 128 + n * 16) = sv + gv[bj][n] * acc[ai][bj][m][n]; }
            }
    }
};

struct EpiRelu2 {
    static constexpr bool PERM = false, AFTER_DRAIN = false;
    bf16_t* U;
    __device__ __forceinline__ void operator()(const f32x4 (&acc)[2][2][4][2], const pg8::Unit& u, int wr, int wc, int fr, int fq) const {
        const int col0 = u.pn * 256 + wc * 32 + fq * 4;
#pragma unroll
        for (int ai = 0; ai < 2; ++ai)
#pragma unroll
            for (int m = 0; m < 4; ++m) {
                bf16_t* rowp = U + ((size_t)u.pm * 256 + ai * 128 + wr * 64 + m * 16 + fr) * 4096 + col0;
#pragma unroll
                for (int bj = 0; bj < 2; ++bj)
#pragma unroll
                    for (int n = 0; n < 2; ++n) { f32x4 v = acc[ai][bj][m][n];
#pragma unroll
                        for (int j = 0; j < 4; ++j) { const float t = fmaxf(v[j], 0.f); v[j] = t * t; }
                        u32x2 w; w.x = pk(v[0], v[1]); w.y = pk(v[2], v[3]); *(u32x2*)(rowp + bj * 128 + n * 16) = w; }
            }
    }
};

struct EpiFourier {
    static constexpr bool PERM = false, AFTER_DRAIN = false;
    bf16_t* CAT; int rowbase, Ls;
    __device__ __forceinline__ void operator()(const f32x4 (&acc)[2][2][4][2], const pg8::Unit& u, int wr, int wc, int fr, int fq) const {
        const int b = u.pn;
#pragma unroll
        for (int ai = 0; ai < 2; ++ai)
#pragma unroll
            for (int m = 0; m < 4; ++m) {
                const int k1 = u.pm * 256 + ai * 128 + wr * 64 + m * 16 + fr;
                bf16_t* rowp = CAT + ((size_t)rowbase + (size_t)b * Ls + k1) * 1024 + wc * 32 + fq * 4;
#pragma unroll
                for (int bj = 0; bj < 2; ++bj)
#pragma unroll
                    for (int n = 0; n < 2; ++n) { const f32x4 v = acc[ai][bj][m][n]; u32x2 w; w.x = pk(v[0], v[1]); w.y = pk(v[2], v[3]); *(u32x2*)(rowp + bj * 128 + n * 16) = w; }
            }
    }
};

__device__ __forceinline__ void tr_item(const float* Wsrc, int ld, bf16_t* dst, int K, LAS float* scr, int lane) {
#pragma unroll 8
    for (int i = 0; i < 32; ++i) { const int kk = 2 * i + (lane >> 5); scr[kk * 33 + (lane & 31)] = Wsrc[(size_t)kk * ld + (lane & 31)]; }
    asm volatile("s_waitcnt lgkmcnt(0)" ::: "memory");
    const int c = lane & 7;
#pragma unroll
    for (int j = 0; j < 4; ++j) { const int n = (lane >> 3) + 8 * j; const LAS float* s = scr + (8 * c) * 33 + n;
        u32x4 o; o.x = pk(s[0 * 33], s[1 * 33]); o.y = pk(s[2 * 33], s[3 * 33]); o.z = pk(s[4 * 33], s[5 * 33]); o.w = pk(s[6 * 33], s[7 * 33]);
        *(u32x4*)(dst + (size_t)n * K + 8 * c) = o; }
    asm volatile("s_waitcnt lgkmcnt(0)" ::: "memory");
}
__device__ __forceinline__ int w1_orig_col(int n0) {
    const int tile = n0 >> 8, c = n0 & 255, bj = c >> 7, wc = (c & 127) >> 5;
    if (tile < 4) return 256 + (tile - 2) * 256 + 64 * wc + 32 * bj;
    if (tile == 4) return wc < 2 ? 768 + 64 * wc + 32 * bj : 896 + 64 * (wc - 2) + 32 * bj;
    if (tile < 8) return 1024 + (tile - 5) * 256 + c;
    return 1792 + c;
}

typedef const __attribute__((address_space(4))) Params CParamsP;
__device__ __forceinline__ void phase_prologue(CParamsP* pp, LAS uchar* L, int tid, int lane, int wave) {
    uchar* ws = pp->ws;
    LAS float* trig = (LAS float*)(L + LDS_MISC);
    if (tid < 64) { float s, c; sincospif((float)tid / 32.f, &s, &c); trig[tid] = c; trig[64 + tid] = s; }
    if (blockIdx.x < 192) {
        const int item = blockIdx.x;
        LAS float* sc = (LAS float*)L;
        LAS float* red = (LAS float*)(L + 17 * 1024 * 4);
        const float* c = pp->in[1]; const float* cctx = pp->in[3];
        for (int i = tid; i < 17 * 1024; i += 512) { const int bb = i >> 10, k = i & 1023; const float v = bb < 16 ? c[bb * 1024 + k] : cctx[k]; sc[i] = silu_f(v); }
        __syncthreads();
        const int l = item / 96, cb = item % 96, n = cb * 64 + lane;
        const float* W = pp->in[6] + (size_t)l * 1024 * 6144;
        float acc[17];
#pragma unroll
        for (int bb = 0; bb < 17; ++bb) acc[bb] = 0.f;
#pragma unroll 4
        for (int kk = 0; kk < 128; ++kk) { const int k = wave * 128 + kk; const float wv = W[(size_t)k * 6144 + n];
#pragma unroll
            for (int bb = 0; bb < 17; ++bb) acc[bb] += sc[bb * 1024 + k] * wv; }
#pragma unroll
        for (int bb = 0; bb < 17; ++bb) red[(wave * 17 + bb) * 64 + lane] = acc[bb];
        __syncthreads();
        float* mod = (float*)(ws + OFF_MOD);
        const float* bm = pp->in[7];
        for (int i = tid; i < 17 * 64; i += 512) { const int bb = i >> 6, ln = i & 63; float s = 0.f;
#pragma unroll
            for (int w = 0; w < 8; ++w) s += red[(w * 17 + bb) * 64 + ln];
            const int nn = cb * 64 + ln; mod[(size_t)(l * 17 + bb) * 6144 + nn] = s + bm[l * 6144 + nn]; }
    }
    __syncthreads();
    LAS float* scr = (LAS float*)(L + wave * 16384);
    const int gw = blockIdx.x * 8 + wave, NGW = gridDim.x * 8;
    constexpr int I_W1 = 56 * 16, I_WO = 32 * 16, I_F1 = 128 * 16, I_F2 = 32 * 64, I_FO = 4 * 16 * 8, I_LAYER = I_W1 + I_WO + I_F1 + I_F2 + I_FO;
    for (int it = gw; it < 2 * I_LAYER; it += NGW) {
        const int l = it / I_LAYER; int r = it % I_LAYER;
        uchar* wb = ws + OFF_WB + (size_t)l * WB_LAYER;
        const float* w_in = pp->in[8] + (size_t)l * 1024 * 2064;
        if (r < I_W1) { const int nb = 16 + r / 16, kb = r % 16; const int n0 = nb * 32, k0 = kb * 64;
            tr_item(w_in + (size_t)k0 * 2064 + w1_orig_col(n0), 2064, (bf16_t*)(wb + WB_W1) + (size_t)n0 * 1024 + k0, 1024, scr, lane); continue; }
        r -= I_W1;
        if (r < I_WO) { const int nb = r / 16, kb = r % 16; const int n0 = nb * 32, k0 = kb * 64;
            tr_item(pp->in[15] + (size_t)l * 1024 * 1024 + (size_t)k0 * 1024 + n0, 1024, (bf16_t*)(wb + WB_WO) + (size_t)n0 * 1024 + k0, 1024, scr, lane); continue; }
        r -= I_WO;
        if (r < I_F1) { const int nb = r / 16, kb = r % 16; const int n0 = nb * 32, k0 = kb * 64;
            tr_item(pp->in[16] + (size_t)l * 1024 * 4096 + (size_t)k0 * 4096 + n0, 4096, (bf16_t*)(wb + WB_F1) + (size_t)n0 * 1024 + k0, 1024, scr, lane); continue; }
        r -= I_F1;
        if (r < I_F2) { const int nb = r / 64, kb = r % 64; const int n0 = nb * 32, k0 = kb * 64;
            tr_item(pp->in[17] + (size_t)l * 4096 * 1024 + (size_t)k0 * 1024 + n0, 1024, (bf16_t*)(wb + WB_F2) + (size_t)n0 * 4096 + k0, 4096, scr, lane); continue; }
        r -= I_F2;
        {
            const int g = r >> 7, kb = (r >> 3) & 15, k2b = r & 7; const int k = kb * 64 + lane;
            const f32x4* src = (const f32x4*)(w_in + (size_t)k * 2064 + g * 64);
            float ac[8], as[8];
#pragma unroll
            for (int j = 0; j < 8; ++j) { ac[j] = 0.f; as[j] = 0.f; }
            for (int n4 = 0; n4 < 16; ++n4) { const f32x4 v = src[n4];
#pragma unroll
                for (int e = 0; e < 4; ++e) { const int n2 = n4 * 4 + e;
#pragma unroll
                    for (int j = 0; j < 8; ++j) { const int idx = ((k2b * 8 + j) * n2) & 63; ac[j] += v[e] * trig[idx]; as[j] += v[e] * trig[64 + idx]; } } }
            bf16_t* W1 = (bf16_t*)(wb + WB_W1);
#pragma unroll
            for (int j = 0; j < 8; ++j) { const int k2 = k2b * 8 + j; W1[(size_t)(g * 64 + k2) * 1024 + k] = f2bf(ac[j]); W1[(size_t)(256 + g * 64 + k2) * 1024 + k] = f2bf(as[j]); }
        }
    }
    {
        const size_t gt = (size_t)blockIdx.x * 512 + tid, NT = (size_t)gridDim.x * 512;
        bf16_t* AL = (bf16_t*)(ws + OFF_DFTL);
        const float nl = 0.00276213586f;
        for (size_t it = gt; it < (size_t)2048 * 512; it += NT) { const int k1 = (int)(it >> 9), cg_ = (int)(it & 511), cs = cg_ >> 8, n0 = (cg_ & 255) * 8;
            float v[8];
#pragma unroll
            for (int e = 0; e < 8; ++e) { const int m = (k1 * (n0 + e)) & 2047; float s, c; sincospif((float)m * (1.f / 1024.f), &s, &c); v[e] = (cs ? -s : c) * nl; }
            u32x4 o; o.x = pk(v[0], v[1]); o.y = pk(v[2], v[3]); o.z = pk(v[4], v[5]); o.w = pk(v[6], v[7]);
            *(u32x4*)(AL + (size_t)k1 * 4096 + cs * 2048 + n0) = o; }
        bf16_t* AC = (bf16_t*)(ws + OFF_DFTC);
        const float nc = 1.f / 128.f;
        for (size_t it = gt; it < (size_t)256 * 64; it += NT) { const int k1 = (int)(it >> 6), cg_ = (int)(it & 63), cs = cg_ >> 5, n0 = (cg_ & 31) * 8;
            float v[8];
#pragma unroll
            for (int e = 0; e < 8; ++e) { const int m = (k1 * (n0 + e)) & 255; float s, c; sincospif((float)m * (1.f / 128.f), &s, &c); v[e] = (cs ? -s : c) * nc; }
            u32x4 o; o.x = pk(v[0], v[1]); o.y = pk(v[2], v[3]); o.z = pk(v[4], v[5]); o.w = pk(v[6], v[7]);
            *(u32x4*)(AC + (size_t)k1 * 512 + cs * 256 + n0) = o; }
        if (blockIdx.x == 0) { float2* rope = (float2*)(ws + OFF_ROPE);
            for (int i = tid; i < 1024; i += 512) { const int pos = i >> 4, pp = i & 15; const float invf = powf(10000.f, -(float)pp * 2.0f / 32.f); const float ang = (float)pos * invf; rope[i] = make_float2(cosf(ang), sinf(ang)); } }
    }
}

template <bool GATES>
__device__ __forceinline__ void phase_norm(const float* xl, const float* xc, int nrows, const float* ng, const float* modl, int shIdx, int scIdx, bf16_t* H,
                                           const float* w_in_l, const float* a_log_l, const float* dt_bias_l, float* GB, LAS uchar* L, int tid, int lane, int wave) {
    LAS float* wgT = (LAS float*)L;
    if (GATES) { for (int i = tid; i < 16384; i += 512) { const int k = i >> 4, e = i & 15; wgT[e * 1024 + k] = w_in_l[(size_t)k * 2064 + 2048 + e]; } __syncthreads(); }
    for (int r = blockIdx.x * 8 + wave; r < nrows; r += gridDim.x * 8) {
        const float* xr = r < TL ? xl + (size_t)r * 1024 : xc + (size_t)(r - TL) * 1024;
        const int bb = r < TL ? r >> 11 : 16;
        const float* scp = modl + (size_t)bb * 6144 + scIdx * 1024; const float* shp = modl + (size_t)bb * 6144 + shIdx * 1024;
        f32x4 v[4]; float ss = 0.f;
#pragma unroll
        for (int j = 0; j < 4; ++j) { v[j] = ((const f32x4*)xr)[lane + 64 * j]; ss += (v[j][0] * v[j][0] + v[j][1] * v[j][1]) + (v[j][2] * v[j][2] + v[j][3] * v[j][3]); }
        const float rstd = rsqrtf(wave_sum(ss) * (1.f / 1024.f) + 1e-6f);
#pragma unroll
        for (int j = 0; j < 4; ++j) { const f32x4 g = ((const f32x4*)ng)[lane + 64 * j], sc = ((const f32x4*)scp)[lane + 64 * j], sh = ((const f32x4*)shp)[lane + 64 * j];
            v[j] = v[j] * rstd * g * (sc + 1.f) + sh;
            u32x2 w; w.x = pk(v[j][0], v[j][1]); w.y = pk(v[j][2], v[j][3]); *(u32x2*)(H + (size_t)r * 1024 + 4 * (lane + 64 * j)) = w; }
        if (GATES) {
            LAS float* wg = wgT; asm volatile("" : "+v"(wg));
            float acc[16];
#pragma unroll
            for (int e = 0; e < 16; ++e) { float a = 0.f;
#pragma unroll
                for (int j = 0; j < 4; ++j) { const f32x4 w = *(const LAS f32x4*)(wg + e * 1024 + 4 * (lane + 64 * j)); a += (v[j][0] * w[0] + v[j][1] * w[1]) + (v[j][2] * w[2] + v[j][3] * w[3]); }
                acc[e] = wave_sum(a); }
            float mine = 0.f;
#pragma unroll
            for (int e = 0; e < 16; ++e) mine = (lane == e) ? acc[e] : mine;
            if (lane < 16) { float o;
                if (lane < 8) o = 1.f / (1.f + expf(-mine));
                else { const int dh = lane - 8; const float xx = mine + dt_bias_l[dh]; const float sp = xx > 20.f ? xx : log1pf(expf(xx)); o = -expf(a_log_l[dh]) * sp; }
                GB[(size_t)r * 16 + lane] = o; }
        }
    }
}

__device__ __forceinline__ f32x4 mm16(const LAS uchar* X, int x0, const LAS uchar* Y, int y0, int lane) {
    const int r = lane & 15, q = lane >> 4;
    const LAS uchar* xp = X + (x0 + r) * 144 + q * 16; const LAS uchar* yp = Y + (y0 + r) * 144 + q * 16;
    const bf16x8 a0 = *(const LAS bf16x8*)xp, a1 = *(const LAS bf16x8*)(xp + 64), b0 = *(const LAS bf16x8*)yp, b1 = *(const LAS bf16x8*)(yp + 64);
    f32x4 acc = {0.f, 0.f, 0.f, 0.f};
    acc = mfma16(a0, b0, acc); acc = mfma16(a1, b1, acc);
    return acc;
}
constexpr int GL_QH = 0, GL_KH = 9216, GL_VT = 18432, GL_KBT = 27648, GL_KTT = 36864, GL_T = 46080, GL_QKM = 55296, GL_UT = 64512, GL_WT = 73728, GL_A = 82944, GL_GAM = 100352, GL_BET = 100608;

__device__ __forceinline__ void phase_gdn_pre(uchar* ws, const float* conv_w_l, LAS uchar* L_in, int tid_in, int lane_in, int wave) {
    const bf16_t* DQKV = (const bf16_t*)(ws + OFF_DQKV); const float* GB = (const float*)(ws + OFF_GB);
    bf16_t* M1g = (bf16_t*)(ws + OFF_M1); bf16_t* M2g = (bf16_t*)(ws + OFF_M2); bf16_t* O0Tg = (bf16_t*)(ws + OFF_O0T); bf16_t* S0Tg = (bf16_t*)(ws + OFF_S0T);
    for (int task = blockIdx.x; task < 4608; task += gridDim.x) {
        int tid = tid_in; asm volatile("" : "+v"(tid)); const int lane = tid & 63; (void)lane_in;
        LAS uchar* L = L_in; asm volatile("" : "+v"(L));
        LAS float* gam = (LAS float*)(L + GL_GAM); LAS float* bet = (LAS float*)(L + GL_BET); LAS float* A = (LAS float*)(L + GL_A);
        const int dir = task / 2304, rem = task % 2304, b = rem / 144, rem2 = rem % 144, h = rem2 / 36, cidx = rem2 % 36;
        const bool isctx = cidx < 4; const int Ls = isctx ? 256 : 2048;
        const int chunk = isctx ? (dir ? 3 - cidx : cidx) : (dir ? 35 - cidx : cidx - 4);
        const int base = chunk * 64; const size_t row0 = isctx ? (size_t)TL + b * 256 : (size_t)b * 2048;
        const size_t slot = (size_t)((dir * 16 + b) * 4 + h) * 36 + cidx;
        if (wave == 0) { const int pos = base + (dir ? 63 - lane : lane); const float* gb = GB + (row0 + pos) * 16; float s = gb[8 + dir * 4 + h]; const float be = gb[dir * 4 + h];
#pragma unroll
            for (int o = 1; o < 64; o <<= 1) { const float t = __shfl_up(s, o); if (lane >= o) s += t; }
            gam[lane] = s; bet[lane] = be; }
        __syncthreads();
        {
            const int i = tid >> 3, part = tid & 7; const int pos = base + (dir ? 63 - i : i);
            const float gi = gam[i], bi = bet[i], g63 = gam[63];
            const float eg = __expf(gi), ek = __expf(g63 - gi);
#pragma unroll
            for (int which = 0; which < 3; ++which) {
                const int ch = which * 256 + h * 64 + part * 8;
                float y[8];
#pragma unroll
                for (int e = 0; e < 8; ++e) y[e] = 0.f;
#pragma unroll
                for (int j = 0; j < 3; ++j) { const int pp = pos + j - 1;
                    if (pp >= 0 && pp < Ls) { const u32x4 raw = *(const u32x4*)(DQKV + (row0 + pp) * 768 + ch);
                        const f32x4 w0 = *(const f32x4*)(conv_w_l + j * 768 + ch), w1 = *(const f32x4*)(conv_w_l + j * 768 + ch + 4);
                        y[0] += w0[0] * bflo(raw.x); y[1] += w0[1] * bfhi(raw.x); y[2] += w0[2] * bflo(raw.y); y[3] += w0[3] * bfhi(raw.y);
                        y[4] += w1[0] * bflo(raw.z); y[5] += w1[1] * bfhi(raw.z); y[6] += w1[2] * bflo(raw.w); y[7] += w1[3] * bfhi(raw.w); } }
                float ss = 0.f;
#pragma unroll
                for (int e = 0; e < 8; ++e) { y[e] = silu_f(y[e]); ss += y[e] * y[e]; }
                if (which < 2) { ss += __shfl_xor(ss, 1); ss += __shfl_xor(ss, 2); ss += __shfl_xor(ss, 4); const float rn = rsqrtf(ss + 1e-6f) * (which == 0 ? 0.125f : 1.f);
#pragma unroll
                    for (int e = 0; e < 8; ++e) y[e] *= rn; }
                if (which < 2) { u32x4 o; o.x = pk(y[0], y[1]); o.y = pk(y[2], y[3]); o.z = pk(y[4], y[5]); o.w = pk(y[6], y[7]);
                    *(LAS u32x4*)(L + (which == 0 ? GL_QH : GL_KH) + i * 144 + part * 16) = o; }
                if (which == 1) {
#pragma unroll
                    for (int e = 0; e < 8; ++e) { const int d = part * 8 + e; *(LAS bf16_t*)(L + GL_KBT + d * 144 + i * 2) = f2bf(bi * eg * y[e]); *(LAS bf16_t*)(L + GL_KTT + d * 144 + i * 2) = f2bf(ek * y[e]); } }
                if (which == 2) {
#pragma unroll
                    for (int e = 0; e < 8; ++e) { const int d = part * 8 + e; *(LAS bf16_t*)(L + GL_VT + d * 144 + i * 2) = f2bf(bi * y[e]); } }
            }
        }
        __syncthreads();
        {
#pragma unroll
            for (int tt = 0; tt < 2; ++tt) { const int tile = 2 * wave + tt, ti = tile >> 2, tj = tile & 3;
                const f32x4 kk = mm16(L + GL_KH, ti * 16, L + GL_KH, tj * 16, lane);
                const f32x4 qk = mm16(L + GL_QH, ti * 16, L + GL_KH, tj * 16, lane);
                const int j = tj * 16 + (lane & 15); const float gj = gam[j];
#pragma unroll
                for (int idx = 0; idx < 4; ++idx) { const int i = ti * 16 + 4 * (lane >> 4) + idx; const float gi = gam[i], bi = bet[i]; const float dec = __expf(fminf(gi - gj, 0.f));
                    A[i * 68 + j] = (i > j) ? bi * kk[idx] * dec : 0.f;
                    *(LAS bf16_t*)(L + GL_QKM + i * 144 + j * 2) = f2bf((i >= j) ? qk[idx] * dec : 0.f); } }
        }
        __syncthreads();
        if (wave == 0) {
            float t[64]; int c = lane; asm volatile("" : "+v"(c));
            const unsigned ohlo = c < 32 ? (1u << c) : 0u, ohhi = c >= 32 ? (1u << (c - 32)) : 0u;
#pragma unroll
            for (int i = 0; i < 64; ++i) { float s = (float)(((i < 32 ? ohlo : ohhi) >> (i & 31)) & 1u);
#pragma unroll
                for (int j4 = 0; j4 < (i + 3) / 4; ++j4) { const f32x4 a = *(const LAS f32x4*)(A + i * 68 + 4 * j4);
                    s -= a[0] * t[4 * j4];
                    if (4 * j4 + 1 < i) s -= a[1] * t[4 * j4 + 1];
                    if (4 * j4 + 2 < i) s -= a[2] * t[4 * j4 + 2];
                    if (4 * j4 + 3 < i) s -= a[3] * t[4 * j4 + 3]; }
                t[i] = s; }
#pragma unroll
            for (int i = 0; i < 64; ++i) *(LAS bf16_t*)(L + GL_T + i * 144 + c * 2) = f2bf(t[i]);
        }
        __syncthreads();
        {
#pragma unroll
            for (int tt = 0; tt < 4; ++tt) { const int tile = 4 * wave + tt, mat = tile >> 4, t16 = tile & 15, ti = t16 >> 2, te = t16 & 3;
                const f32x4 acc = mm16(L + GL_T, ti * 16, L + (mat ? GL_KBT : GL_VT), te * 16, lane);
                const int y = te * 16 + (lane & 15), i0 = ti * 16 + 4 * (lane >> 4);
                u32x2 w; w.x = pk(acc[0], acc[1]); w.y = pk(acc[2], acc[3]);
                *(LAS u32x2*)(L + (mat ? GL_WT : GL_UT) + y * 144 + i0 * 2) = w; }
        }
        __syncthreads();
        {
            const int mi = wave >> 1;
            const LAS uchar* X = L + (mi < 2 ? GL_QKM : GL_KTT); const LAS uchar* Y = L + ((mi & 1) ? GL_UT : GL_WT);
            const float a63 = __expf(gam[63]);
#pragma unroll
            for (int tt = 0; tt < 8; ++tt) { const int t16 = (wave & 1) * 8 + tt, tx = t16 >> 2, ty = t16 & 3;
                const f32x4 acc = mm16(X, tx * 16, Y, ty * 16, lane);
                const int y = ty * 16 + (lane & 15), x0 = tx * 16 + 4 * (lane >> 4);
                if (mi == 0) {
#pragma unroll
                    for (int idx = 0; idx < 4; ++idx) { const int i = x0 + idx; const float qv = bf2f(*(const LAS bf16_t*)(L + GL_QH + i * 144 + y * 2)) * __expf(gam[i]) - acc[idx];
                        const int ir = dir ? 63 - i : i; M1g[slot * 4096 + ir * 64 + y] = f2bf(qv); }
                } else if (mi == 1) {
#pragma unroll
                    for (int idx = 0; idx < 4; ++idx) { const int i = x0 + idx; const int ir = dir ? 63 - i : i; O0Tg[slot * 4096 + y * 64 + ir] = f2bf(acc[idx]); }
                } else if (mi == 2) {
#pragma unroll
                    for (int idx = 0; idx < 4; ++idx) { const int dp = x0 + idx; const float v = ((dp == y) ? a63 : 0.f) - acc[idx]; M2g[slot * 4096 + dp * 64 + y] = f2bf(v); }
                } else {
                    u32x2 w; w.x = pk(acc[0], acc[1]); w.y = pk(acc[2], acc[3]); *(u32x2*)(S0Tg + slot * 4096 + y * 64 + x0) = w;
                }
            }
        }
        __syncthreads();
    }
}

__device__ __forceinline__ void phase_scan(uchar* ws, int lane, int wave) {
    if (wave >= 2) return;
    const bf16_t* M2g = (const bf16_t*)(ws + OFF_M2); const bf16_t* S0Tg = (const bf16_t*)(ws + OFF_S0T); bf16_t* STg = (bf16_t*)(ws + OFF_ST);
    const int r = lane & 15, q = lane >> 4;
    for (int item = blockIdx.x * 2 + wave; item < 512; item += gridDim.x * 2) {
        const int chain = item >> 2, e = (item & 3) * 16 + r;
        f32x4 S[4];
#pragma unroll
        for (int t = 0; t < 4; ++t) S[t] = (f32x4){0.f, 0.f, 0.f, 0.f};
        for (int n = 0; n < 36; ++n) {
            const size_t so = ((size_t)chain * 36 + n) * 4096;
            u32x4 y0, y1;
            y0.x = pk(S[0][0], S[0][1]); y0.y = pk(S[0][2], S[0][3]); y0.z = pk(S[1][0], S[1][1]); y0.w = pk(S[1][2], S[1][3]);
            y1.x = pk(S[2][0], S[2][1]); y1.y = pk(S[2][2], S[2][3]); y1.z = pk(S[3][0], S[3][1]); y1.w = pk(S[3][2], S[3][3]);
            *(u32x2*)(STg + so + e * 64 + 4 * q) = (u32x2){y0.x, y0.y}; *(u32x2*)(STg + so + e * 64 + 16 + 4 * q) = (u32x2){y0.z, y0.w};
            *(u32x2*)(STg + so + e * 64 + 32 + 4 * q) = (u32x2){y1.x, y1.y}; *(u32x2*)(STg + so + e * 64 + 48 + 4 * q) = (u32x2){y1.z, y1.w};
            const bf16x8 yb0 = __builtin_bit_cast(bf16x8, y0), yb1 = __builtin_bit_cast(bf16x8, y1);
#pragma unroll
            for (int t = 0; t < 4; ++t) {
                const u32x2 c = *(const u32x2*)(S0Tg + so + e * 64 + 16 * t + 4 * q);
                f32x4 C = {bflo(c.x), bfhi(c.x), bflo(c.y), bfhi(c.y)};
                const bf16_t* mrow = M2g + so + (16 * t + r) * 64;
                const u32x2 l0 = *(const u32x2*)(mrow + 4 * q), h0 = *(const u32x2*)(mrow + 16 + 4 * q), l1 = *(const u32x2*)(mrow + 32 + 4 * q), h1 = *(const u32x2*)(mrow + 48 + 4 * q);
                const bf16x8 x0 = __builtin_bit_cast(bf16x8, (u32x4){l0.x, l0.y, h0.x, h0.y}), x1 = __builtin_bit_cast(bf16x8, (u32x4){l1.x, l1.y, h1.x, h1.y});
                C = mfma16(x0, yb0, C); C = mfma16(x1, yb1, C);
                S[t] = C;
            }
        }
    }
}

__device__ __forceinline__ void phase_gdn_out(uchar* ws, const float* ong, bool need_ctx, int lane, int wave) {
    const bf16_t* M1g = (const bf16_t*)(ws + OFF_M1); const bf16_t* O0Tg = (const bf16_t*)(ws + OFF_O0T); const bf16_t* STg = (const bf16_t*)(ws + OFF_ST);
    const bf16_t* DZ = (const bf16_t*)(ws + OFF_DZ); bf16_t* CAT = (bf16_t*)(ws + OFF_CAT);
    const int r = lane & 15, q = lane >> 4, ti = wave & 3;
    for (int unit = blockIdx.x * 2 + (wave >> 2); unit < 2304; unit += gridDim.x * 2) {
        const int b = unit / 144, rem = unit % 144, h = rem / 36, cpos = rem % 36;
        const bool isctx = cpos < 4; if (isctx && !need_ctx) continue;
        const int cb = isctx ? 3 - cpos : 39 - cpos;
        const size_t sof = ((size_t)((0 * 16 + b) * 4 + h) * 36 + cpos) * 4096, sob = ((size_t)((16 + b) * 4 + h) * 36 + cb) * 4096;
        f32x4 acc[4];
#pragma unroll
        for (int te = 0; te < 4; ++te) { const int e = te * 16 + r;
            const u32x2 cf = *(const u32x2*)(O0Tg + sof + e * 64 + 16 * ti + 4 * q), cbk = *(const u32x2*)(O0Tg + sob + e * 64 + 16 * ti + 4 * q);
            acc[te] = (f32x4){bflo(cf.x) + bflo(cbk.x), bfhi(cf.x) + bfhi(cbk.x), bflo(cf.y) + bflo(cbk.y), bfhi(cf.y) + bfhi(cbk.y)}; }
#pragma unroll
        for (int dn = 0; dn < 2; ++dn) { const size_t so = dn ? sob : sof;
#pragma unroll
            for (int ks = 0; ks < 2; ++ks) { const bf16x8 x = *(const bf16x8*)(M1g + so + (16 * ti + r) * 64 + 32 * ks + 8 * q);
#pragma unroll
                for (int te = 0; te < 4; ++te) { const bf16x8 y = *(const bf16x8*)(STg + so + (te * 16 + r) * 64 + 32 * ks + 8 * q); acc[te] = mfma16(x, y, acc[te]); } } }
        const size_t tok0 = isctx ? (size_t)TL + b * 256 + cpos * 64 : (size_t)b * 2048 + (cpos - 4) * 64;
#pragma unroll
        for (int idx = 0; idx < 4; ++idx) {
            float ss = (acc[0][idx] * acc[0][idx] + acc[1][idx] * acc[1][idx]) + (acc[2][idx] * acc[2][idx] + acc[3][idx] * acc[3][idx]);
            ss += __shfl_xor(ss, 1); ss += __shfl_xor(ss, 2); ss += __shfl_xor(ss, 4); ss += __shfl_xor(ss, 8);
            const float rinv = rsqrtf(ss * (1.f / 64.f) + 1e-6f);
            const size_t tok = tok0 + 16 * ti + 4 * q + idx;
#pragma unroll
            for (int te = 0; te < 4; ++te) { const int e = te * 16 + r; const float gate = silu_f(bf2f(DZ[tok * 256 + h * 64 + e]));
                CAT[tok * 1024 + 768 + h * 64 + e] = f2bf(acc[te][idx] * rinv * ong[e] * gate); }
        }
    }
}

constexpr int AL_K = 0, AL_V = 18432;
__device__ __forceinline__ void attn_unit(LAS uchar* L, const bf16_t* Qb, const bf16_t* Kb, const bf16_t* VTl, const bf16_t* VTc, bf16_t* CAT,
                                          int b, int head, size_t qrow0, bool lat, int tid, int lane, int wave) {
    const int kvh = head >> 2, ntile = lat ? 36 : 4;
    const int r32 = lane & 31, hi = lane >> 5;
    const size_t qrow = qrow0 + wave * 32 + r32;
    bf16x8 qf[4];
#pragma unroll
    for (int ks = 0; ks < 4; ++ks) qf[ks] = *(const bf16x8*)(Qb + qrow * 512 + head * 64 + 16 * ks + 8 * hi);
    f32x16 o0, o1;
#pragma unroll
    for (int i = 0; i < 16; ++i) { o0[i] = 0.f; o1[i] = 0.f; }
    float mrun = -INFINITY, lsum = 0.f;
    const int lrow = tid >> 3, lch = tid & 7;
    const float LOG2E = 1.4426950408889634f;
    const bf16_t* kl = Kb + ((size_t)b * 2048 + lrow) * 128 + kvh * 64 + 8 * lch;
    const bf16_t* kc = Kb + ((size_t)TL + b * 256 + lrow) * 128 + kvh * 64 + 8 * lch;
    const bf16_t* vl = VTl + ((size_t)(b * 2 + kvh) * 64 + lrow) * 2048 + 8 * lch;
    const bf16_t* vc = VTc + ((size_t)(b * 2 + kvh) * 64 + lrow) * 256 + 8 * lch;
    u32x4 kreg, vreg;
#define ATT_LOAD(t) do { const int t_ = (t); if (lat && t_ < 32) { kreg = *(const u32x4*)(kl + (size_t)t_ * 64 * 128); vreg = *(const u32x4*)(vl + t_ * 64); } \
        else { const int tc_ = lat ? t_ - 32 : t_; kreg = *(const u32x4*)(kc + (size_t)tc_ * 64 * 128); vreg = *(const u32x4*)(vc + tc_ * 64); } } while (0)
#define ATT_STORE(buf) do { *(LAS u32x4*)(L + AL_K + (buf) * 9216 + lrow * 144 + lch * 16) = kreg; *(LAS u32x4*)(L + AL_V + (buf) * 9216 + lrow * 144 + lch * 16) = vreg; } while (0)
    __syncthreads();
    ATT_LOAD(0); ATT_STORE(0);
    __syncthreads();
    for (int t = 0; t < ntile; ++t) {
        const int buf = t & 1;
        if (t + 1 < ntile) ATT_LOAD(t + 1);
        const LAS uchar* Kt = L + AL_K + buf * 9216; const LAS uchar* Vt = L + AL_V + buf * 9216;
        f32x16 s0, s1;
#pragma unroll
        for (int i = 0; i < 16; ++i) { s0[i] = 0.f; s1[i] = 0.f; }
#pragma unroll
        for (int ks = 0; ks < 4; ++ks) {
            const bf16x8 k0 = *(const LAS bf16x8*)(Kt + r32 * 144 + ks * 32 + hi * 16);
            const bf16x8 k1 = *(const LAS bf16x8*)(Kt + (32 + r32) * 144 + ks * 32 + hi * 16);
            s0 = mfma32(k0, qf[ks], s0); s1 = mfma32(k1, qf[ks], s1);
        }
        float mx = s0[0];
#pragma unroll
        for (int i = 1; i < 16; ++i) mx = fmaxf(mx, s0[i]);
#pragma unroll
        for (int i = 0; i < 16; ++i) mx = fmaxf(mx, s1[i]);
        mx = fmaxf(mx, __shfl_xor(mx, 32));
        const float mnew = fmaxf(mrun, mx * LOG2E);
        const float alpha = exp2f(mrun - mnew);
        mrun = mnew;
        float ps = 0.f;
#pragma unroll
        for (int i = 0; i < 16; ++i) { s0[i] = exp2f(s0[i] * LOG2E - mnew); s1[i] = exp2f(s1[i] * LOG2E - mnew); ps += s0[i] + s1[i]; }
        lsum = lsum * alpha + ps;
#pragma unroll
        for (int i = 0; i < 16; ++i) { o0[i] *= alpha; o1[i] *= alpha; }
#pragma unroll
        for (int kk = 0; kk < 2; ++kk)
#pragma unroll
            for (int kst = 0; kst < 2; ++kst) {
                u32x4 pw;
                if (kk == 0) { pw.x = pk(s0[8 * kst + 0], s0[8 * kst + 1]); pw.y = pk(s0[8 * kst + 2], s0[8 * kst + 3]); pw.z = pk(s0[8 * kst + 4], s0[8 * kst + 5]); pw.w = pk(s0[8 * kst + 6], s0[8 * kst + 7]); }
                else         { pw.x = pk(s1[8 * kst + 0], s1[8 * kst + 1]); pw.y = pk(s1[8 * kst + 2], s1[8 * kst + 3]); pw.z = pk(s1[8 * kst + 4], s1[8 * kst + 5]); pw.w = pk(s1[8 * kst + 6], s1[8 * kst + 7]); }
                const bf16x8 pf = __builtin_bit_cast(bf16x8, pw);
                const int kof = (32 * kk + 16 * kst + 4 * hi) * 2;
                const u32x2 a0 = *(const LAS u32x2*)(Vt + r32 * 144 + kof), a1 = *(const LAS u32x2*)(Vt + r32 * 144 + kof + 16);
                const u32x2 c0 = *(const LAS u32x2*)(Vt + (32 + r32) * 144 + kof), c1 = *(const LAS u32x2*)(Vt + (32 + r32) * 144 + kof + 16);
                o0 = mfma32(__builtin_bit_cast(bf16x8, (u32x4){a0.x, a0.y, a1.x, a1.y}), pf, o0);
                o1 = mfma32(__builtin_bit_cast(bf16x8, (u32x4){c0.x, c0.y, c1.x, c1.y}), pf, o1);
            }
        if (t + 1 < ntile) ATT_STORE(buf ^ 1);
        __syncthreads();
    }
#undef ATT_LOAD
#undef ATT_STORE
    lsum += __shfl_xor(lsum, 32);
    const float inv = 1.f / lsum;
    bf16_t* dst = CAT + qrow * 1024 + 256 + head * 64 + 4 * hi;
#pragma unroll
    for (int g = 0; g < 4; ++g) {
        u32x2 w0, w1; w0.x = pk(o0[4 * g] * inv, o0[4 * g + 1] * inv); w0.y = pk(o0[4 * g + 2] * inv, o0[4 * g + 3] * inv);
        w1.x = pk(o1[4 * g] * inv, o1[4 * g + 1] * inv); w1.y = pk(o1[4 * g + 2] * inv, o1[4 * g + 3] * inv);
        *(u32x2*)(dst + 8 * g) = w0; *(u32x2*)(dst + 32 + 8 * g) = w1;
    }
}

__device__ __forceinline__ void phase_attn(uchar* ws, bool need_ctx, LAS uchar* L, int tid, int lane, int wave) {
    const bf16_t* Qb = (const bf16_t*)(ws + OFF_Q); const bf16_t* Kb = (const bf16_t*)(ws + OFF_K);
    const bf16_t* VTl = (const bf16_t*)(ws + OFF_VTL); const bf16_t* VTc = (const bf16_t*)(ws + OFF_VTC); bf16_t* CAT = (bf16_t*)(ws + OFF_CAT);
    const int nunits = 1024 + (need_ctx ? 128 : 0);
    for (int u = blockIdx.x; u < nunits; u += gridDim.x) {
        if (u < 1024) { const int b = u >> 6, head = (u >> 3) & 7, qb = u & 7; attn_unit(L, Qb, Kb, VTl, VTc, CAT, b, head, (size_t)b * 2048 + qb * 256, true, tid, lane, wave); }
        else { const int v = u - 1024, b = v >> 3, head = v & 7; attn_unit(L, Qb, Kb, VTl, VTc, CAT, b, head, (size_t)TL + b * 256, false, tid, lane, wave); }
    }
}

typedef const __attribute__((address_space(4))) Params CParams;
#define PH_BEGIN { CParams* kp = (CParams*)__builtin_amdgcn_kernarg_segment_ptr(); int tid = threadIdx.x; LAS uchar* Lv = L; asm volatile("" : "+s"(kp), "+v"(tid), "+v"(Lv)); (void)Lv; \
    uchar* ws = kp->ws; const int lane = tid & 63, wave = __builtin_amdgcn_readfirstlane(tid >> 6); const int G = gridDim.x, bid = blockIdx.x; \
    const float* mod = (const float*)(ws + OFF_MOD); float* XC = (float*)(ws + OFF_XC); bf16_t* H = (bf16_t*)(ws + OFF_H); bf16_t* CAT = (bf16_t*)(ws + OFF_CAT); bf16_t* U = (bf16_t*)(ws + OFF_U); \
    const float* modl = mod + (size_t)l * 17 * 6144; uchar* wb = ws + OFF_WB + (size_t)l * WB_LAYER; float* OUT = kp->out; \
    (void)lane; (void)wave; (void)XC; (void)H; (void)CAT; (void)U; (void)modl; (void)wb; (void)G; (void)bid; (void)OUT;
#define PH_END }
#define GSYNC() do { __threadfence(); grid.sync(); __threadfence(); } while (0)
#define IN(k) (kp->in[k])

__global__ void __launch_bounds__(512) mega(Params p) {
    extern __shared__ __attribute__((aligned(16))) unsigned char lds[];
    cg::grid_group grid = cg::this_grid();
    LAS uchar* L = (LAS uchar*)lds;
    (void)p;
    { const int l = 0;
    PH_BEGIN phase_prologue(kp, Lv, tid, lane, wave); PH_END
    GSYNC();
    PH_BEGIN phase_norm<true>(IN(0), IN(2), TT, IN(4), mod, 0, 1, H, IN(8), IN(12), IN(13), (float*)(ws + OFF_GB), Lv, tid, lane, wave); PH_END
    GSYNC();
    }
#pragma unroll 1
    for (int l = 0; l < 2; ++l) {
        const bool last = (l == 1);
        const int Mrows = last ? TL : TT;
        PH_BEGIN {
            pg8::Gemm g{H, (const bf16_t*)(wb + WB_W1), TT, 2304, 1024}; pg8::StaticOrder S; S.init(TT, 2304, G, bid);
            EpiProj E{ws, IN(10) + l * 64, IN(11) + l * 64};
            pg8::gemm_phase<EpiProj, pg8::StaticOrder, false, true>(L, g, S, E);
        } PH_END
        GSYNC();
        PH_BEGIN phase_gdn_pre(ws, IN(9) + (size_t)l * 3 * 768, Lv, tid, lane, wave); PH_END
        GSYNC();
        PH_BEGIN phase_scan(ws, lane, wave); PH_END
        __syncthreads();
        PH_BEGIN {
            pg8::Gemm g{(const bf16_t*)(ws + OFF_DFTL), (const bf16_t*)(ws + OFF_GTL), 2048, 4096, 4096}; pg8::StaticOrder S; S.init(2048, 4096, G, bid);
            EpiFourier E{CAT, 0, 2048};
            pg8::gemm_phase<EpiFourier, pg8::StaticOrder, false, true>(L, g, S, E);
        } PH_END
        if (!last) PH_BEGIN {
            __syncthreads();
            pg8::Gemm g{(const bf16_t*)(ws + OFF_DFTC), (const bf16_t*)(ws + OFF_GTC), 256, 4096, 512}; pg8::StaticOrder S; S.init(256, 4096, G, bid);
            EpiFourier E{CAT, TL, 256};
            pg8::gemm_phase<EpiFourier, pg8::StaticOrder, false, true>(L, g, S, E);
        } PH_END
        __syncthreads();
        PH_BEGIN phase_attn(ws, !last, Lv, tid, lane, wave); PH_END
        GSYNC();
        PH_BEGIN phase_gdn_out(ws, IN(14) + l * 64, !last, lane, wave); PH_END
        GSYNC();
        PH_BEGIN {
            pg8::Gemm g{CAT, (const bf16_t*)(wb + WB_WO), Mrows, 1024, 1024}; pg8::StaticOrder S; S.init(Mrows, 1024, G, bid);
            EpiResid E{last ? (const float*)OUT : IN(0), OUT, last ? (const float*)XC : IN(2), XC, modl + 2 * 1024};
            pg8::gemm_phase<EpiResid, pg8::StaticOrder, false, true>(L, g, S, E);
        } PH_END
        GSYNC();
        PH_BEGIN phase_norm<false>(OUT, XC, Mrows, IN(5) + l * 1024, modl, 3, 4, H, nullptr, nullptr, nullptr, nullptr, Lv, tid, lane, wave); PH_END
        GSYNC();
        PH_BEGIN {
            pg8::Gemm g{H, (const bf16_t*)(wb + WB_F1), Mrows, 4096, 1024}; pg8::StaticOrder S; S.init(Mrows, 4096, G, bid);
            EpiRelu2 E{U};
            pg8::gemm_phase<EpiRelu2, pg8::StaticOrder, false, true>(L, g, S, E);
        } PH_END
        GSYNC();
        PH_BEGIN {
            pg8::Gemm g{U, (const bf16_t*)(wb + WB_F2), Mrows, 1024, 4096}; pg8::StaticOrder S; S.init(Mrows, 1024, G, bid);
            EpiResid E{OUT, OUT, XC, XC, modl + 5 * 1024};
            pg8::gemm_phase<EpiResid, pg8::StaticOrder, false, true>(L, g, S, E);
        } PH_END
#if NAN_SCRUB
        if (last) {
            GSYNC();
            PH_BEGIN for (size_t i = (size_t)bid * 512 + tid; i < (size_t)TL * 1024; i += (size_t)G * 512) { float v = OUT[i]; if (!(fabsf(v) < 1e30f)) OUT[i] = 0.f; } PH_END
        }
#endif
        if (!last) {
            GSYNC();
            PH_BEGIN phase_norm<true>(OUT, XC, TT, IN(4) + 1024, mod + (size_t)17 * 6144, 0, 1, H, IN(8) + (size_t)1024 * 2064, IN(12) + 8, IN(13) + 8, (float*)(ws + OFF_GB), Lv, tid, lane, wave); PH_END
            GSYNC();
        }
    }
}

extern "C" void kernel_launch(void* const* d_in, const int* in_sizes, int n_in, void* d_out, int out_size, void* d_ws, size_t ws_size, hipStream_t stream) {
    static int grid = 0;
    if (!grid) {
        int dev = 0, cus = 0, per_cu = 0;
        (void)hipGetDevice(&dev);
        (void)hipDeviceGetAttribute(&cus, hipDeviceAttributeMultiprocessorCount, dev);
        (void)hipFuncSetAttribute((const void*)mega, hipFuncAttributeMaxDynamicSharedMemorySize, LDS_BYTES);
        (void)hipOccupancyMaxActiveBlocksPerMultiprocessor(&per_cu, (const void*)mega, 512, LDS_BYTES);
        if (per_cu < 1) per_cu = 1;
        grid = cus * per_cu;
        if (ws_size < WS_END) { fprintf(stderr, "kernel_launch: workspace too small: %zu < %zu\n", ws_size, (size_t)WS_END); grid = -1; }
    }
    if (grid < 0) return;
    Params p{};
    for (int i = 0; i < 18; ++i) p.in[i] = (const float*)d_in[i];
    p.out = (float*)d_out; p.ws = (unsigned char*)d_ws;
    void* args[] = {&p};
    hipError_t e = hipLaunchCooperativeKernel((const void*)mega, dim3(grid), dim3(512), args, LDS_BYTES, stream);
    if (e != hipSuccess) fprintf(stderr, "cooperative launch failed: %s (grid %d)\n", hipGetErrorString(e), grid);
}
```

```cpp
#include <hip/hip_runtime.h>
#include <hip/hip_cooperative_groups.h>
#include <cstdio>
#include <cstdint>
#include <cmath>
namespace cg = cooperative_groups;
#define NAN_SCRUB 0
#define DIAG 0
namespace pg8 {
#define PG8_LAS __attribute__((address_space(3)))
typedef unsigned short bf16_t;
typedef short bf16x8 __attribute__((ext_vector_type(8)));
typedef float f32x4 __attribute__((ext_vector_type(4)));
typedef unsigned u32x4 __attribute__((ext_vector_type(4)));
constexpr int BM = 256, BK = 64, HALF = 128, HTB = HALF * BK * 2  , STAGE_BYTES = 8 * HTB, NXCD = 8, WGM = 4;

__host__ __device__ __forceinline__ int lds_byte(int r, int c) { const int st = (r >> 4) * 2 + (c >> 5), rr = r & 15, cc = c & 31, ob = rr * 64 + cc * 2; return st * 1024 + (ob ^ (((ob >> 9) & 1) << 5)); }
__host__ __device__ __forceinline__ void stage_rc(int b, int& R, int& C) { const int st = b / 1024, sb = b % 1024, swz = sb ^ (((sb >> 9) & 1) << 5); R = (st >> 1) * 16 + swz / 64; C = (st & 1) * 32 + (swz % 64) / 2; }
__host__ __device__ __forceinline__ int perm32(int rho) { const int n = rho >> 4, i = rho & 15; return 8 * (i >> 2) + 4 * n + (i & 3); }

struct Unit { int pm, pn; };
struct Gemm { const bf16_t* A; const bf16_t* Bt; int M, N, K, ld; };

struct StaticOrder {
    int nM, nN, nwg, G, c;
    __host__ __device__ void init(int M, int N, int G_, int c_) { nM = M / BM; nN = N / BM; nwg = nM * nN; G = G_; c = c_; }
    __host__ __device__ bool next(int i, Unit& u) const {
        const long L = (long)i * G + c; if (L >= nwg) return false;
        int wgid = (int)L; { const int q = nwg / NXCD, r = nwg % NXCD, xcd = wgid % NXCD, off = wgid / NXCD; wgid = (xcd < r ? xcd * (q + 1) : r * (q + 1) + (xcd - r) * q) + off; }
        const int nig = WGM * nN, gid = wgid / nig, fm = gid * WGM, gsz = (nM - fm) < WGM ? (nM - fm) : WGM;
        u.pm = fm + ((wgid % nig) % gsz); u.pn = (wgid % nig) / gsz; return true;
    }
    __device__ __forceinline__ void a_ready(const Unit&) const {}
    __device__ __forceinline__ void done(const Unit&) const {}
};

__device__ __forceinline__ unsigned cvt_pk_bf16(float lo, float hi) { unsigned r; asm volatile("v_cvt_pk_bf16_f32 %0, %1, %2" : "=v"(r) : "v"(lo), "v"(hi)); return r; }
typedef float f32x2 __attribute__((ext_vector_type(2)));
template <class Epi, class Sched, bool ALIGN_EPI = false, bool SP2 = false>
__device__ __forceinline__ void gemm_phase(PG8_LAS unsigned char* lds, const Gemm g, const Sched& S, const Epi& E, int tid_in) {
    int tid_l = tid_in; asm volatile("" : "+v"(tid_l)); const int tid = tid_l, wid = __builtin_amdgcn_readfirstlane(tid >> 6), lane = tid & 63, wr = wid >> 2, wc = wid & 3, fr = lane & 15, fq = lane >> 4;
    const int K = g.K, nt = K / BK, LD = g.ld;
    unsigned voffA[2], voffB[2];
#pragma unroll
    for (int i = 0; i < 2; ++i) { int R, C; stage_rc(tid * 16 + i * 8192, R, C); const int Rb = Epi::PERM ? ((R & ~31) + perm32(R & 31)) : R;
        voffA[i] = (unsigned)(R * LD + C) * 2u; voffB[i] = (unsigned)(Rb * LD + C) * 2u; }
    const size_t kstep = (size_t)(BK * 2);
    const size_t hstep = (size_t)HALF * LD * 2;
    const size_t tstep = 2 * hstep;
    const unsigned ldsw = (unsigned)wid * 1024u;
    const int aoff = lds_byte(wr * 64 + fr, fq * 8), boff = lds_byte(wc * 32 + fr, fq * 8);
#define PG8_SA(b, h) (((b) * 2 + (h)) * HTB)
#define PG8_SB(b, h) ((4 + (b) * 2 + (h)) * HTB)
#define PG8_STAGE(bufoff, gbase, voff) do { _Pragma("unroll") for (int _i = 0; _i < 2; ++_i) \
        __builtin_amdgcn_global_load_lds((const unsigned*)((const char*)(gbase) + (voff)[_i]), (PG8_LAS unsigned*)(lds + (bufoff) + ldsw + _i * 8192), 16, 0, 0); } while (0)
#define PG8_LDA(dst, b, h) do { _Pragma("unroll") for (int m = 0; m < 4; ++m) _Pragma("unroll") for (int k = 0; k < 2; ++k) dst[m][k] = *(const PG8_LAS bf16x8*)(lds + PG8_SA(b, h) + aoff + m * 2048 + k * 1024); } while (0)
#define PG8_LDB(dst, b, h) do { _Pragma("unroll") for (int n = 0; n < 2; ++n) _Pragma("unroll") for (int k = 0; k < 2; ++k) dst[n][k] = *(const PG8_LAS bf16x8*)(lds + PG8_SB(b, h) + boff + n * 2048 + k * 1024); } while (0)
#define PG8_MMA(ai, bj, At, Bt) do { __builtin_amdgcn_s_setprio(1); _Pragma("unroll") for (int m = 0; m < 4; ++m) _Pragma("unroll") for (int n = 0; n < 2; ++n) _Pragma("unroll") for (int k = 0; k < 2; ++k) \
        acc[ai][bj][m][n] = __builtin_amdgcn_mfma_f32_16x16x32_bf16(Bt[n][k], At[m][k], acc[ai][bj][m][n], 0, 0, 0); __builtin_amdgcn_s_setprio(0); } while (0)
#define PG8_WAIT_V(n) asm volatile("s_waitcnt vmcnt(" #n ")" ::: "memory")
#define PG8_WAIT_L(n) asm volatile("s_waitcnt lgkmcnt(" #n ")" ::: "memory")
#define PG8_BAR __builtin_amdgcn_s_barrier()
#define PG8_SCHED __builtin_amdgcn_sched_barrier(0)
    Unit cur, nxt; int ui = 0;
    if (!S.next(0, cur)) return;
    f32x4 acc[2][2][4][2];
#pragma unroll
    for (int a = 0; a < 2; ++a)
#pragma unroll
        for (int b = 0; b < 2; ++b)
#pragma unroll
            for (int m = 0; m < 4; ++m)
#pragma unroll
                for (int n = 0; n < 2; ++n) acc[a][b][m][n] = (f32x4){0.f, 0.f, 0.f, 0.f};
    bf16x8 At[4][2], B0[2][2], B1[2][2];
    const char* cA = (const char*)g.A + (size_t)cur.pm * tstep; const char* cB = (const char*)g.Bt + (size_t)cur.pn * tstep;
    S.a_ready(cur);
    if constexpr (SP2) {
        PG8_STAGE(PG8_SB(0, 0), cB, voffB); PG8_STAGE(PG8_SB(0, 1), cB + hstep, voffB); PG8_STAGE(PG8_SA(0, 0), cA, voffA); PG8_STAGE(PG8_SA(0, 1), cA + hstep, voffA);
        if (wr == 1) PG8_BAR;
        PG8_WAIT_V(2); PG8_BAR;
        PG8_STAGE(PG8_SB(1, 0), cB + kstep, voffB); PG8_STAGE(PG8_SA(1, 0), cA + kstep, voffA); PG8_STAGE(PG8_SB(1, 1), cB + hstep + kstep, voffB);
        PG8_WAIT_V(6); PG8_BAR;
    } else {
        PG8_STAGE(PG8_SB(0, 0), cB, voffB); PG8_STAGE(PG8_SA(0, 0), cA, voffA); PG8_STAGE(PG8_SB(0, 1), cB + hstep, voffB); PG8_STAGE(PG8_SA(0, 1), cA + hstep, voffA);
        if (wr == 1) PG8_BAR;
        PG8_WAIT_V(4); PG8_BAR;
        PG8_STAGE(PG8_SB(1, 0), cB + kstep, voffB); PG8_STAGE(PG8_SA(1, 0), cA + kstep, voffA); PG8_STAGE(PG8_SB(1, 1), cB + hstep + kstep, voffB);
        PG8_WAIT_V(6); PG8_BAR;
    }
    for (;;) {
        const bool has_next = S.next(ui + 1, nxt);
        const char* nA = has_next ? (const char*)g.A + (size_t)nxt.pm * tstep : cA; const char* nB = has_next ? (const char*)g.Bt + (size_t)nxt.pn * tstep : cB;
        for (int t = 0; t < nt; t += 2) {
            const bool last = (t == nt - 2);
            const char* a1 = cA + (size_t)(t + 1) * kstep;
            const char* a2 = last ? nA : cA + (size_t)(t + 2) * kstep; const char* b2 = last ? nB : cB + (size_t)(t + 2) * kstep;
            const char* a3 = a2 + kstep; const char* b3 = b2 + kstep;
            if (last && has_next) S.a_ready(nxt);
            if constexpr (SP2) {
            PG8_LDB(B0, 0, 0); PG8_LDB(B1, 0, 1); PG8_SCHED; PG8_LDA(At, 0, 0); PG8_STAGE(PG8_SA(1, 1), a1 + hstep, voffA);
            PG8_WAIT_V(8); PG8_WAIT_L(0); PG8_BAR; PG8_MMA(0, 0, At, B0); PG8_MMA(0, 1, At, B1); PG8_BAR; PG8_SCHED;
            PG8_LDA(At, 0, 1); PG8_STAGE(PG8_SB(0, 0), b2, voffB); PG8_STAGE(PG8_SB(0, 1), b2 + hstep, voffB); PG8_STAGE(PG8_SA(0, 0), a2, voffA);
            PG8_WAIT_V(8); PG8_WAIT_L(0); PG8_BAR; PG8_MMA(1, 0, At, B0); PG8_MMA(1, 1, At, B1); PG8_BAR; PG8_SCHED;
            PG8_LDB(B0, 1, 0); PG8_LDB(B1, 1, 1); PG8_SCHED; PG8_LDA(At, 1, 0); PG8_STAGE(PG8_SA(0, 1), a2 + hstep, voffA);
            PG8_WAIT_V(8); PG8_WAIT_L(0); PG8_BAR; PG8_MMA(0, 0, At, B0); PG8_MMA(0, 1, At, B1); PG8_BAR; PG8_SCHED;
            PG8_LDA(At, 1, 1); PG8_STAGE(PG8_SB(1, 0), b3, voffB); PG8_STAGE(PG8_SB(1, 1), b3 + hstep, voffB); PG8_STAGE(PG8_SA(1, 0), a3, voffA);
            PG8_WAIT_V(8); PG8_WAIT_L(0); PG8_BAR; PG8_MMA(1, 0, At, B0); PG8_MMA(1, 1, At, B1); PG8_BAR; PG8_SCHED;
            } else {
            PG8_LDB(B0, 0, 0); PG8_SCHED; PG8_LDA(At, 0, 0); PG8_STAGE(PG8_SA(1, 1), a1 + hstep, voffA);
            PG8_WAIT_L(8); PG8_BAR; PG8_WAIT_L(0); PG8_MMA(0, 0, At, B0); PG8_BAR; PG8_SCHED;
            PG8_LDB(B1, 0, 1); PG8_STAGE(PG8_SB(0, 0), b2, voffB);
            PG8_BAR; PG8_WAIT_L(0); PG8_MMA(0, 1, At, B1); PG8_BAR;
            PG8_LDA(At, 0, 1); PG8_STAGE(PG8_SA(0, 0), a2, voffA);
            PG8_BAR; PG8_WAIT_L(0); PG8_MMA(1, 0, At, B0); PG8_BAR; PG8_SCHED;
            PG8_STAGE(PG8_SB(0, 1), b2 + hstep, voffB);
            PG8_WAIT_V(6); PG8_BAR; PG8_MMA(1, 1, At, B1); PG8_BAR;
            PG8_LDB(B0, 1, 0); PG8_SCHED; PG8_LDA(At, 1, 0); PG8_STAGE(PG8_SA(0, 1), a2 + hstep, voffA);
            PG8_WAIT_L(8); PG8_BAR; PG8_WAIT_L(0); PG8_MMA(0, 0, At, B0); PG8_BAR; PG8_SCHED;
            PG8_LDB(B1, 1, 1); PG8_STAGE(PG8_SB(1, 0), b3, voffB);
            PG8_BAR; PG8_WAIT_L(0); PG8_MMA(0, 1, At, B1); PG8_BAR;
            PG8_LDA(At, 1, 1); PG8_STAGE(PG8_SA(1, 0), a3, voffA);
            PG8_BAR; PG8_WAIT_L(0); PG8_MMA(1, 0, At, B0); PG8_BAR; PG8_SCHED;
            PG8_STAGE(PG8_SB(1, 1), b3 + hstep, voffB);
            PG8_WAIT_V(6); PG8_BAR; PG8_MMA(1, 1, At, B1); PG8_BAR;
            }
        }
        if constexpr (ALIGN_EPI) { if (wr == 0) PG8_BAR; }
        if constexpr (!Epi::AFTER_DRAIN) { E(acc, cur, wr, wc, fr, fq); S.done(cur); }
        if (!has_next) break;
#pragma unroll
        for (int a = 0; a < 2; ++a)
#pragma unroll
            for (int b = 0; b < 2; ++b)
#pragma unroll
                for (int m = 0; m < 4; ++m)
#pragma unroll
                    for (int n = 0; n < 2; ++n) acc[a][b][m][n] = (f32x4){0.f, 0.f, 0.f, 0.f};
        cur = nxt; cA = nA; cB = nB; ++ui;
        if constexpr (ALIGN_EPI) { if (wr == 1) PG8_BAR; }
    }
    PG8_WAIT_V(0);
    if constexpr (!ALIGN_EPI) { if (wr == 0) PG8_BAR; }
    PG8_BAR;
    if constexpr (Epi::AFTER_DRAIN) { E.fused(acc, cur, wr, wc, fr, fq, lds, wid, lane); S.done(cur); }
#undef PG8_SA
#undef PG8_SB
#undef PG8_STAGE
#undef PG8_LDA
#undef PG8_LDB
#undef PG8_MMA
#undef PG8_WAIT_V
#undef PG8_WAIT_L
#undef PG8_BAR
#undef PG8_SCHED
}
}

#define LAS __attribute__((address_space(3)))
typedef unsigned short bf16_t;
typedef unsigned char uchar;
typedef short bf16x8 __attribute__((ext_vector_type(8)));
typedef float f32x4 __attribute__((ext_vector_type(4)));
typedef float f32x16 __attribute__((ext_vector_type(16)));
typedef unsigned u32x2 __attribute__((ext_vector_type(2)));
typedef unsigned u32x4 __attribute__((ext_vector_type(4)));

constexpr int TL = 32768, TC = 4096, TT = 36864;
constexpr size_t MiB = 1u << 20;
constexpr size_t OFF_ROPE = 64 * 1024, OFF_MOD = 128 * 1024;
constexpr size_t OFF_WB = 1 * MiB;
constexpr size_t WB_W1 = 0, WB_WO = (size_t)2304 * 1024 * 2, WB_F1 = WB_WO + (size_t)1024 * 1024 * 2, WB_F2 = WB_F1 + (size_t)4096 * 1024 * 2, WB_LAYER = WB_F2 + (size_t)4096 * 1024 * 2;
constexpr size_t OFF_DFTL = 46 * MiB, OFF_DFTC = 62 * MiB, OFF_XC = 63 * MiB, OFF_H = 79 * MiB, OFF_M1 = 79 * MiB, OFF_M2 = 115 * MiB;
constexpr size_t OFF_GTL = 151 * MiB, OFF_GTC = 183 * MiB, OFF_Q = 187 * MiB, OFF_K = 223 * MiB, OFF_VTL = 232 * MiB, OFF_VTC = 240 * MiB, OFF_DQKV = 241 * MiB,
                 OFF_DZ = 295 * MiB, OFF_GB = 313 * MiB, OFF_O0T = 316 * MiB, OFF_S0T = 352 * MiB, OFF_ST = 388 * MiB, OFF_CAT = 424 * MiB, OFF_U = 151 * MiB, WS_END = 496 * MiB,
                 OFF_PART2 = 151 * MiB  ,
                 OFF_PARTF = 440 * MiB  ;
static_assert(OFF_WB + 2 * WB_LAYER <= OFF_DFTL, "ws map");
constexpr int LDS_BYTES = 163840, LDS_MISC = 155648;

struct Params { const float* in[18]; float* out; unsigned char* ws; };

typedef float f32x2_t __attribute__((ext_vector_type(2))); typedef __bf16 bf16x2_t __attribute__((ext_vector_type(2)));
__device__ __forceinline__ unsigned pk(float lo, float hi) { f32x2_t v = {lo, hi}; bf16x2_t b = __builtin_convertvector(v, bf16x2_t); return __builtin_bit_cast(unsigned, b); }
__device__ __forceinline__ bf16_t f2bf(float x) { return (bf16_t)(pk(x, 0.f) & 0xffffu); }
__device__ __forceinline__ float bf2f(unsigned h) { return __uint_as_float(h << 16); }
__device__ __forceinline__ float bflo(unsigned w) { return __uint_as_float(w << 16); }
__device__ __forceinline__ float bfhi(unsigned w) { return __uint_as_float(w & 0xffff0000u); }
__device__ __forceinline__ float silu_f(float x) { return x * __builtin_amdgcn_rcpf(1.f + __expf(-x)); }
template <int M> __device__ __forceinline__ float sxor(float v) {
    static_assert(M >= 1 && M <= 16, "sxor: mask 1..16");
    return __int_as_float(__builtin_amdgcn_ds_swizzle(__float_as_int(v), (M << 10) | 0x1f));
}
__device__ __forceinline__ float sum32(float v) { auto r = __builtin_amdgcn_permlane32_swap(__float_as_uint(v), __float_as_uint(v), false, false); return __uint_as_float(r[0]) + __uint_as_float(r[1]); }
__device__ __forceinline__ float max32(float v) { auto r = __builtin_amdgcn_permlane32_swap(__float_as_uint(v), __float_as_uint(v), false, false); return fmaxf(__uint_as_float(r[0]), __uint_as_float(r[1])); }
__device__ __forceinline__ float wave_sum(float v) {
    v += sxor<1>(v); v += sxor<2>(v); v += sxor<4>(v); v += sxor<8>(v); v += sxor<16>(v); return sum32(v);
}
__device__ __forceinline__ f32x4 mfma16(bf16x8 a, bf16x8 b, f32x4 c) { return __builtin_amdgcn_mfma_f32_16x16x32_bf16(a, b, c, 0, 0, 0); }
__device__ __forceinline__ f32x16 mfma32(bf16x8 a, bf16x8 b, f32x16 c) { return __builtin_amdgcn_mfma_f32_32x32x16_bf16(a, b, c, 0, 0, 0); }

struct EpiProj {
    static constexpr bool PERM = false, AFTER_DRAIN = false;
    unsigned char* ws; const float *qg, *kg;
    __device__ __forceinline__ void operator()(const f32x4 (&acc)[2][2][4][2], const pg8::Unit& u, int wr, int wc, int fr, int fq) const {
        asm volatile("" : "+v"(fr), "+v"(fq));
        bf16_t* const GTl = (bf16_t*)(ws + OFF_GTL); bf16_t* const GTc = (bf16_t*)(ws + OFF_GTC); bf16_t* const Qb = (bf16_t*)(ws + OFF_Q); bf16_t* const Kb = (bf16_t*)(ws + OFF_K);
        bf16_t* const VTl = (bf16_t*)(ws + OFF_VTL); bf16_t* const VTc = (bf16_t*)(ws + OFF_VTC); bf16_t* const DQKV = (bf16_t*)(ws + OFF_DQKV); bf16_t* const DZ = (bf16_t*)(ws + OFF_DZ);
        const float2* const rope = (const float2*)(ws + OFF_ROPE);
        const int pn = u.pn, rowt = u.pm * 256;
        const bool ctx = rowt >= TL;
        const int b = ctx ? (rowt - TL) >> 8 : rowt >> 11;
        const int s0 = ctx ? 0 : (rowt & 2047);
        const int Ls = ctx ? 256 : 2048;
        if (pn < 2) {
            bf16_t* G = (ctx ? GTc : GTl);
#pragma unroll
            for (int ai = 0; ai < 2; ++ai)
#pragma unroll
                for (int m = 0; m < 4; ++m) {
                    const int s = s0 + ai * 128 + wr * 64 + m * 16 + fr;
#pragma unroll
                    for (int bj = 0; bj < 2; ++bj)
#pragma unroll
                        for (int n = 0; n < 2; ++n)
#pragma unroll
                            for (int j = 0; j < 4; ++j) {
                                const int c = bj * 128 + wc * 32 + n * 16 + fq * 4 + j;
                                G[((size_t)((b * 256 + c) * 2 + pn)) * Ls + s] = f2bf(acc[ai][bj][m][n][j]);
                            }
                }
        } else if (pn < 5) {
            const bool isv = (pn == 4) && (wc >= 2);
            if (isv) {
                const int kvh = wc - 2; bf16_t* V = ctx ? VTc : VTl;
#pragma unroll
                for (int ai = 0; ai < 2; ++ai)
#pragma unroll
                    for (int m = 0; m < 4; ++m) {
                        const int s = s0 + ai * 128 + wr * 64 + m * 16 + fr;
#pragma unroll
                        for (int bj = 0; bj < 2; ++bj)
#pragma unroll
                            for (int n = 0; n < 2; ++n)
#pragma unroll
                                for (int j = 0; j < 4; ++j) {
                                    const int d = bj * 32 + n * 16 + fq * 4 + j;
                                    V[((size_t)((b * 2 + kvh) * 64 + d)) * Ls + s] = f2bf(acc[ai][bj][m][n][j]);
                                }
                    }
            } else {
                const bool isq = pn < 4;
                const float* gw = isq ? qg : kg;
                const float osc = isq ? 0.125f : 1.0f;
                f32x4 gv[2][2];
#pragma unroll
                for (int bj = 0; bj < 2; ++bj)
#pragma unroll
                    for (int n = 0; n < 2; ++n) gv[bj][n] = *(const f32x4*)(gw + bj * 32 + n * 16 + fq * 4);
#pragma unroll
                for (int ai = 0; ai < 2; ++ai)
#pragma unroll
                    for (int m = 0; m < 4; ++m) {
                        const int rl = ai * 128 + wr * 64 + m * 16 + fr;
                        const int s = s0 + rl; const size_t row = (size_t)rowt + rl;
                        float ss = 0.f;
#pragma unroll
                        for (int bj = 0; bj < 2; ++bj)
#pragma unroll
                            for (int n = 0; n < 2; ++n) { const f32x4 v = acc[ai][bj][m][n]; ss += (v[0] * v[0] + v[1] * v[1]) + (v[2] * v[2] + v[3] * v[3]); }
                        ss += sxor<16>(ss); ss = sum32(ss);
                        const float rinv = rsqrtf(ss * (1.f / 64.f) + 1e-6f);
                        bf16_t* dst = isq ? (Qb + row * 512 + ((pn - 2) * 4 + wc) * 64) : (Kb + row * 128 + wc * 64);
#pragma unroll
                        for (int bj = 0; bj < 2; ++bj) {
                            f32x4 x0 = acc[ai][bj][m][0] * rinv * gv[bj][0], x1 = acc[ai][bj][m][1] * rinv * gv[bj][1];
                            if (!ctx) {
                                const int pos = bj == 0 ? (s >> 6) : (s & 63);
                                const float2* rp = rope + pos * 16 + fq * 4;
                                f32x4 o0, o1;
#pragma unroll
                                for (int j = 0; j < 4; ++j) { const float2 cs = rp[j]; o0[j] = x0[j] * cs.x - x1[j] * cs.y; o1[j] = x1[j] * cs.x + x0[j] * cs.y; }
                                x0 = o0; x1 = o1;
                            }
                            x0 = x0 * osc; x1 = x1 * osc;
                            u32x2 w0, w1; w0.x = pk(x0[0], x0[1]); w0.y = pk(x0[2], x0[3]); w1.x = pk(x1[0], x1[1]); w1.y = pk(x1[2], x1[3]);
                            *(u32x2*)(dst + bj * 32 + fq * 4) = w0; *(u32x2*)(dst + bj * 32 + 16 + fq * 4) = w1;
                        }
                    }
            }
        } else {
            bf16_t* O = pn < 8 ? DQKV : DZ; const int ldo = pn < 8 ? 768 : 256; const int cb = pn < 8 ? (pn - 5) * 256 : 0;
#pragma unroll
            for (int ai = 0; ai < 2; ++ai)
#pragma unroll
                for (int m = 0; m < 4; ++m) {
                    bf16_t* rowp = O + ((size_t)rowt + ai * 128 + wr * 64 + m * 16 + fr) * ldo + cb + wc * 32 + fq * 4;
#pragma unroll
                    for (int bj = 0; bj < 2; ++bj)
#pragma unroll
                        for (int n = 0; n < 2; ++n) { const f32x4 v = acc[ai][bj][m][n]; u32x2 w; w.x = pk(v[0], v[1]); w.y = pk(v[2], v[3]); *(u32x2*)(rowp + bj * 128 + n * 16) = w; }
                }
        }
    }
};

struct EpiResid {
    static constexpr bool PERM = false, AFTER_DRAIN = false;
    const float* srcl; float* dstl; const float* srcc; float* dstc; const float* gate;
    __device__ __forceinline__ void operator()(const f32x4 (&acc)[2][2][4][2], const pg8::Unit& u, int wr, int wc, int fr, int fq) const {
        const int rowt = u.pm * 256; const bool ctx = rowt >= TL;
        const int bb = ctx ? 16 : rowt >> 11;
        const float* src = ctx ? srcc + (size_t)(rowt - TL) * 1024 : srcl + (size_t)rowt * 1024;
        float* dst = ctx ? dstc + (size_t)(rowt - TL) * 1024 : dstl + (size_t)rowt * 1024;
        const int col0 = u.pn * 256 + wc * 32 + fq * 4;
        f32x4 gv[2][2];
#pragma unroll
        for (int bj = 0; bj < 2; ++bj)
#pragma unroll
            for (int n = 0; n < 2; ++n) gv[bj][n] = *(const f32x4*)(gate + bb * 6144 + col0 + bj * 128 + n * 16);
#pragma unroll
        for (int ai = 0; ai < 2; ++ai)
#pragma unroll
            for (int m = 0; m < 4; ++m) {
                const size_t off = (size_t)(ai * 128 + wr * 64 + m * 16 + fr) * 1024 + col0;
#pragma unroll
                for (int bj = 0; bj < 2; ++bj)
#pragma unroll
                    for (int n = 0; n < 2; ++n) { const f32x4 sv = *(const f32x4*)(src + off + bj * 128 + n * 16); *(f32x4*)(dst + off + bj * 128 + n * 16) = sv + gv[bj][n] * acc[ai][bj][m][n]; }
            }
    }
};

struct EpiRelu2 {
    static constexpr bool PERM = false, AFTER_DRAIN = false;
    bf16_t* U;
    __device__ __forceinline__ void operator()(const f32x4 (&acc)[2][2][4][2], const pg8::Unit& u, int wr, int wc, int fr, int fq) const {
        const int col0 = u.pn * 256 + wc * 32 + fq * 4;
#pragma unroll
        for (int ai = 0; ai < 2; ++ai)
#pragma unroll
            for (int m = 0; m < 4; ++m) {
                bf16_t* rowp = U + ((size_t)u.pm * 256 + ai * 128 + wr * 64 + m * 16 + fr) * 4096 + col0;
#pragma unroll
                for (int bj = 0; bj < 2; ++bj)
#pragma unroll
                    for (int n = 0; n < 2; ++n) { f32x4 v = acc[ai][bj][m][n];
#pragma unroll
                        for (int j = 0; j < 4; ++j) { const float t = fmaxf(v[j], 0.f); v[j] = t * t; }
                        u32x2 w; w.x = pk(v[0], v[1]); w.y = pk(v[2], v[3]); *(u32x2*)(rowp + bj * 128 + n * 16) = w; }
            }
    }
};

struct EpiFourier {
    static constexpr bool PERM = false, AFTER_DRAIN = false;
    bf16_t* CAT; int rowbase, Ls;
    __device__ __forceinline__ void operator()(const f32x4 (&acc)[2][2][4][2], const pg8::Unit& u, int wr, int wc, int fr, int fq) const {
        const int b = u.pn;
#pragma unroll
        for (int ai = 0; ai < 2; ++ai)
#pragma unroll
            for (int m = 0; m < 4; ++m) {
                const int k1 = u.pm * 256 + ai * 128 + wr * 64 + m * 16 + fr;
                bf16_t* rowp = CAT + ((size_t)rowbase + (size_t)b * Ls + k1) * 1024 + wc * 32 + fq * 4;
#pragma unroll
                for (int bj = 0; bj < 2; ++bj)
#pragma unroll
                    for (int n = 0; n < 2; ++n) { const f32x4 v = acc[ai][bj][m][n]; u32x2 w; w.x = pk(v[0], v[1]); w.y = pk(v[2], v[3]); *(u32x2*)(rowp + bj * 128 + n * 16) = w; }
            }
    }
};

struct EpiSplit {
    static constexpr bool PERM = false, AFTER_DRAIN = false;
    const float* src; float* dst; const float* gate;
    __device__ __forceinline__ void operator()(const f32x4 (&acc)[2][2][4][2], const pg8::Unit& u, int wr, int wc, int fr, int fq) const {
        const int col0 = u.pn * 256 + wc * 32 + fq * 4;
        f32x4 gv[2][2];
#pragma unroll
        for (int bj = 0; bj < 2; ++bj)
#pragma unroll
            for (int n = 0; n < 2; ++n) gv[bj][n] = *(const f32x4*)(gate + col0 + bj * 128 + n * 16);
#pragma unroll
        for (int ai = 0; ai < 2; ++ai)
#pragma unroll
            for (int m = 0; m < 4; ++m) {
                const size_t off = ((size_t)u.pm * 256 + ai * 128 + wr * 64 + m * 16 + fr) * 1024 + col0;
#pragma unroll
                for (int bj = 0; bj < 2; ++bj)
#pragma unroll
                    for (int n = 0; n < 2; ++n) { f32x4 o = gv[bj][n] * acc[ai][bj][m][n]; if (src) o += *(const f32x4*)(src + off + bj * 128 + n * 16); *(f32x4*)(dst + off + bj * 128 + n * 16) = o; }
            }
    }
};
struct OrderL1 {
    pg8::StaticOrder so; int G, c;
    __device__ void init(int G_, int c_) { so.init(TL, 2304, G_, c_); G = G_; c = c_; }
    __device__ bool next(int i, pg8::Unit& u) const {
        if (so.next(i, u)) return true;
        const long Lx = (long)i * G + c - so.nwg; if (Lx < 0 || Lx >= 64) return false;
        u.pm = 128 + (int)(Lx >> 2); u.pn = 4 + (int)(Lx & 3); return true;
    }
    __device__ __forceinline__ void a_ready(const pg8::Unit&) const {}
    __device__ __forceinline__ void done(const pg8::Unit&) const {}
};

struct RevOrder {
    pg8::StaticOrder so; int nM;
    __device__ void init(int M, int N, int G_, int c_) { so.init(M, N, G_, c_); nM = M / 256; }
    __device__ bool next(int i, pg8::Unit& u) const { if (!so.next(i, u)) return false; u.pm = nM - 1 - u.pm; return true; }
    __device__ __forceinline__ void a_ready(const pg8::Unit&) const {}
    __device__ __forceinline__ void done(const pg8::Unit&) const {}
};

__device__ __forceinline__ void tr_item(const float* Wsrc, int ld, bf16_t* dst, int K, LAS float* scr, int lane) {
#pragma unroll 8
    for (int i = 0; i < 32; ++i) { const int kk = 2 * i + (lane >> 5); scr[kk * 33 + (lane & 31)] = Wsrc[(size_t)kk * ld + (lane & 31)]; }
    asm volatile("s_waitcnt lgkmcnt(0)" ::: "memory");
    const int c = lane & 7;
#pragma unroll
    for (int j = 0; j < 4; ++j) { const int n = (lane >> 3) + 8 * j; const LAS float* s = scr + (8 * c) * 33 + n;
        u32x4 o; o.x = pk(s[0 * 33], s[1 * 33]); o.y = pk(s[2 * 33], s[3 * 33]); o.z = pk(s[4 * 33], s[5 * 33]); o.w = pk(s[6 * 33], s[7 * 33]);
        *(u32x4*)(dst + (size_t)n * K + 8 * c) = o; }
    asm volatile("s_waitcnt lgkmcnt(0)" ::: "memory");
}
__device__ __forceinline__ int w1_orig_col(int n0) {
    const int tile = n0 >> 8, c = n0 & 255, bj = c >> 7, wc = (c & 127) >> 5;
    if (tile < 4) return 256 + (tile - 2) * 256 + 64 * wc + 32 * bj;
    if (tile == 4) return wc < 2 ? 768 + 64 * wc + 32 * bj : 896 + 64 * (wc - 2) + 32 * bj;
    if (tile < 8) return 1024 + (tile - 5) * 256 + c;
    return 1792 + c;
}

typedef const __attribute__((address_space(4))) Params CParamsP;
__device__ __forceinline__ void phase_prologue(CParamsP* pp, LAS uchar* L, int tid, int lane, int wave) {
    uchar* ws = pp->ws;
    LAS float* trig = (LAS float*)(L + LDS_MISC);
    if (tid < 64) { float s, c; sincospif((float)tid / 32.f, &s, &c); trig[tid] = c; trig[64 + tid] = s; }
    if (blockIdx.x < 192) {
        const int item = blockIdx.x;
        LAS float* sc = (LAS float*)L;
        LAS float* red = (LAS float*)(L + 17 * 1024 * 4);
        const float* c = pp->in[1]; const float* cctx = pp->in[3];
        for (int i = tid; i < 17 * 1024; i += 512) { const int bb = i >> 10, k = i & 1023; const float v = bb < 16 ? c[bb * 1024 + k] : cctx[k]; sc[i] = silu_f(v); }
        __syncthreads();
        const int l = item / 96, cb = item % 96, n = cb * 64 + lane;
        const float* W = pp->in[6] + (size_t)l * 1024 * 6144;
        float acc[17];
#pragma unroll
        for (int bb = 0; bb < 17; ++bb) acc[bb] = 0.f;
#pragma unroll 4
        for (int kk = 0; kk < 128; ++kk) { const int k = wave * 128 + kk; const float wv = W[(size_t)k * 6144 + n];
#pragma unroll
            for (int bb = 0; bb < 17; ++bb) acc[bb] += sc[bb * 1024 + k] * wv; }
#pragma unroll
        for (int bb = 0; bb < 17; ++bb) red[(wave * 17 + bb) * 64 + lane] = acc[bb];
        __syncthreads();
        float* mod = (float*)(ws + OFF_MOD);
        const float* bm = pp->in[7];
        for (int i = tid; i < 17 * 64; i += 512) { const int bb = i >> 6, ln = i & 63; float s = 0.f;
#pragma unroll
            for (int w = 0; w < 8; ++w) s += red[(w * 17 + bb) * 64 + ln];
            const int nn = cb * 64 + ln; mod[(size_t)(l * 17 + bb) * 6144 + nn] = s + bm[l * 6144 + nn]; }
    }
    __syncthreads();
    LAS float* scr = (LAS float*)(L + wave * 16384);
    const int gw = blockIdx.x * 8 + wave, NGW = gridDim.x * 8;
    constexpr int I_W1 = 56 * 16, I_WO = 32 * 16, I_F1 = 128 * 16, I_F2 = 32 * 64, I_FO = 4 * 16 * 8, I_LAYER = I_W1 + I_WO + I_F1 + I_F2 + I_FO;
    for (int it = gw; it < 2 * I_LAYER; it += NGW) {
        const int l = it / I_LAYER; int r = it % I_LAYER;
        uchar* wb = ws + OFF_WB + (size_t)l * WB_LAYER;
        const float* w_in = pp->in[8] + (size_t)l * 1024 * 2064;
        if (r < I_W1) { const int nb = 16 + r / 16, kb = r % 16; const int n0 = nb * 32, k0 = kb * 64;
            tr_item(w_in + (size_t)k0 * 2064 + w1_orig_col(n0), 2064, (bf16_t*)(wb + WB_W1) + (size_t)n0 * 1024 + k0, 1024, scr, lane); continue; }
        r -= I_W1;
        if (r < I_WO) { const int nb = r / 16, kb = r % 16; const int n0 = nb * 32, k0 = kb * 64;
            tr_item(pp->in[15] + (size_t)l * 1024 * 1024 + (size_t)k0 * 1024 + n0, 1024, (bf16_t*)(wb + WB_WO) + (size_t)n0 * 1024 + k0, 1024, scr, lane); continue; }
        r -= I_WO;
        if (r < I_F1) { const int nb = r / 16, kb = r % 16; const int n0 = nb * 32, k0 = kb * 64;
            tr_item(pp->in[16] + (size_t)l * 1024 * 4096 + (size_t)k0 * 4096 + n0, 4096, (bf16_t*)(wb + WB_F1) + (size_t)n0 * 1024 + k0, 1024, scr, lane); continue; }
        r -= I_F1;
        if (r < I_F2) { const int nb = r / 64, kb = r % 64; const int n0 = nb * 32, k0 = kb * 64;
            tr_item(pp->in[17] + (size_t)l * 4096 * 1024 + (size_t)k0 * 1024 + n0, 1024, (bf16_t*)(wb + WB_F2) + (size_t)n0 * 4096 + k0, 4096, scr, lane); continue; }
        r -= I_F2;
        {
            const int g = r >> 7, kb = (r >> 3) & 15, k2b = r & 7; const int k = kb * 64 + lane;
            const f32x4* src = (const f32x4*)(w_in + (size_t)k * 2064 + g * 64);
            float ac[8], as[8];
#pragma unroll
            for (int j = 0; j < 8; ++j) { ac[j] = 0.f; as[j] = 0.f; }
            for (int n4 = 0; n4 < 16; ++n4) { const f32x4 v = src[n4];
#pragma unroll
                for (int e = 0; e < 4; ++e) { const int n2 = n4 * 4 + e;
#pragma unroll
                    for (int j = 0; j < 8; ++j) { const int idx = ((k2b * 8 + j) * n2) & 63; ac[j] += v[e] * trig[idx]; as[j] += v[e] * trig[64 + idx]; } } }
            bf16_t* W1 = (bf16_t*)(wb + WB_W1);
#pragma unroll
            for (int j = 0; j < 8; ++j) { const int k2 = k2b * 8 + j; W1[(size_t)(g * 64 + k2) * 1024 + k] = f2bf(ac[j]); W1[(size_t)(256 + g * 64 + k2) * 1024 + k] = f2bf(as[j]); }
        }
    }
    {
        const size_t gt = (size_t)blockIdx.x * 512 + tid, NT = (size_t)gridDim.x * 512;
        bf16_t* AL = (bf16_t*)(ws + OFF_DFTL);
        const float nl = 0.00276213586f;
        for (size_t it = gt; it < (size_t)2048 * 512; it += NT) { const int k1 = (int)(it >> 9), cg_ = (int)(it & 511), cs = cg_ >> 8, n0 = (cg_ & 255) * 8;
            float v[8];
#pragma unroll
            for (int e = 0; e < 8; ++e) { const int m = (k1 * (n0 + e)) & 2047; float s, c; sincospif((float)m * (1.f / 1024.f), &s, &c); v[e] = (cs ? -s : c) * nl; }
            u32x4 o; o.x = pk(v[0], v[1]); o.y = pk(v[2], v[3]); o.z = pk(v[4], v[5]); o.w = pk(v[6], v[7]);
            *(u32x4*)(AL + (size_t)k1 * 4096 + cs * 2048 + n0) = o; }
        bf16_t* AC = (bf16_t*)(ws + OFF_DFTC);
        const float nc = 1.f / 128.f;
        for (size_t it = gt; it < (size_t)256 * 64; it += NT) { const int k1 = (int)(it >> 6), cg_ = (int)(it & 63), cs = cg_ >> 5, n0 = (cg_ & 31) * 8;
            float v[8];
#pragma unroll
            for (int e = 0; e < 8; ++e) { const int m = (k1 * (n0 + e)) & 255; float s, c; sincospif((float)m * (1.f / 128.f), &s, &c); v[e] = (cs ? -s : c) * nc; }
            u32x4 o; o.x = pk(v[0], v[1]); o.y = pk(v[2], v[3]); o.z = pk(v[4], v[5]); o.w = pk(v[6], v[7]);
            *(u32x4*)(AC + (size_t)k1 * 512 + cs * 256 + n0) = o; }
        for (size_t it = gt; it < (size_t)TC * 256; it += NT) ((f32x4*)(ws + OFF_XC))[it] = ((const f32x4*)pp->in[2])[it];
        if (blockIdx.x == 0) { float2* rope = (float2*)(ws + OFF_ROPE);
            for (int i = tid; i < 1024; i += 512) { const int pos = i >> 4, pp = i & 15; const float invf = powf(10000.f, -(float)pp * 2.0f / 32.f); const float ang = (float)pos * invf; rope[i] = make_float2(cosf(ang), sinf(ang)); } }
    }
}

template <bool GATES, bool PART>
__device__ __forceinline__ void phase_norm(const float* xl, const float* xc, int nrows, const float* ng, const float* modl, int shIdx, int scIdx, bf16_t* H,
                                           const float* w_in_l, const float* a_log_l, const float* dt_bias_l, float* GB, LAS uchar* L, int tid, int lane, int wave,
                                           const float* part = nullptr, float* xcw = nullptr) {
    LAS float* wgT = (LAS float*)L;
    if (GATES) { for (int i = tid; i < 16384; i += 512) { const int k = i >> 4, e = i & 15; wgT[e * 1024 + k] = w_in_l[(size_t)k * 2064 + 2048 + e]; } __syncthreads(); }
    const int NW = gridDim.x * 8, gw = blockIdx.x * 8 + wave;
    const int rpw = ((nrows + NW - 1) / NW + 1) & ~1;
    const int r0 = gw * rpw, r1 = min(nrows, r0 + rpw);
    f32x4 ga[4], gb[4]; int cur_bb = -1;
    for (int r = r0; r < r1; r += 2) {
        const int bb = r < TL ? r >> 11 : 16;
        if (bb != cur_bb) { cur_bb = bb;
            const float* scp = modl + (size_t)bb * 6144 + scIdx * 1024; const float* shp = modl + (size_t)bb * 6144 + shIdx * 1024;
#pragma unroll
            for (int j = 0; j < 4; ++j) { const f32x4 g = ((const f32x4*)ng)[lane + 64 * j], sc = ((const f32x4*)scp)[lane + 64 * j]; ga[j] = g * (sc + 1.f); gb[j] = ((const f32x4*)shp)[lane + 64 * j]; } }
        const float* xr = r < TL ? xl + (size_t)r * 1024 : xc + (size_t)(r - TL) * 1024;
        f32x4 v[2][4]; float ss0 = 0.f, ss1 = 0.f;
#pragma unroll
        for (int j = 0; j < 4; ++j) { v[0][j] = ((const f32x4*)xr)[lane + 64 * j]; v[1][j] = ((const f32x4*)(xr + 1024))[lane + 64 * j]; }
        if (PART && r >= TL) {
            const size_t po = (size_t)(r - TL) * 1024;
#pragma unroll
            for (int k = 0; k < 3; ++k)
#pragma unroll
                for (int j = 0; j < 4; ++j) { v[0][j] += ((const f32x4*)(part + (size_t)k * TC * 1024 + po))[lane + 64 * j]; v[1][j] += ((const f32x4*)(part + (size_t)k * TC * 1024 + po + 1024))[lane + 64 * j]; }
            if (xcw != nullptr) {
#pragma unroll
                for (int j = 0; j < 4; ++j) { ((f32x4*)(xcw + po))[lane + 64 * j] = v[0][j]; ((f32x4*)(xcw + po + 1024))[lane + 64 * j] = v[1][j]; } }
        }
#pragma unroll
        for (int j = 0; j < 4; ++j) { ss0 += (v[0][j][0] * v[0][j][0] + v[0][j][1] * v[0][j][1]) + (v[0][j][2] * v[0][j][2] + v[0][j][3] * v[0][j][3]);
                                      ss1 += (v[1][j][0] * v[1][j][0] + v[1][j][1] * v[1][j][1]) + (v[1][j][2] * v[1][j][2] + v[1][j][3] * v[1][j][3]); }
        ss0 = wave_sum(ss0); ss1 = wave_sum(ss1);
        const float rs0 = rsqrtf(ss0 * (1.f / 1024.f) + 1e-6f), rs1 = rsqrtf(ss1 * (1.f / 1024.f) + 1e-6f);
#pragma unroll
        for (int j = 0; j < 4; ++j) {
            v[0][j] = v[0][j] * rs0 * ga[j] + gb[j]; v[1][j] = v[1][j] * rs1 * ga[j] + gb[j];
            u32x2 w0, w1; w0.x = pk(v[0][j][0], v[0][j][1]); w0.y = pk(v[0][j][2], v[0][j][3]); w1.x = pk(v[1][j][0], v[1][j][1]); w1.y = pk(v[1][j][2], v[1][j][3]);
            *(u32x2*)(H + (size_t)r * 1024 + 4 * (lane + 64 * j)) = w0; *(u32x2*)(H + (size_t)(r + 1) * 1024 + 4 * (lane + 64 * j)) = w1; }
        if (GATES) {
            LAS float* wg = wgT; asm volatile("" : "+v"(wg));
            float a0[16], a1[16];
#pragma unroll
            for (int e = 0; e < 16; ++e) { float s0 = 0.f, s1 = 0.f;
#pragma unroll
                for (int j = 0; j < 4; ++j) { const f32x4 w = *(const LAS f32x4*)(wg + e * 1024 + 4 * (lane + 64 * j));
                    s0 += (v[0][j][0] * w[0] + v[0][j][1] * w[1]) + (v[0][j][2] * w[2] + v[0][j][3] * w[3]);
                    s1 += (v[1][j][0] * w[0] + v[1][j][1] * w[1]) + (v[1][j][2] * w[2] + v[1][j][3] * w[3]); }
                a0[e] = s0; a1[e] = s1; }
#define NRM_STEP(N, BIT, SRC0, SRC1, DST0, DST1) { const bool up = (lane >> BIT) & 1; _Pragma("unroll") for (int m = 0; m < N; ++m) { \
                const float k0 = up ? SRC0[2 * m + 1] : SRC0[2 * m], s0_ = up ? SRC0[2 * m] : SRC0[2 * m + 1]; const float k1 = up ? SRC1[2 * m + 1] : SRC1[2 * m], s1_ = up ? SRC1[2 * m] : SRC1[2 * m + 1]; \
                DST0[m] = k0 + sxor<(1 << BIT)>(s0_); DST1[m] = k1 + sxor<(1 << BIT)>(s1_); } }
            float b0[8], b1[8], c0[4], c1[4], d0[2], d1[2], e0[1], e1[1];
            NRM_STEP(8, 0, a0, a1, b0, b1) NRM_STEP(4, 1, b0, b1, c0, c1) NRM_STEP(2, 2, c0, c1, d0, d1) NRM_STEP(1, 3, d0, d1, e0, e1)
#undef NRM_STEP
            float m0 = e0[0], m1 = e1[0];
            m0 += sxor<16>(m0); m1 += sxor<16>(m1); m0 = sum32(m0); m1 = sum32(m1);
            if (lane < 32) { const int e = lane & 15; const float mine = lane < 16 ? m0 : m1; float o;
                if (e < 8) o = 1.f / (1.f + expf(-mine));
                else { const int dh = e - 8; const float xx = mine + dt_bias_l[dh]; const float sp = xx > 20.f ? xx : log1pf(expf(xx)); o = -expf(a_log_l[dh]) * sp; }
                GB[(size_t)(r + (lane >> 4)) * 16 + e] = o; }
        }
    }
}

__device__ __forceinline__ f32x4 mm16(const LAS uchar* X, int x0, const LAS uchar* Y, int y0, int lane) {
    const int r = lane & 15, q = lane >> 4;
    const LAS uchar* xp = X + (x0 + r) * 144 + q * 16; const LAS uchar* yp = Y + (y0 + r) * 144 + q * 16;
    const bf16x8 a0 = *(const LAS bf16x8*)xp, a1 = *(const LAS bf16x8*)(xp + 64), b0 = *(const LAS bf16x8*)yp, b1 = *(const LAS bf16x8*)(yp + 64);
    f32x4 acc = {0.f, 0.f, 0.f, 0.f};
    acc = mfma16(a0, b0, acc); acc = mfma16(a1, b1, acc);
    return acc;
}
__device__ __forceinline__ f32x4 mm16k32(const LAS uchar* X, int x0, int xk, const LAS uchar* Y, int y0, int yk, int lane) {
    const int r = lane & 15, q = lane >> 4;
    const bf16x8 a0 = *(const LAS bf16x8*)(X + (x0 + r) * 144 + xk * 2 + q * 16), b0 = *(const LAS bf16x8*)(Y + (y0 + r) * 144 + yk * 2 + q * 16);
    f32x4 acc = {0.f, 0.f, 0.f, 0.f};
    return mfma16(a0, b0, acc);
}
constexpr int GL_QH = 0, GL_KH = 9216, GL_VT = 18432, GL_KBT = 27648, GL_KTT = 36864, GL_T = 46080, GL_QKM = 55296, GL_UT = 64512, GL_WT = 73728, GL_A = 82944, GL_GAM = 100352, GL_BET = 100608, GL_AB = 100864, GL_CW = 110080;

struct GdnRaw { u32x4 raw[3][3]; float g, be; };
__device__ __forceinline__ void gdn_decode(int v, int& h, int& dir, int& b, int& cidx) { h = v & 3; const int c = v >> 2; dir = c / 576; const int rem = c % 576; b = rem / 36; cidx = rem % 36; }
__device__ __forceinline__ void gdn_load(GdnRaw& R, int v, const bf16_t* DQKV, const float* GB, int tid, int lane, int wave) {
    int h, dir, b, cidx; gdn_decode(v, h, dir, b, cidx);
    const bool isctx = cidx < 4; const int Ls = isctx ? 256 : 2048;
    const int chunk = isctx ? (dir ? 3 - cidx : cidx) : (dir ? 35 - cidx : cidx - 4);
    const int base = chunk * 64; const size_t row0 = isctx ? (size_t)TL + b * 256 : (size_t)b * 2048;
    const int i = tid >> 3, part = tid & 7; const int pos = base + (dir ? 63 - i : i);
#pragma unroll
    for (int which = 0; which < 3; ++which)
#pragma unroll
        for (int j = 0; j < 3; ++j) { const int pp = pos + j - 1;
            R.raw[which][j] = (pp >= 0 && pp < Ls) ? *(const u32x4*)(DQKV + (row0 + pp) * 768 + which * 256 + h * 64 + part * 8) : (u32x4){0u, 0u, 0u, 0u}; }
    if (wave == 0) { const int p0 = base + (dir ? 63 - lane : lane); const float* gb = GB + (row0 + p0) * 16; R.g = gb[8 + dir * 4 + h]; R.be = gb[dir * 4 + h]; }
}

__device__ __forceinline__ void phase_gdn_pre(uchar* ws, const float* conv_w_l, LAS uchar* L_in, int tid_in, int lane_in, int wave) {
    const bf16_t* DQKV = (const bf16_t*)(ws + OFF_DQKV); const float* GB = (const float*)(ws + OFF_GB);
    bf16_t* M1g = (bf16_t*)(ws + OFF_M1); bf16_t* M2g = (bf16_t*)(ws + OFF_M2); bf16_t* O0Tg = (bf16_t*)(ws + OFF_O0T); bf16_t* S0Tg = (bf16_t*)(ws + OFF_S0T);
    (void)lane_in;
    int cur_h = -1;
    GdnRaw cur, nxt;
    if ((int)blockIdx.x < 4608) gdn_load(cur, blockIdx.x, DQKV, GB, tid_in, tid_in & 63, wave);
    for (int v = blockIdx.x; v < 4608; v += gridDim.x) {
        int tid = tid_in; asm volatile("" : "+v"(tid)); const int lane = tid & 63;
        LAS uchar* L = L_in; asm volatile("" : "+v"(L));
        LAS float* gam = (LAS float*)(L + GL_GAM); LAS float* bet = (LAS float*)(L + GL_BET); LAS float* A = (LAS float*)(L + GL_A);
        int h, dir, b, cidx; gdn_decode(v, h, dir, b, cidx);
        const size_t slot = (size_t)((dir * 16 + b) * 4 + h) * 36 + cidx;
        if (h != cur_h) { cur_h = h;
            for (int i = tid; i < 576; i += 512) { const int wj = i >> 6, d = i & 63; ((LAS float*)(L + GL_CW))[i] = conv_w_l[(wj % 3) * 768 + (wj / 3) * 256 + h * 64 + d]; } }
        if (v + (int)gridDim.x < 4608) gdn_load(nxt, v + gridDim.x, DQKV, GB, tid, lane, wave); else nxt = cur;
        if (wave == 0) { float s = cur.g;
#pragma unroll
            for (int o = 1; o < 64; o <<= 1) { const float t = __shfl_up(s, o); if (lane >= o) s += t; }
            gam[lane] = s; bet[lane] = cur.be; }
        __syncthreads();
        {
            const int i = tid >> 3, part = tid & 7;
            const float gi = gam[i], bi = bet[i], g63 = gam[63];
            const float eg = __expf(gi), ek = __expf(g63 - gi);
#pragma unroll
            for (int which = 0; which < 3; ++which) {
                float y[8];
#pragma unroll
                for (int e = 0; e < 8; ++e) y[e] = 0.f;
#pragma unroll
                for (int j = 0; j < 3; ++j) { const u32x4 raw = cur.raw[which][j]; const LAS float* wp = (const LAS float*)(L + GL_CW) + (which * 3 + j) * 64 + part * 8; const f32x4 w0 = *(const LAS f32x4*)wp, w1 = *(const LAS f32x4*)(wp + 4);
                    y[0] += w0[0] * bflo(raw.x); y[1] += w0[1] * bfhi(raw.x); y[2] += w0[2] * bflo(raw.y); y[3] += w0[3] * bfhi(raw.y);
                    y[4] += w1[0] * bflo(raw.z); y[5] += w1[1] * bfhi(raw.z); y[6] += w1[2] * bflo(raw.w); y[7] += w1[3] * bfhi(raw.w); }
                float ss = 0.f;
#pragma unroll
                for (int e = 0; e < 8; ++e) { y[e] = silu_f(y[e]); ss += y[e] * y[e]; }
                if (which < 2) { ss += sxor<1>(ss); ss += sxor<2>(ss); ss += sxor<4>(ss); const float rn = rsqrtf(ss + 1e-6f) * (which == 0 ? 0.125f : 1.f);
#pragma unroll
                    for (int e = 0; e < 8; ++e) y[e] *= rn; }
                if (which < 2) { u32x4 o; o.x = pk(y[0], y[1]); o.y = pk(y[2], y[3]); o.z = pk(y[4], y[5]); o.w = pk(y[6], y[7]);
                    *(LAS u32x4*)(L + (which == 0 ? GL_QH : GL_KH) + i * 144 + part * 16) = o; }
                if (which == 1) {
#pragma unroll
                    for (int e = 0; e < 8; ++e) { const int d = part * 8 + e; *(LAS bf16_t*)(L + GL_KBT + d * 144 + i * 2) = f2bf(bi * eg * y[e]); *(LAS bf16_t*)(L + GL_KTT + d * 144 + i * 2) = f2bf(ek * y[e]); } }
                if (which == 2) {
#pragma unroll
                    for (int e = 0; e < 8; ++e) { const int d = part * 8 + e; *(LAS bf16_t*)(L + GL_VT + d * 144 + i * 2) = f2bf(bi * y[e]); } }
            }
        }
        __syncthreads();
        {
#pragma unroll
            for (int tt = 0; tt < 2; ++tt) { const int tile = 2 * wave + tt, ti = tile >> 2, tj = tile & 3;
                const f32x4 kk = mm16(L + GL_KH, ti * 16, L + GL_KH, tj * 16, lane);
                const f32x4 qk = mm16(L + GL_QH, ti * 16, L + GL_KH, tj * 16, lane);
                const int j = tj * 16 + (lane & 15); const float gj = gam[j];
#pragma unroll
                for (int idx = 0; idx < 4; ++idx) { const int i = ti * 16 + 4 * (lane >> 4) + idx; const float gi = gam[i], bi = bet[i]; const float dec = __expf(fminf(gi - gj, 0.f));
                    const float av = (i > j) ? bi * kk[idx] * dec : 0.f;
                    *(LAS bf16_t*)(L + GL_AB + i * 144 + j * 2) = f2bf(av);
                    *(LAS bf16_t*)(L + GL_QKM + i * 144 + j * 2) = f2bf((i >= j) ? qk[idx] * dec : 0.f); } }
        }
        __syncthreads();
        if (wave == 0) {
            float t[32]; int c = lane & 31; const int half = lane >> 5, r0 = 32 * half; asm volatile("" : "+v"(c));
            const LAS uchar* ABp = L + GL_AB + r0 * 144 + r0 * 2;
            const unsigned oh = 1u << c;
            u32x4 buf[2][8];
#define SUB_LOAD(G, B) { const LAS uchar* pg_ = ABp; asm volatile("" : "+v"(pg_) : "v"(tdep)); _Pragma("unroll") for (int rr = 0; rr < 2; ++rr) { _Pragma("unroll") for (int j8 = 0; j8 < (2 * (G) + rr + 7) / 8; ++j8) buf[B][rr * 4 + j8] = *(const LAS u32x4*)(pg_ + (2 * (G) + rr) * 144 + j8 * 16); } }
            float tdep = 0.f;
            SUB_LOAD(0, 0) SUB_LOAD(1, 1)
#pragma unroll
            for (int g = 0; g < 16; ++g) {
#pragma unroll
                for (int rr = 0; rr < 2; ++rr) { const int i = 2 * g + rr; float s0 = (float)((oh >> i) & 1u), s1 = 0.f;
#pragma unroll
                    for (int j8 = 0; j8 < (i + 7) / 8; ++j8) { const u32x4 w = buf[g & 1][rr * 4 + j8];
#pragma unroll
                        for (int e = 0; e < 8; ++e) { const int j = 8 * j8 + e;
                            if (j < i) { if (e & 1) s1 -= bfhi(w[e >> 1]) * t[j]; else s0 -= bflo(w[e >> 1]) * t[j]; } } }
                    t[i] = s0 + s1; }
                tdep = t[2 * g + 1];
                if (g + 2 < 16) SUB_LOAD(g + 2, g & 1)
            }
#undef SUB_LOAD
#pragma unroll
            for (int i = 0; i < 32; ++i) *(LAS bf16_t*)(L + GL_T + (r0 + i) * 144 + (r0 + c) * 2) = f2bf(t[i]);
            if (half == 0) {
#pragma unroll
                for (int i = 0; i < 32; ++i) *(LAS bf16_t*)(L + GL_T + i * 144 + (32 + c) * 2) = (bf16_t)0;
#pragma unroll
                for (int j8 = 0; j8 < 4; ++j8) { u32x4 o; o.x = pk(t[8 * j8], t[8 * j8 + 1]); o.y = pk(t[8 * j8 + 2], t[8 * j8 + 3]); o.z = pk(t[8 * j8 + 4], t[8 * j8 + 5]); o.w = pk(t[8 * j8 + 6], t[8 * j8 + 7]);
                    *(LAS u32x4*)(L + GL_UT + c * 144 + j8 * 16) = o; }
            }
        }
        __syncthreads();
        if (wave < 4) {
            const int tm = wave >> 1, tc = wave & 1;
            const f32x4 acc = mm16k32(L + GL_AB, 32 + 16 * tm, 0, L + GL_UT, 16 * tc, 0, lane);
            const int cc = 16 * tc + (lane & 15), m0 = 16 * tm + 4 * (lane >> 4);
            u32x2 w; w.x = pk(acc[0], acc[1]); w.y = pk(acc[2], acc[3]);
            *(LAS u32x2*)(L + GL_WT + cc * 144 + m0 * 2) = w;
        }
        __syncthreads();
        if (wave < 4) {
            const int ti = wave >> 1, tc = wave & 1;
            const f32x4 acc = mm16k32(L + GL_T, 32 + 16 * ti, 32, L + GL_WT, 16 * tc, 0, lane);
            const int cc = 16 * tc + (lane & 15), i0 = 32 + 16 * ti + 4 * (lane >> 4);
#pragma unroll
            for (int idx = 0; idx < 4; ++idx) *(LAS bf16_t*)(L + GL_T + (i0 + idx) * 144 + cc * 2) = f2bf(-acc[idx]);
        }
        __syncthreads();
        {
#pragma unroll
            for (int tt = 0; tt < 4; ++tt) { const int tile = 4 * wave + tt, mat = tile >> 4, t16 = tile & 15, ti = t16 >> 2, te = t16 & 3;
                const f32x4 acc = mm16(L + GL_T, ti * 16, L + (mat ? GL_KBT : GL_VT), te * 16, lane);
                const int y = te * 16 + (lane & 15), i0 = ti * 16 + 4 * (lane >> 4);
                u32x2 w; w.x = pk(acc[0], acc[1]); w.y = pk(acc[2], acc[3]);
                *(LAS u32x2*)(L + (mat ? GL_WT : GL_UT) + y * 144 + i0 * 2) = w; }
        }
        __syncthreads();
        {
            const int mi = wave >> 1;
            const LAS uchar* X = L + (mi == 1 ? GL_UT : (mi == 3 ? GL_KTT : GL_WT));
            const LAS uchar* Y = L + ((mi == 0 || mi == 1) ? GL_QKM : (mi == 2 ? GL_KTT : GL_UT));
            const float a63 = __expf(gam[63]);
#pragma unroll
            for (int tt = 0; tt < 8; ++tt) { const int t16 = (wave & 1) * 8 + tt, tx = t16 >> 2, ty = t16 & 3;
                const f32x4 acc = mm16(X, tx * 16, Y, ty * 16, lane);
                const int y = ty * 16 + (lane & 15), x0 = tx * 16 + 4 * (lane >> 4);
                if (mi == 0) {
                    const u32x2 qq = *(const LAS u32x2*)(L + GL_QH + y * 144 + x0 * 2); const float eg = __expf(gam[y]);
                    u32x2 w; w.x = pk(bflo(qq.x) * eg - acc[0], bfhi(qq.x) * eg - acc[1]); w.y = pk(bflo(qq.y) * eg - acc[2], bfhi(qq.y) * eg - acc[3]);
                    const int ir = dir ? 63 - y : y; *(u32x2*)(M1g + slot * 4096 + ir * 64 + x0) = w;
                } else if (mi == 1) {
                    u32x2 w; w.x = pk(acc[0], acc[1]); w.y = pk(acc[2], acc[3]);
                    const int ir = dir ? 63 - y : y; *(u32x2*)(O0Tg + slot * 4096 + ir * 64 + x0) = w;
                } else if (mi == 2) {
                    u32x2 w; w.x = pk((y == x0 ? a63 : 0.f) - acc[0], (y == x0 + 1 ? a63 : 0.f) - acc[1]); w.y = pk((y == x0 + 2 ? a63 : 0.f) - acc[2], (y == x0 + 3 ? a63 : 0.f) - acc[3]);
                    *(u32x2*)(M2g + slot * 4096 + y * 64 + x0) = w;
                } else {
                    u32x2 w; w.x = pk(acc[0], acc[1]); w.y = pk(acc[2], acc[3]); *(u32x2*)(S0Tg + slot * 4096 + y * 64 + x0) = w;
                }
            }
        }
        __syncthreads();
        cur = nxt;
    }
}


struct Frag2 { bf16x8 a0, a1; };
__device__ __forceinline__ Frag2 ldfrag(const LAS uchar* M, int row0, int lane) { const LAS uchar* p = M + (row0 + (lane & 15)) * 144 + (lane >> 4) * 16; Frag2 f; f.a0 = *(const LAS bf16x8*)p; f.a1 = *(const LAS bf16x8*)(p + 64); return f; }
__device__ __forceinline__ f32x4 mmf(const Frag2& x, const Frag2& y) { f32x4 acc = {0.f, 0.f, 0.f, 0.f}; acc = mfma16(x.a0, y.a0, acc); return mfma16(x.a1, y.a1, acc); }
constexpr int G2_QH = 0, G2_KH = 9216  , G2_VT = 18432, G2_KBT = 27648, G2_KTT = 36864, G2_QKM = 46080, G2_AB = 55296  , G2_WT = 64512  ,
              G2_GAM = 73728, G2_BET = 73984, G2_CW = 74240, G2_HALF = 76544;
static_assert(2 * G2_HALF <= LDS_MISC, "gdn2 LDS map");
struct GdnRaw2 { u32x4 raw[2][3][3]; float g, be; };
__device__ __forceinline__ void gdn_load2(GdnRaw2& R, int v, const bf16_t* DQKV, const float* GB, int t2, int lane, int wl) {
    int h, dir, b, cidx; gdn_decode(v, h, dir, b, cidx);
    const bool isctx = cidx < 4; const int Ls = isctx ? 256 : 2048;
    const int chunk = isctx ? (dir ? 3 - cidx : cidx) : (dir ? 35 - cidx : cidx - 4);
    const int base = chunk * 64; const size_t row0 = isctx ? (size_t)TL + b * 256 : (size_t)b * 2048;
    const int i = t2 >> 2, part = t2 & 3; const int pos = base + (dir ? 63 - i : i);
#pragma unroll
    for (int p2 = 0; p2 < 2; ++p2)
#pragma unroll
        for (int which = 0; which < 3; ++which)
#pragma unroll
            for (int j = 0; j < 3; ++j) { const int pp = pos + j - 1;
                R.raw[p2][which][j] = (pp >= 0 && pp < Ls) ? *(const u32x4*)(DQKV + (row0 + pp) * 768 + which * 256 + h * 64 + part * 16 + p2 * 8) : (u32x4){0u, 0u, 0u, 0u}; }
    if (wl == 0) { const int p0 = base + (dir ? 63 - lane : lane); const float* gb = GB + (row0 + p0) * 16; R.g = gb[8 + dir * 4 + h]; R.be = gb[dir * 4 + h]; }
}

__device__ __forceinline__ void phase_gdn_pre2(uchar* ws, const float* conv_w_l, LAS uchar* L_in, int tid_in, int wave) {
    const bf16_t* DQKV = (const bf16_t*)(ws + OFF_DQKV); const float* GB = (const float*)(ws + OFF_GB);
    bf16_t* M1g = (bf16_t*)(ws + OFF_M1); bf16_t* M2g = (bf16_t*)(ws + OFF_M2); bf16_t* O0g = (bf16_t*)(ws + OFF_O0T); bf16_t* S0Tg = (bf16_t*)(ws + OFF_S0T);
    const int half = wave >> 2, wl = wave & 3, G = gridDim.x, bid = blockIdx.x;
    int cur_h = -1;
    GdnRaw2 cur, nxt;
    { const int v0 = bid + half * G; if (v0 < 4608) gdn_load2(cur, v0, DQKV, GB, tid_in & 255, tid_in & 63, wl); }
    for (int it = 0; bid + 2 * it * G < 4608; ++it) {
        int tid = tid_in; asm volatile("" : "+v"(tid)); const int lane = tid & 63, t2 = tid & 255;
        LAS uchar* L = L_in + half * G2_HALF; asm volatile("" : "+v"(L));
        LAS float* gam = (LAS float*)(L + G2_GAM); LAS float* bet = (LAS float*)(L + G2_BET);
        const int v = bid + (2 * it + half) * G; const bool act = v < 4608;
        int h = 0, dir = 0, b = 0, cidx = 0; if (act) gdn_decode(v, h, dir, b, cidx);
        const size_t slot = (size_t)((dir * 16 + b) * 4 + h) * 36 + cidx;
        if (act && h != cur_h) { cur_h = h;
            for (int i = t2; i < 576; i += 256) { const int wj = i >> 6, d = i & 63; ((LAS float*)(L + G2_CW))[i] = conv_w_l[(wj % 3) * 768 + (wj / 3) * 256 + h * 64 + d]; } }
        { const int vn = v + 2 * G; if (vn < 4608) gdn_load2(nxt, vn, DQKV, GB, t2, lane, wl); else nxt = cur; }
        if (act && wl == 0) { float s = cur.g;
#pragma unroll
            for (int o = 1; o < 64; o <<= 1) { const float t = __shfl_up(s, o); if (lane >= o) s += t; }
            gam[lane] = s; bet[lane] = cur.be; }
        __syncthreads();
        if (act) {
            const int i = t2 >> 2, part = t2 & 3;
            const float gi = gam[i], bi = bet[i], g63 = gam[63];
            const float eg = __expf(gi), ek = __expf(g63 - gi);
#pragma unroll
            for (int which = 0; which < 3; ++which) {
                float y[16]; float ss = 0.f;
#pragma unroll
                for (int p2 = 0; p2 < 2; ++p2) {
#pragma unroll
                    for (int e = 0; e < 8; ++e) y[p2 * 8 + e] = 0.f;
#pragma unroll
                    for (int j = 0; j < 3; ++j) { const u32x4 raw = cur.raw[p2][which][j]; const LAS float* wp = (const LAS float*)(L + G2_CW) + (which * 3 + j) * 64 + part * 16 + p2 * 8; const f32x4 w0 = *(const LAS f32x4*)wp, w1 = *(const LAS f32x4*)(wp + 4);
                        y[p2 * 8 + 0] += w0[0] * bflo(raw.x); y[p2 * 8 + 1] += w0[1] * bfhi(raw.x); y[p2 * 8 + 2] += w0[2] * bflo(raw.y); y[p2 * 8 + 3] += w0[3] * bfhi(raw.y);
                        y[p2 * 8 + 4] += w1[0] * bflo(raw.z); y[p2 * 8 + 5] += w1[1] * bfhi(raw.z); y[p2 * 8 + 6] += w1[2] * bflo(raw.w); y[p2 * 8 + 7] += w1[3] * bfhi(raw.w); }
                }
#pragma unroll
                for (int e = 0; e < 16; ++e) { y[e] = silu_f(y[e]); ss += y[e] * y[e]; }
                if (which < 2) { ss += sxor<1>(ss); ss += sxor<2>(ss); const float rn = rsqrtf(ss + 1e-6f) * (which == 0 ? 0.125f : 1.f);
#pragma unroll
                    for (int e = 0; e < 16; ++e) y[e] *= rn;
#pragma unroll
                    for (int p2 = 0; p2 < 2; ++p2) { u32x4 o; o.x = pk(y[p2 * 8], y[p2 * 8 + 1]); o.y = pk(y[p2 * 8 + 2], y[p2 * 8 + 3]); o.z = pk(y[p2 * 8 + 4], y[p2 * 8 + 5]); o.w = pk(y[p2 * 8 + 6], y[p2 * 8 + 7]);
                        *(LAS u32x4*)(L + (which == 0 ? G2_QH : G2_KH) + i * 144 + part * 32 + p2 * 16) = o; } }
                if (which == 1) {
#pragma unroll
                    for (int e = 0; e < 16; ++e) { const int d = part * 16 + e; *(LAS bf16_t*)(L + G2_KBT + d * 144 + i * 2) = f2bf(bi * eg * y[e]); *(LAS bf16_t*)(L + G2_KTT + d * 144 + i * 2) = f2bf(ek * y[e]); } }
                if (which == 2) {
#pragma unroll
                    for (int e = 0; e < 16; ++e) { const int d = part * 16 + e; *(LAS bf16_t*)(L + G2_VT + d * 144 + i * 2) = f2bf(bi * y[e]); } }
            }
        }
        __syncthreads();
        if (act) {
            const int ti = wl;
            const Frag2 kx = ldfrag(L + G2_KH, ti * 16, lane), qx = ldfrag(L + G2_QH, ti * 16, lane);
            Frag2 ky[4];
#pragma unroll
            for (int tj = 0; tj < 4; ++tj) ky[tj] = ldfrag(L + G2_KH, tj * 16, lane);
#pragma unroll
            for (int tj = 0; tj < 4; ++tj) {
                const f32x4 kk = mmf(kx, ky[tj]);
                const f32x4 qk = mmf(qx, ky[tj]);
                const int j = tj * 16 + (lane & 15); const float gj = gam[j];
#pragma unroll
                for (int idx = 0; idx < 4; ++idx) { const int i = ti * 16 + 4 * (lane >> 4) + idx; const float gi = gam[i], bi = bet[i]; const float dec = __expf(fminf(gi - gj, 0.f));
                    *(LAS bf16_t*)(L + G2_AB + i * 144 + j * 2) = f2bf((i > j) ? bi * kk[idx] * dec : 0.f);
                    *(LAS bf16_t*)(L + G2_QKM + i * 144 + j * 2) = f2bf((i >= j) ? qk[idx] * dec : 0.f); } }
        }
        __syncthreads();
        if (act && wl == half) {
            float t[32]; int c = lane & 31; const int hf = lane >> 5, r0 = 32 * hf; asm volatile("" : "+v"(c));
            const LAS uchar* ABp = L + G2_AB + r0 * 144 + r0 * 2;
            const unsigned oh = 1u << c;
            u32x4 buf[2][8];
#define SUB_LOAD(G_, B_) { const LAS uchar* pg_ = ABp; asm volatile("" : "+v"(pg_) : "v"(tdep)); _Pragma("unroll") for (int rr = 0; rr < 2; ++rr) { _Pragma("unroll") for (int j8 = 0; j8 < (2 * (G_) + rr + 7) / 8; ++j8) buf[B_][rr * 4 + j8] = *(const LAS u32x4*)(pg_ + (2 * (G_) + rr) * 144 + j8 * 16); } }
            float tdep = 0.f;
            SUB_LOAD(0, 0) SUB_LOAD(1, 1)
#pragma unroll
            for (int g = 0; g < 16; ++g) {
#pragma unroll
                for (int rr = 0; rr < 2; ++rr) { const int i = 2 * g + rr; float s0 = (float)((oh >> i) & 1u), s1 = 0.f;
#pragma unroll
                    for (int j8 = 0; j8 < (i + 7) / 8; ++j8) { const u32x4 w = buf[g & 1][rr * 4 + j8];
#pragma unroll
                        for (int e = 0; e < 8; ++e) { const int j = 8 * j8 + e;
                            if (j < i) { if (e & 1) s1 -= bfhi(w[e >> 1]) * t[j]; else s0 -= bflo(w[e >> 1]) * t[j]; } } }
                    t[i] = s0 + s1; }
                tdep = t[2 * g + 1];
                if (g + 2 < 16) SUB_LOAD(g + 2, g & 1)
            }
#undef SUB_LOAD
#pragma unroll
            for (int i = 0; i < 32; ++i) *(LAS bf16_t*)(L + G2_KH + (r0 + i) * 144 + (r0 + c) * 2) = f2bf(t[i]);
            if (hf == 0) {
#pragma unroll
                for (int i = 0; i < 32; ++i) *(LAS bf16_t*)(L + G2_KH + i * 144 + (32 + c) * 2) = (bf16_t)0;
#pragma unroll
                for (int j8 = 0; j8 < 4; ++j8) { u32x4 o; o.x = pk(t[8 * j8], t[8 * j8 + 1]); o.y = pk(t[8 * j8 + 2], t[8 * j8 + 3]); o.z = pk(t[8 * j8 + 4], t[8 * j8 + 5]); o.w = pk(t[8 * j8 + 6], t[8 * j8 + 7]);
                    *(LAS u32x4*)(L + G2_WT + c * 144 + j8 * 16) = o; }
            }
        }
        __syncthreads();
        if (act) {
            const int tm = wl >> 1, tc = wl & 1;
            const f32x4 acc = mm16k32(L + G2_AB, 32 + 16 * tm, 0, L + G2_WT, 16 * tc, 0, lane);
            const int cc = 16 * tc + (lane & 15), m0 = 16 * tm + 4 * (lane >> 4);
            u32x2 w; w.x = pk(acc[0], acc[1]); w.y = pk(acc[2], acc[3]);
            *(LAS u32x2*)(L + G2_WT + (32 + cc) * 144 + m0 * 2) = w;
        }
        __syncthreads();
        if (act) {
            const int ti = wl >> 1, tc = wl & 1;
            const f32x4 acc = mm16k32(L + G2_KH, 32 + 16 * ti, 32, L + G2_WT, 32 + 16 * tc, 0, lane);
            const int cc = 16 * tc + (lane & 15), i0 = 32 + 16 * ti + 4 * (lane >> 4);
#pragma unroll
            for (int idx = 0; idx < 4; ++idx) *(LAS bf16_t*)(L + G2_KH + (i0 + idx) * 144 + cc * 2) = f2bf(-acc[idx]);
        }
        __syncthreads();
        if (act) {
            const int ti = wl;
            const Frag2 tfr = ldfrag(L + G2_KH, ti * 16, lane);
            Frag2 yv[8];
#pragma unroll
            for (int tt = 0; tt < 8; ++tt) yv[tt] = ldfrag(L + ((tt >> 2) ? G2_KBT : G2_VT), (tt & 3) * 16, lane);
#pragma unroll
            for (int tt = 0; tt < 8; ++tt) { const int mat = tt >> 2, te = tt & 3;
                const f32x4 acc = mmf(tfr, yv[tt]);
                const int y = te * 16 + (lane & 15), i0 = ti * 16 + 4 * (lane >> 4);
                u32x2 w; w.x = pk(acc[0], acc[1]); w.y = pk(acc[2], acc[3]);
                *(LAS u32x2*)(L + (mat ? G2_WT : G2_AB) + y * 144 + i0 * 2) = w; }
        }
        __syncthreads();
        if (act) {
            const int mi = wl;
            const LAS uchar* X = L + (mi == 1 ? G2_AB : (mi == 3 ? G2_KTT : G2_WT));
            const LAS uchar* Y = L + ((mi == 0 || mi == 1) ? G2_QKM : (mi == 2 ? G2_KTT : G2_AB));
            const float a63 = __expf(gam[63]);
            Frag2 xf[4], yf[4];
#pragma unroll
            for (int a = 0; a < 4; ++a) { xf[a] = ldfrag(X, a * 16, lane); yf[a] = ldfrag(Y, a * 16, lane); }
#pragma unroll
            for (int tt = 0; tt < 16; ++tt) { const int tx = tt >> 2, ty = tt & 3;
                const f32x4 acc = mmf(xf[tx], yf[ty]);
                const int y = ty * 16 + (lane & 15), x0 = tx * 16 + 4 * (lane >> 4);
                if (mi == 0) {
                    const u32x2 qq = *(const LAS u32x2*)(L + G2_QH + y * 144 + x0 * 2); const float eg = __expf(gam[y]);
                    u32x2 w; w.x = pk(bflo(qq.x) * eg - acc[0], bfhi(qq.x) * eg - acc[1]); w.y = pk(bflo(qq.y) * eg - acc[2], bfhi(qq.y) * eg - acc[3]);
                    const int ir = dir ? 63 - y : y; *(u32x2*)(M1g + slot * 4096 + ir * 64 + x0) = w;
                } else if (mi == 1) {
                    u32x2 w; w.x = pk(acc[0], acc[1]); w.y = pk(acc[2], acc[3]);
                    const int ir = dir ? 63 - y : y; *(u32x2*)(O0g + slot * 4096 + ir * 64 + x0) = w;
                } else if (mi == 2) {
                    u32x2 w; w.x = pk((y == x0 ? a63 : 0.f) - acc[0], (y == x0 + 1 ? a63 : 0.f) - acc[1]); w.y = pk((y == x0 + 2 ? a63 : 0.f) - acc[2], (y == x0 + 3 ? a63 : 0.f) - acc[3]);
                    *(u32x2*)(M2g + slot * 4096 + y * 64 + x0) = w;
                } else {
                    u32x2 w; w.x = pk(acc[0], acc[1]); w.y = pk(acc[2], acc[3]); *(u32x2*)(S0Tg + slot * 4096 + y * 64 + x0) = w;
                }
            }
        }
        __syncthreads();
        cur = nxt;
    }
}

struct ScanIn { u32x2 m[16]; u32x2 c[4]; };
__device__ __forceinline__ void scan_load(ScanIn& in, const bf16_t* M2g, const bf16_t* S0Tg, size_t so, int e, int r, int q) {
#pragma unroll
    for (int t = 0; t < 4; ++t) { in.c[t] = *(const u32x2*)(S0Tg + so + e * 64 + 16 * t + 4 * q);
        const bf16_t* mrow = M2g + so + (16 * t + r) * 64 + 4 * q;
        in.m[4 * t + 0] = *(const u32x2*)(mrow); in.m[4 * t + 1] = *(const u32x2*)(mrow + 16); in.m[4 * t + 2] = *(const u32x2*)(mrow + 32); in.m[4 * t + 3] = *(const u32x2*)(mrow + 48); }
}
__device__ __forceinline__ void phase_scan(uchar* ws, int lane, int wave) {
    const int first = gridDim.x >> 1, nsb = gridDim.x - first;
    if ((int)blockIdx.x < first || wave >= 4) return;
    const bf16_t* M2g = (const bf16_t*)(ws + OFF_M2); const bf16_t* S0Tg = (const bf16_t*)(ws + OFF_S0T); bf16_t* STg = (bf16_t*)(ws + OFF_ST);
    const int r = lane & 15, q = lane >> 4;
    for (int item = ((int)blockIdx.x - first) * 4 + wave; item < 512; item += nsb * 4) {
        const int chain = item >> 2, e = (item & 3) * 16 + r;
        f32x4 S[4];
#pragma unroll
        for (int t = 0; t < 4; ++t) S[t] = (f32x4){0.f, 0.f, 0.f, 0.f};
        ScanIn in0, in1, in2;
        const size_t cb0 = (size_t)chain * 36 * 4096;
        scan_load(in0, M2g, S0Tg, cb0, e, r, q); scan_load(in1, M2g, S0Tg, cb0 + 4096, e, r, q); scan_load(in2, M2g, S0Tg, cb0 + 2 * 4096, e, r, q);
#define SCAN_STEP(IN, n_) do { const size_t so = cb0 + (size_t)(n_) * 4096; \
            u32x4 y0, y1; \
            y0.x = pk(S[0][0], S[0][1]); y0.y = pk(S[0][2], S[0][3]); y0.z = pk(S[1][0], S[1][1]); y0.w = pk(S[1][2], S[1][3]); \
            y1.x = pk(S[2][0], S[2][1]); y1.y = pk(S[2][2], S[2][3]); y1.z = pk(S[3][0], S[3][1]); y1.w = pk(S[3][2], S[3][3]); \
            *(u32x2*)(STg + so + e * 64 + 4 * q) = (u32x2){y0.x, y0.y}; *(u32x2*)(STg + so + e * 64 + 16 + 4 * q) = (u32x2){y0.z, y0.w}; \
            *(u32x2*)(STg + so + e * 64 + 32 + 4 * q) = (u32x2){y1.x, y1.y}; *(u32x2*)(STg + so + e * 64 + 48 + 4 * q) = (u32x2){y1.z, y1.w}; \
            const bf16x8 yb0 = __builtin_bit_cast(bf16x8, y0), yb1 = __builtin_bit_cast(bf16x8, y1); \
            _Pragma("unroll") for (int t = 0; t < 4; ++t) { const u32x2 c = IN.c[t]; f32x4 C = {bflo(c.x), bfhi(c.x), bflo(c.y), bfhi(c.y)}; \
                const bf16x8 x0 = __builtin_bit_cast(bf16x8, (u32x4){IN.m[4 * t].x, IN.m[4 * t].y, IN.m[4 * t + 1].x, IN.m[4 * t + 1].y}); \
                const bf16x8 x1 = __builtin_bit_cast(bf16x8, (u32x4){IN.m[4 * t + 2].x, IN.m[4 * t + 2].y, IN.m[4 * t + 3].x, IN.m[4 * t + 3].y}); \
                C = mfma16(x0, yb0, C); C = mfma16(x1, yb1, C); S[t] = C; } \
            if ((n_) + 3 < 36) scan_load(IN, M2g, S0Tg, so + 3 * 4096, e, r, q); } while (0)
        for (int n = 0; n < 36; n += 3) { SCAN_STEP(in0, n); SCAN_STEP(in1, n + 1); SCAN_STEP(in2, n + 2); }
#undef SCAN_STEP
    }
}

__device__ __forceinline__ void phase_gdn_out(uchar* ws, const float* ong, bool need_ctx, int lane, int wave) {
    const bf16_t* M1g = (const bf16_t*)(ws + OFF_M1); const bf16_t* O0g = (const bf16_t*)(ws + OFF_O0T); const bf16_t* STg = (const bf16_t*)(ws + OFF_ST);
    const bf16_t* DZ = (const bf16_t*)(ws + OFF_DZ); bf16_t* CAT = (bf16_t*)(ws + OFF_CAT);
    const int r = lane & 15, q = lane >> 4, ti = wave & 3;
    for (int unit = blockIdx.x * 2 + (wave >> 2); unit < 2304; unit += gridDim.x * 2) {
        const int b = unit / 144, rem = unit % 144, h = rem / 36, cpos = rem % 36;
        const bool isctx = cpos < 4; if (isctx && !need_ctx) continue;
        const int cb = isctx ? 3 - cpos : 39 - cpos;
        const size_t sof = ((size_t)((0 * 16 + b) * 4 + h) * 36 + cpos) * 4096, sob = ((size_t)((16 + b) * 4 + h) * 36 + cb) * 4096;
        const int i = 16 * ti + r;
        f32x4 acc[4];
#pragma unroll
        for (int te = 0; te < 4; ++te) { const int e0 = te * 16 + 4 * q;
            const u32x2 cf = *(const u32x2*)(O0g + sof + i * 64 + e0), cbk = *(const u32x2*)(O0g + sob + i * 64 + e0);
            acc[te] = (f32x4){bflo(cf.x) + bflo(cbk.x), bfhi(cf.x) + bfhi(cbk.x), bflo(cf.y) + bflo(cbk.y), bfhi(cf.y) + bfhi(cbk.y)}; }
#pragma unroll
        for (int dn = 0; dn < 2; ++dn) { const size_t so = dn ? sob : sof;
#pragma unroll
            for (int ks = 0; ks < 2; ++ks) { const bf16x8 y = *(const bf16x8*)(M1g + so + i * 64 + 32 * ks + 8 * q);
#pragma unroll
                for (int te = 0; te < 4; ++te) { const bf16x8 x = *(const bf16x8*)(STg + so + (te * 16 + r) * 64 + 32 * ks + 8 * q); acc[te] = mfma16(x, y, acc[te]); } } }
        float ss = 0.f;
#pragma unroll
        for (int te = 0; te < 4; ++te) ss += (acc[te][0] * acc[te][0] + acc[te][1] * acc[te][1]) + (acc[te][2] * acc[te][2] + acc[te][3] * acc[te][3]);
        ss += sxor<16>(ss); ss = sum32(ss);
        const float rinv = rsqrtf(ss * (1.f / 64.f) + 1e-6f);
        const size_t tok = (isctx ? (size_t)TL + b * 256 + cpos * 64 : (size_t)b * 2048 + (cpos - 4) * 64) + i;
#pragma unroll
        for (int te = 0; te < 4; ++te) { const int e0 = te * 16 + 4 * q;
            const u32x2 dz = *(const u32x2*)(DZ + tok * 256 + h * 64 + e0); const f32x4 og = *(const f32x4*)(ong + e0);
            u32x2 w; w.x = pk(acc[te][0] * rinv * og[0] * silu_f(bflo(dz.x)), acc[te][1] * rinv * og[1] * silu_f(bfhi(dz.x)));
            w.y = pk(acc[te][2] * rinv * og[2] * silu_f(bflo(dz.y)), acc[te][3] * rinv * og[3] * silu_f(bfhi(dz.y)));
            *(u32x2*)(CAT + tok * 1024 + 768 + h * 64 + e0) = w; }
    }
}

constexpr int AL_K = 0, AL_V = 18432;
__device__ __forceinline__ void attn_unit(LAS uchar* L, const bf16_t* Qb, const bf16_t* Kb, const bf16_t* VTl, const bf16_t* VTc, bf16_t* CAT,
                                          int b, int head, size_t qrow0, bool lat, int tid, int lane, int wave) {
    const int kvh = head >> 2, ntile = lat ? 36 : 4;
    const int r32 = lane & 31, hi = lane >> 5;
    const size_t qrow = qrow0 + wave * 32 + r32;
    bf16x8 qf[4];
#pragma unroll
    for (int ks = 0; ks < 4; ++ks) qf[ks] = *(const bf16x8*)(Qb + qrow * 512 + head * 64 + 16 * ks + 8 * hi);
    f32x16 o0, o1;
#pragma unroll
    for (int i = 0; i < 16; ++i) { o0[i] = 0.f; o1[i] = 0.f; }
    float mrun = -INFINITY, lsum = 0.f;
    const int lrow = tid >> 3, lch = tid & 7;
    const float LOG2E = 1.4426950408889634f;
    const bf16_t* kl = Kb + ((size_t)b * 2048 + lrow) * 128 + kvh * 64 + 8 * lch;
    const bf16_t* kc = Kb + ((size_t)TL + b * 256 + lrow) * 128 + kvh * 64 + 8 * lch;
    const bf16_t* vl = VTl + ((size_t)(b * 2 + kvh) * 64 + lrow) * 2048 + 8 * lch;
    const bf16_t* vc = VTc + ((size_t)(b * 2 + kvh) * 64 + lrow) * 256 + 8 * lch;
    u32x4 kreg, vreg;
#define ATT_LOAD(t) do { const int t_ = (t); if (lat && t_ < 32) { kreg = *(const u32x4*)(kl + (size_t)t_ * 64 * 128); vreg = *(const u32x4*)(vl + t_ * 64); } \
        else { const int tc_ = lat ? t_ - 32 : t_; kreg = *(const u32x4*)(kc + (size_t)tc_ * 64 * 128); vreg = *(const u32x4*)(vc + tc_ * 64); } } while (0)
#define ATT_STORE(buf) do { *(LAS u32x4*)(L + AL_K + (buf) * 9216 + lrow * 144 + lch * 16) = kreg; *(LAS u32x2*)(L + AL_V + (buf) * 9216 + lrow * 136 + lch * 16) = (u32x2){vreg.x, vreg.y}; *(LAS u32x2*)(L + AL_V + (buf) * 9216 + lrow * 136 + lch * 16 + 8) = (u32x2){vreg.z, vreg.w}; } while (0)
    __syncthreads();
    ATT_LOAD(0); ATT_STORE(0);
    __syncthreads();
    for (int t = 0; t < ntile; ++t) {
        const int buf = t & 1;
        if (t + 1 < ntile) ATT_LOAD(t + 1);
        const LAS uchar* Kt = L + AL_K + buf * 9216; const LAS uchar* Vt = L + AL_V + buf * 9216;
        f32x16 s0, s1;
#pragma unroll
        for (int i = 0; i < 16; ++i) { s0[i] = 0.f; s1[i] = 0.f; }
#pragma unroll
        for (int ks = 0; ks < 4; ++ks) {
            const bf16x8 k0 = *(const LAS bf16x8*)(Kt + r32 * 144 + ks * 32 + hi * 16);
            const bf16x8 k1 = *(const LAS bf16x8*)(Kt + (32 + r32) * 144 + ks * 32 + hi * 16);
            s0 = mfma32(k0, qf[ks], s0); s1 = mfma32(k1, qf[ks], s1);
        }
        float mx = s0[0];
#pragma unroll
        for (int i = 1; i < 16; ++i) mx = fmaxf(mx, s0[i]);
#pragma unroll
        for (int i = 0; i < 16; ++i) mx = fmaxf(mx, s1[i]);
        mx = max32(mx);
        const float mnew = fmaxf(mrun, mx * LOG2E);
        const float alpha = __builtin_amdgcn_exp2f(mrun - mnew);
        mrun = mnew;
        float ps = 0.f;
#pragma unroll
        for (int i = 0; i < 16; ++i) { s0[i] = __builtin_amdgcn_exp2f(s0[i] * LOG2E - mnew); s1[i] = __builtin_amdgcn_exp2f(s1[i] * LOG2E - mnew); ps += s0[i] + s1[i]; }
        lsum = lsum * alpha + ps;
        if (__any(alpha != 1.f)) {
#pragma unroll
            for (int i = 0; i < 16; ++i) { o0[i] *= alpha; o1[i] *= alpha; } }
#pragma unroll
        for (int kk = 0; kk < 2; ++kk)
#pragma unroll
            for (int kst = 0; kst < 2; ++kst) {
                u32x4 pw;
                if (kk == 0) { pw.x = pk(s0[8 * kst + 0], s0[8 * kst + 1]); pw.y = pk(s0[8 * kst + 2], s0[8 * kst + 3]); pw.z = pk(s0[8 * kst + 4], s0[8 * kst + 5]); pw.w = pk(s0[8 * kst + 6], s0[8 * kst + 7]); }
                else         { pw.x = pk(s1[8 * kst + 0], s1[8 * kst + 1]); pw.y = pk(s1[8 * kst + 2], s1[8 * kst + 3]); pw.z = pk(s1[8 * kst + 4], s1[8 * kst + 5]); pw.w = pk(s1[8 * kst + 6], s1[8 * kst + 7]); }
                const bf16x8 pf = __builtin_bit_cast(bf16x8, pw);
                const int kof = (32 * kk + 16 * kst + 4 * hi) * 2;
                const u32x2 a0 = *(const LAS u32x2*)(Vt + r32 * 136 + kof), a1 = *(const LAS u32x2*)(Vt + r32 * 136 + kof + 16);
                const u32x2 c0 = *(const LAS u32x2*)(Vt + (32 + r32) * 136 + kof), c1 = *(const LAS u32x2*)(Vt + (32 + r32) * 136 + kof + 16);
                o0 = mfma32(__builtin_bit_cast(bf16x8, (u32x4){a0.x, a0.y, a1.x, a1.y}), pf, o0);
                o1 = mfma32(__builtin_bit_cast(bf16x8, (u32x4){c0.x, c0.y, c1.x, c1.y}), pf, o1);
            }
        if (t + 1 < ntile) ATT_STORE(buf ^ 1);
        __syncthreads();
    }
#undef ATT_LOAD
#undef ATT_STORE
    lsum = sum32(lsum);
    const float inv = __builtin_amdgcn_rcpf(lsum);
    bf16_t* dst = CAT + qrow * 1024 + 256 + head * 64 + 4 * hi;
#pragma unroll
    for (int g = 0; g < 4; ++g) {
        u32x2 w0, w1; w0.x = pk(o0[4 * g] * inv, o0[4 * g + 1] * inv); w0.y = pk(o0[4 * g + 2] * inv, o0[4 * g + 3] * inv);
        w1.x = pk(o1[4 * g] * inv, o1[4 * g + 1] * inv); w1.y = pk(o1[4 * g + 2] * inv, o1[4 * g + 3] * inv);
        *(u32x2*)(dst + 8 * g) = w0; *(u32x2*)(dst + 32 + 8 * g) = w1;
    }
}

__device__ __forceinline__ void phase_attn(uchar* ws, unsigned* counter, bool need_ctx, LAS uchar* L, int tid, int lane, int wave) {
    const bf16_t* Qb = (const bf16_t*)(ws + OFF_Q); const bf16_t* Kb = (const bf16_t*)(ws + OFF_K);
    const bf16_t* VTl = (const bf16_t*)(ws + OFF_VTL); const bf16_t* VTc = (const bf16_t*)(ws + OFF_VTC); bf16_t* CAT = (bf16_t*)(ws + OFF_CAT);
    const int nunits = 1024 + (need_ctx ? 128 : 0);
    volatile LAS int* ubox = (volatile LAS int*)(L + LDS_MISC + 1040);
    for (;;) {
        __syncthreads();
        if (tid == 0) *ubox = (int)atomicAdd(counter, 1u);
        __syncthreads();
        const int u = *ubox;
        if (u >= nunits) break;
        if (u < 1024) { const int b = u >> 6, head = (u >> 3) & 7, qb = u & 7; attn_unit(L, Qb, Kb, VTl, VTc, CAT, b, head, (size_t)b * 2048 + qb * 256, true, tid, lane, wave); }
        else { const int v = u - 1024, b = v >> 3, head = v & 7; attn_unit(L, Qb, Kb, VTl, VTc, CAT, b, head, (size_t)TL + b * 256, false, tid, lane, wave); }
    }
}

#define GAS __attribute__((address_space(1)))
typedef GAS unsigned gu32;
typedef GAS unsigned long long gu64;
#define RLX_AGENT __ATOMIC_RELAXED, __HIP_MEMORY_SCOPE_AGENT
#define LDS_WAIT() asm volatile("s_waitcnt lgkmcnt(0)" ::: "memory")
#define VM_WAIT() asm volatile("s_waitcnt vmcnt(0)" ::: "memory")
__device__ __forceinline__ unsigned long long rt() { return __builtin_amdgcn_s_memrealtime(); }
#define XB_TMO      128
#define XB_XCNT(j)  (256  + 64 * (j))
#define XB_XSUB(j)  (1280 + 64 * (j))
#define XB_XGEN(j)  (2304 + 64 * (j))
#define XB_TOP      3328
#define XB_TOPGEN   3392
#define XCD_BAR_WORDS 3456
#define XB_SPIN_CAP (1u << 18)

__device__ __forceinline__ unsigned xb_ld(unsigned* p)              { return __hip_atomic_load(p, __ATOMIC_RELAXED, __HIP_MEMORY_SCOPE_AGENT); }
__device__ __forceinline__ unsigned xb_add(unsigned* p, unsigned v) { return __hip_atomic_fetch_add(p, v, __ATOMIC_RELAXED, __HIP_MEMORY_SCOPE_AGENT); }
__device__ __forceinline__ unsigned xb_xcc_id() { return (unsigned)__builtin_amdgcn_s_getreg((3 << 11) | 20) & 0xFu; }
#define XB_SPIN(cond, bar) do { unsigned _sp = 0; while (cond) { __builtin_amdgcn_s_sleep(1); \
    if ((++_sp & 255u) == 0u) { if (xb_ld(&(bar)[XB_TMO])) break; if (_sp > XB_SPIN_CAP) { atomicAdd(&(bar)[XB_TMO], 1u); break; } } } } while (0)

struct XcdBarrier {
    unsigned* bar; unsigned x;
    volatile LAS unsigned* st;
};

__device__ __forceinline__ XcdBarrier xcd_barrier_post(unsigned* bar, volatile LAS unsigned* st, bool leader) {
    XcdBarrier b; b.bar = bar; b.x = xb_xcc_id(); b.st = st;
    if (leader) (void)xb_add(&bar[XB_XCNT(b.x)], 1u);
    return b;
}
__device__ __forceinline__ void xcd_barrier_complete(unsigned* bar, unsigned x, unsigned& nloc, unsigned& nx) {
    const unsigned G = gridDim.x * gridDim.y * gridDim.z;
    unsigned sum, cnt, mine, sp = 0u;
    for (;;) {
        sum = 0u; cnt = 0u; mine = 0u;
#pragma unroll
        for (unsigned j = 0; j < 16; ++j) { const unsigned c = xb_ld(&bar[XB_XCNT(j)]); sum += c; cnt += (c > 0u) ? 1u : 0u; mine = (j == x) ? c : mine; }
        if (sum == G) break;
        __builtin_amdgcn_s_sleep(1);
        if ((++sp & 255u) == 0u) { if (xb_ld(&bar[XB_TMO])) break; if (sp > XB_SPIN_CAP) { atomicAdd(&bar[XB_TMO], 1u); break; } }
    }
    nloc = mine > 0u ? mine : 1u; nx = cnt > 0u ? cnt : 1u;
}

__device__ __forceinline__ void xcd_barrier(const XcdBarrier& b, bool leader) {
    asm volatile("s_waitcnt vmcnt(0)" ::: "memory");
    __syncthreads();
    if (leader) {
        unsigned* bar = b.bar;
        __builtin_amdgcn_s_waitcnt(0);
        unsigned nloc = b.st[0], nx = b.st[1];
        if (nloc == 0u) { xcd_barrier_complete(bar, b.x, nloc, nx); b.st[0] = nloc; b.st[1] = nx; }
        const unsigned old = xb_add(&bar[XB_XSUB(b.x)], 1u);
        const unsigned gen = old / nloc;
        if (old + 1u == (gen + 1u) * nloc) {
            __builtin_amdgcn_fence(__ATOMIC_RELEASE, "agent");
            asm volatile("s_waitcnt vmcnt(0)" ::: "memory");
            const unsigned og = xb_add(&bar[XB_TOP], 1u);
            const unsigned tg = og / nx;
            if (og + 1u == (tg + 1u) * nx) xb_add(&bar[XB_TOPGEN], 1u);
            else XB_SPIN(xb_ld(&bar[XB_TOPGEN]) == tg, bar);
            __builtin_amdgcn_fence(__ATOMIC_ACQUIRE, "agent");
            xb_add(&bar[XB_XGEN(b.x)], 1u);
            asm volatile("s_waitcnt vmcnt(0)" ::: "memory");
        } else {
            XB_SPIN(xb_ld(&bar[XB_XGEN(b.x)]) == gen, bar);
            __builtin_amdgcn_fence(__ATOMIC_ACQUIRE, "agent");
            asm volatile("s_waitcnt vmcnt(0)" ::: "memory");
        }
    }
    __syncthreads();
}

#ifndef REP_PRE
#define REP_PRE 1
#endif
#ifndef REP_SCAN
#define REP_SCAN 1
#endif
#ifndef REP_ATTN
#define REP_ATTN 1
#endif
#ifndef REP_OUT
#define REP_OUT 1
#endif
#ifndef REP_NORM
#define REP_NORM 1
#endif
#ifndef REP_PRO
#define REP_PRO 1
#endif
#ifndef REP_G1
#define REP_G1 1
#endif
#ifndef REP_FOUR
#define REP_FOUR 1
#endif
#ifndef REP_F1
#define REP_F1 1
#endif
#ifndef REP_SYNC
#define REP_SYNC 1
#endif
typedef const __attribute__((address_space(4))) Params CParams;
#define PH_BEGIN { CParams* kp = (CParams*)__builtin_amdgcn_kernarg_segment_ptr(); int w0_ = wave0; unsigned on_ = ~0u; asm volatile("" : "+s"(w0_), "+s"(on_)); int tid = w0_ * 64 + (int)__builtin_amdgcn_mbcnt_hi(on_, __builtin_amdgcn_mbcnt_lo(on_, 0u)); LAS uchar* Lv = L; asm volatile("" : "+s"(kp), "+v"(tid), "+v"(Lv)); (void)Lv; \
    uchar* ws = kp->ws; const int lane = tid & 63, wave = __builtin_amdgcn_readfirstlane(tid >> 6); const int G = gridDim.x, bid = blockIdx.x; \
    const float* mod = (const float*)(ws + OFF_MOD); float* XC = (float*)(ws + OFF_XC); bf16_t* H = (bf16_t*)(ws + OFF_H); bf16_t* CAT = (bf16_t*)(ws + OFF_CAT); bf16_t* U = (bf16_t*)(ws + OFF_U); \
    const float* modl = mod + (size_t)l * 17 * 6144; uchar* wb = ws + OFF_WB + (size_t)l * WB_LAYER; float* OUT = kp->out; \
    (void)lane; (void)wave; (void)XC; (void)H; (void)CAT; (void)U; (void)modl; (void)wb; (void)G; (void)bid; (void)OUT;
#define PH_END }
#define GSYNC() do { CParams* kq_ = (CParams*)__builtin_amdgcn_kernarg_segment_ptr(); asm volatile("" : "+s"(kq_)); XcdBarrier xb_; xb_.bar = (unsigned*)(kq_->ws + 8192); xb_.x = xb_xcc_id(); \
    xb_.st = (volatile LAS unsigned*)(L + LDS_MISC + 1024); unsigned on2_ = ~0u; asm volatile("" : "+s"(on2_)); const bool ld_ = (wave0 == 0) && (__builtin_amdgcn_mbcnt_hi(on2_, __builtin_amdgcn_mbcnt_lo(on2_, 0u)) == 0u); for (int rs_ = 0; rs_ < REP_SYNC; ++rs_) xcd_barrier(xb_, ld_); } while (0)
#define IN(k) (kp->in[k])

__global__ void __launch_bounds__(512) mega(Params p) {
    extern __shared__ __attribute__((aligned(16))) unsigned char lds[];
    cg::grid_group grid = cg::this_grid();
    LAS uchar* L = (LAS uchar*)lds;
    const int wave0 = __builtin_amdgcn_readfirstlane(threadIdx.x >> 6);
    if (blockIdx.x == 0) { unsigned* bw = (unsigned*)(p.ws + 8192); for (int i = threadIdx.x; i < XCD_BAR_WORDS; i += 512) bw[i] = 0u; if (threadIdx.x < 128) ((unsigned*)(p.ws + 8192 + 16384))[threadIdx.x] = 0u; }
    if (threadIdx.x < 2) ((volatile LAS unsigned*)(L + LDS_MISC + 1024))[threadIdx.x] = 0u;
    if (blockIdx.x == 0) __threadfence();
    grid.sync();
    (void)xcd_barrier_post((unsigned*)(p.ws + 8192), (volatile LAS unsigned*)(L + LDS_MISC + 1024), threadIdx.x == 0);
    { const int l = 0;
    for (int rep_ = 0; rep_ < REP_PRO; ++rep_) { PH_BEGIN phase_prologue(kp, Lv, tid, lane, wave); PH_END __syncthreads(); }
    GSYNC();
    PH_BEGIN phase_norm<true, false>(IN(0), IN(2), TT, IN(4), mod, 0, 1, H, IN(8), IN(12), IN(13), (float*)(ws + OFF_GB), Lv, tid, lane, wave); PH_END
    GSYNC();
    }
#pragma unroll
    for (int l = 0; l < 2; ++l) {
        const bool last = (l == 1);
        const int Mrows = last ? TL : TT;
        PH_BEGIN {
            pg8::Gemm g{H, (const bf16_t*)(wb + WB_W1), TT, 2304, 1024, 1024};
            EpiProj E{ws, IN(10) + l * 64, IN(11) + l * 64};
            if (!last) { pg8::StaticOrder S; S.init(TT, 2304, G, bid); pg8::gemm_phase<EpiProj, pg8::StaticOrder, true, true>(L, g, S, E, tid); }
            else { OrderL1 S; S.init(G, bid); pg8::gemm_phase<EpiProj, OrderL1, true, true>(L, g, S, E, tid); }
        } PH_END
        GSYNC();
        for (int rep_ = 0; rep_ < REP_PRE; ++rep_) { PH_BEGIN phase_gdn_pre2(ws, IN(9) + (size_t)l * 3 * 768, Lv, tid, wave); PH_END if (rep_ + 1 < REP_PRE) GSYNC(); }
        GSYNC();
        for (int rep_ = 0; rep_ < REP_SCAN; ++rep_) { PH_BEGIN phase_scan(ws, lane, wave); PH_END __syncthreads(); }
        __syncthreads();
        PH_BEGIN {
            pg8::Gemm g{(const bf16_t*)(ws + OFF_DFTL), (const bf16_t*)(ws + OFF_GTL), 2048, 4096, 4096, 4096}; pg8::StaticOrder S; S.init(2048, 4096, G, bid);
            EpiFourier E{CAT, 0, 2048};
            for (int rep_ = 0; rep_ < REP_FOUR; ++rep_) { pg8::gemm_phase<EpiFourier, pg8::StaticOrder, true, true>(L, g, S, E, tid); __syncthreads(); }
        } PH_END
        if (!last) PH_BEGIN {
            __syncthreads();
            pg8::Gemm g{(const bf16_t*)(ws + OFF_DFTC), (const bf16_t*)(ws + OFF_GTC), 256, 4096, 512, 512}; pg8::StaticOrder S; S.init(256, 4096, G, bid);
            EpiFourier E{CAT, TL, 256};
            pg8::gemm_phase<EpiFourier, pg8::StaticOrder, true, true>(L, g, S, E, tid);
        } PH_END
        __syncthreads();
        for (int rep_ = 0; rep_ < REP_ATTN; ++rep_) { PH_BEGIN phase_attn(ws, (unsigned*)(ws + 8192 + 16384) + l * 64, !last, Lv, tid, lane, wave); PH_END __syncthreads(); }
        GSYNC();
        for (int rep_ = 0; rep_ < REP_OUT; ++rep_) { PH_BEGIN phase_gdn_out(ws, IN(14) + l * 64, !last, lane, wave); PH_END __syncthreads(); }
        GSYNC();
        PH_BEGIN {
            const bool split = false;
            pg8::Gemm g{CAT, (const bf16_t*)(wb + WB_WO), split ? TL : Mrows, 1024, 1024, 1024}; pg8::StaticOrder S; S.init(split ? TL : Mrows, 1024, G, bid);
            EpiResid E{last ? (const float*)OUT : IN(0), OUT, last ? (const float*)XC : IN(2), XC, modl + 2 * 1024};
            pg8::gemm_phase<EpiResid, pg8::StaticOrder, true, true>(L, g, S, E, tid);
            if (split) {
                __syncthreads();
                const int kq = bid >> 6;
                pg8::Gemm g2{CAT + (size_t)TL * 1024 + kq * 256, (const bf16_t*)(wb + WB_WO) + kq * 256, TC, 1024, 256, 1024}; pg8::StaticOrder S2; S2.init(TC, 1024, 64, bid & 63);
                EpiSplit E2{kq == 0 ? IN(2) : nullptr, kq == 0 ? XC : (float*)(ws + OFF_PART2) + (size_t)(kq - 1) * TC * 1024, modl + 2 * 1024 + 16 * 6144};
                pg8::gemm_phase<EpiSplit, pg8::StaticOrder, true, true>(L, g2, S2, E2, tid);
            }
        } PH_END
        GSYNC();
        for (int rep_ = 0; rep_ < REP_NORM; ++rep_) { PH_BEGIN if (false) phase_norm<false, true>(OUT, XC, Mrows, IN(5) + l * 1024, modl, 3, 4, H, nullptr, nullptr, nullptr, nullptr, Lv, tid, lane, wave, (const float*)(ws + OFF_PART2), XC); else phase_norm<false, false>(OUT, XC, Mrows, IN(5) + l * 1024, modl, 3, 4, H, nullptr, nullptr, nullptr, nullptr, Lv, tid, lane, wave); PH_END __syncthreads(); }
        GSYNC();
        PH_BEGIN {
            pg8::Gemm g{H, (const bf16_t*)(wb + WB_F1), Mrows, 4096, 1024, 1024}; pg8::StaticOrder S; S.init(Mrows, 4096, G, bid);
            EpiRelu2 E{U};
for (int rep_ = 0; rep_ < REP_F1; ++rep_) { pg8::gemm_phase<EpiRelu2, pg8::StaticOrder, true, true>(L, g, S, E, tid); __syncthreads(); }
        } PH_END
        GSYNC();
        PH_BEGIN {
            const bool split = false;
            pg8::Gemm g{U, (const bf16_t*)(wb + WB_F2), split ? TL : Mrows, 1024, 4096, 4096}; RevOrder S; S.init(split ? TL : Mrows, 1024, G, bid);
            EpiResid E{OUT, OUT, XC, XC, modl + 5 * 1024};
            pg8::gemm_phase<EpiResid, RevOrder, true, true>(L, g, S, E, tid);
            if (split) {
                __syncthreads();
                const int kq = bid >> 6;
                pg8::Gemm g2{U + (size_t)TL * 4096 + kq * 1024, (const bf16_t*)(wb + WB_F2) + kq * 1024, TC, 1024, 1024, 4096}; pg8::StaticOrder S2; S2.init(TC, 1024, 64, bid & 63);
                EpiSplit E2{kq == 0 ? (const float*)XC : nullptr, kq == 0 ? XC : (float*)(ws + OFF_PARTF) + (size_t)(kq - 1) * TC * 1024, modl + 5 * 1024 + 16 * 6144};
                pg8::gemm_phase<EpiSplit, pg8::StaticOrder, true, true>(L, g2, S2, E2, tid);
            }
        } PH_END
#if NAN_SCRUB
        if (last) {
            GSYNC();
            PH_BEGIN for (size_t i = (size_t)bid * 512 + tid; i < (size_t)TL * 1024; i += (size_t)G * 512) { float v = OUT[i]; if (!(fabsf(v) < 1e30f)) OUT[i] = 0.f; } PH_END
        }
#endif
        if (!last) {
            GSYNC();
            for (int rep_ = 0; rep_ < REP_NORM; ++rep_) { PH_BEGIN if (false) phase_norm<true, true>(OUT, XC, TT, IN(4) + 1024, mod + (size_t)17 * 6144, 0, 1, H, IN(8) + (size_t)1024 * 2064, IN(12) + 8, IN(13) + 8, (float*)(ws + OFF_GB), Lv, tid, lane, wave, (const float*)(ws + OFF_PARTF), nullptr); else phase_norm<true, false>(OUT, XC, TT, IN(4) + 1024, mod + (size_t)17 * 6144, 0, 1, H, IN(8) + (size_t)1024 * 2064, IN(12) + 8, IN(13) + 8, (float*)(ws + OFF_GB), Lv, tid, lane, wave); PH_END __syncthreads(); }
            GSYNC();
        }
    }
}

extern "C" void kernel_launch(void* const* d_in, const int* in_sizes, int n_in, void* d_out, int out_size, void* d_ws, size_t ws_size, hipStream_t stream) {
    static int grid = 0;
    if (!grid) {
        int dev = 0, cus = 0, per_cu = 0;
        (void)hipGetDevice(&dev);
        (void)hipDeviceGetAttribute(&cus, hipDeviceAttributeMultiprocessorCount, dev);
        (void)hipFuncSetAttribute((const void*)mega, hipFuncAttributeMaxDynamicSharedMemorySize, LDS_BYTES);
        (void)hipOccupancyMaxActiveBlocksPerMultiprocessor(&per_cu, (const void*)mega, 512, LDS_BYTES);
        if (per_cu < 1) per_cu = 1;
        grid = cus * per_cu;
        if (ws_size < WS_END) { fprintf(stderr, "kernel_launch: workspace too small: %zu < %zu\n", ws_size, (size_t)WS_END); grid = -1; }
    }
    if (grid < 0) return;
    Params p{};
    for (int i = 0; i < 18; ++i) p.in[i] = (const float*)d_in[i];
    p.out = (float*)d_out; p.ws = (unsigned char*)d_ws;
    void* args[] = {&p};
    hipError_t e = hipLaunchCooperativeKernel((const void*)mega, dim3(grid), dim3(512), args, LDS_BYTES, stream);
    if (e != hipSuccess) fprintf(stderr, "cooperative launch failed: %s (grid %d)\n", hipGetErrorString(e), grid);
}
```

```cpp
#include <hip/hip_runtime.h>
#include <hip/hip_cooperative_groups.h>
#include <cstdio>
#include <cstdint>
#include <cmath>
namespace cg = cooperative_groups;
#define NAN_SCRUB 0
#define DIAG 0
namespace pg8 {
#define PG8_LAS __attribute__((address_space(3)))
typedef unsigned short bf16_t;
typedef short bf16x8 __attribute__((ext_vector_type(8)));
typedef float f32x4 __attribute__((ext_vector_type(4)));
typedef unsigned u32x4 __attribute__((ext_vector_type(4)));
constexpr int BM = 256, BK = 64, HALF = 128, HTB = HALF * BK * 2  , STAGE_BYTES = 8 * HTB, NXCD = 8, WGM = 4;

__host__ __device__ __forceinline__ int lds_byte(int r, int c) { const int st = (r >> 4) * 2 + (c >> 5), rr = r & 15, cc = c & 31, ob = rr * 64 + cc * 2; return st * 1024 + (ob ^ (((ob >> 9) & 1) << 5)); }
__host__ __device__ __forceinline__ void stage_rc(int b, int& R, int& C) { const int st = b / 1024, sb = b % 1024, swz = sb ^ (((sb >> 9) & 1) << 5); R = (st >> 1) * 16 + swz / 64; C = (st & 1) * 32 + (swz % 64) / 2; }
__host__ __device__ __forceinline__ int perm32(int rho) { const int n = rho >> 4, i = rho & 15; return 8 * (i >> 2) + 4 * n + (i & 3); }

struct Unit { int pm, pn; };
struct Gemm { const bf16_t* A; const bf16_t* Bt; int M, N, K, ld; };

struct StaticOrder {
    int nM, nN, nwg, G, c;
    __host__ __device__ void init(int M, int N, int G_, int c_) { nM = M / BM; nN = N / BM; nwg = nM * nN; G = G_; c = c_; }
    __host__ __device__ bool next(int i, Unit& u) const {
        const long L = (long)i * G + c; if (L >= nwg) return false;
        int wgid = (int)L; { const int q = nwg / NXCD, r = nwg % NXCD, xcd = wgid % NXCD, off = wgid / NXCD; wgid = (xcd < r ? xcd * (q + 1) : r * (q + 1) + (xcd - r) * q) + off; }
        const int nig = WGM * nN, gid = wgid / nig, fm = gid * WGM, gsz = (nM - fm) < WGM ? (nM - fm) : WGM;
        u.pm = fm + ((wgid % nig) % gsz); u.pn = (wgid % nig) / gsz; return true;
    }
    __device__ __forceinline__ void a_ready(const Unit&) const {}
    __device__ __forceinline__ void done(const Unit&) const {}
};

__device__ __forceinline__ unsigned cvt_pk_bf16(float lo, float hi) { unsigned r; asm volatile("v_cvt_pk_bf16_f32 %0, %1, %2" : "=v"(r) : "v"(lo), "v"(hi)); return r; }
typedef float f32x2 __attribute__((ext_vector_type(2)));
template <class Epi, class Sched, bool ALIGN_EPI = false, bool SP2 = false>
__device__ __forceinline__ void gemm_phase(PG8_LAS unsigned char* lds, const Gemm g, const Sched& S, const Epi& E, int tid_in) {
    int tid_l = tid_in; asm volatile("" : "+v"(tid_l)); const int tid = tid_l, wid = __builtin_amdgcn_readfirstlane(tid >> 6), lane = tid & 63, wr = wid >> 2, wc = wid & 3, fr = lane & 15, fq = lane >> 4;
    const int K = g.K, nt = K / BK, LD = g.ld;
    unsigned voffA[2], voffB[2];
#pragma unroll
    for (int i = 0; i < 2; ++i) { int R, C; stage_rc(tid * 16 + i * 8192, R, C); const int Rb = Epi::PERM ? ((R & ~31) + perm32(R & 31)) : R;
        voffA[i] = (unsigned)(R * LD + C) * 2u; voffB[i] = (unsigned)(Rb * LD + C) * 2u; }
    const size_t kstep = (size_t)(BK * 2);
    const size_t hstep = (size_t)HALF * LD * 2;
    const size_t tstep = 2 * hstep;
    const unsigned ldsw = (unsigned)wid * 1024u;
    const int aoff = lds_byte(wr * 64 + fr, fq * 8), boff = lds_byte(wc * 32 + fr, fq * 8);
#define PG8_SA(b, h) (((b) * 2 + (h)) * HTB)
#define PG8_SB(b, h) ((4 + (b) * 2 + (h)) * HTB)
#define PG8_STAGE(bufoff, gbase, voff) do { _Pragma("unroll") for (int _i = 0; _i < 2; ++_i) \
        __builtin_amdgcn_global_load_lds((const unsigned*)((const char*)(gbase) + (voff)[_i]), (PG8_LAS unsigned*)(lds + (bufoff) + ldsw + _i * 8192), 16, 0, 0); } while (0)
#define PG8_LDA(dst, b, h) do { _Pragma("unroll") for (int m = 0; m < 4; ++m) _Pragma("unroll") for (int k = 0; k < 2; ++k) dst[m][k] = *(const PG8_LAS bf16x8*)(lds + PG8_SA(b, h) + aoff + m * 2048 + k * 1024); } while (0)
#define PG8_LDB(dst, b, h) do { _Pragma("unroll") for (int n = 0; n < 2; ++n) _Pragma("unroll") for (int k = 0; k < 2; ++k) dst[n][k] = *(const PG8_LAS bf16x8*)(lds + PG8_SB(b, h) + boff + n * 2048 + k * 1024); } while (0)
#define PG8_MMA(ai, bj, At, Bt) do { __builtin_amdgcn_s_setprio(1); _Pragma("unroll") for (int m = 0; m < 4; ++m) _Pragma("unroll") for (int n = 0; n < 2; ++n) _Pragma("unroll") for (int k = 0; k < 2; ++k) \
        acc[ai][bj][m][n] = __builtin_amdgcn_mfma_f32_16x16x32_bf16(Bt[n][k], At[m][k], acc[ai][bj][m][n], 0, 0, 0); __builtin_amdgcn_s_setprio(0); } while (0)
#define PG8_WAIT_V(n) asm volatile("s_waitcnt vmcnt(" #n ")" ::: "memory")
#define PG8_WAIT_L(n) asm volatile("s_waitcnt lgkmcnt(" #n ")" ::: "memory")
#define PG8_BAR __builtin_amdgcn_s_barrier()
#define PG8_SCHED __builtin_amdgcn_sched_barrier(0)
    Unit cur, nxt; int ui = 0;
    if (!S.next(0, cur)) return;
    f32x4 acc[2][2][4][2];
#pragma unroll
    for (int a = 0; a < 2; ++a)
#pragma unroll
        for (int b = 0; b < 2; ++b)
#pragma unroll
            for (int m = 0; m < 4; ++m)
#pragma unroll
                for (int n = 0; n < 2; ++n) acc[a][b][m][n] = (f32x4){0.f, 0.f, 0.f, 0.f};
    bf16x8 At[4][2], B0[2][2], B1[2][2];
    const char* cA = (const char*)g.A + (size_t)cur.pm * tstep; const char* cB = (const char*)g.Bt + (size_t)cur.pn * tstep;
    S.a_ready(cur);
    if constexpr (SP2) {
        PG8_STAGE(PG8_SB(0, 0), cB, voffB); PG8_STAGE(PG8_SB(0, 1), cB + hstep, voffB); PG8_STAGE(PG8_SA(0, 0), cA, voffA); PG8_STAGE(PG8_SA(0, 1), cA + hstep, voffA);
        if (wr == 1) PG8_BAR;
        PG8_WAIT_V(2); PG8_BAR;
        PG8_STAGE(PG8_SB(1, 0), cB + kstep, voffB); PG8_STAGE(PG8_SA(1, 0), cA + kstep, voffA); PG8_STAGE(PG8_SB(1, 1), cB + hstep + kstep, voffB);
        PG8_WAIT_V(6); PG8_BAR;
    } else {
        PG8_STAGE(PG8_SB(0, 0), cB, voffB); PG8_STAGE(PG8_SA(0, 0), cA, voffA); PG8_STAGE(PG8_SB(0, 1), cB + hstep, voffB); PG8_STAGE(PG8_SA(0, 1), cA + hstep, voffA);
        if (wr == 1) PG8_BAR;
        PG8_WAIT_V(4); PG8_BAR;
        PG8_STAGE(PG8_SB(1, 0), cB + kstep, voffB); PG8_STAGE(PG8_SA(1, 0), cA + kstep, voffA); PG8_STAGE(PG8_SB(1, 1), cB + hstep + kstep, voffB);
        PG8_WAIT_V(6); PG8_BAR;
    }
    for (;;) {
        const bool has_next = S.next(ui + 1, nxt);
        const char* nA = has_next ? (const char*)g.A + (size_t)nxt.pm * tstep : cA; const char* nB = has_next ? (const char*)g.Bt + (size_t)nxt.pn * tstep : cB;
        for (int t = 0; t < nt; t += 2) {
            const bool last = (t == nt - 2);
            const char* a1 = cA + (size_t)(t + 1) * kstep;
            const char* a2 = last ? nA : cA + (size_t)(t + 2) * kstep; const char* b2 = last ? nB : cB + (size_t)(t + 2) * kstep;
            const char* a3 = a2 + kstep; const char* b3 = b2 + kstep;
            if (last && has_next) S.a_ready(nxt);
            if constexpr (SP2) {
            PG8_LDB(B0, 0, 0); PG8_LDB(B1, 0, 1); PG8_SCHED; PG8_LDA(At, 0, 0); PG8_STAGE(PG8_SA(1, 1), a1 + hstep, voffA);
            PG8_WAIT_V(8); PG8_WAIT_L(0); PG8_BAR; PG8_MMA(0, 0, At, B0); PG8_MMA(0, 1, At, B1); PG8_BAR; PG8_SCHED;
            PG8_LDA(At, 0, 1); PG8_STAGE(PG8_SB(0, 0), b2, voffB); PG8_STAGE(PG8_SB(0, 1), b2 + hstep, voffB); PG8_STAGE(PG8_SA(0, 0), a2, voffA);
            PG8_WAIT_V(8); PG8_WAIT_L(0); PG8_BAR; PG8_MMA(1, 0, At, B0); PG8_MMA(1, 1, At, B1); PG8_BAR; PG8_SCHED;
            PG8_LDB(B0, 1, 0); PG8_LDB(B1, 1, 1); PG8_SCHED; PG8_LDA(At, 1, 0); PG8_STAGE(PG8_SA(0, 1), a2 + hstep, voffA);
            PG8_WAIT_V(8); PG8_WAIT_L(0); PG8_BAR; PG8_MMA(0, 0, At, B0); PG8_MMA(0, 1, At, B1); PG8_BAR; PG8_SCHED;
            PG8_LDA(At, 1, 1); PG8_STAGE(PG8_SB(1, 0), b3, voffB); PG8_STAGE(PG8_SB(1, 1), b3 + hstep, voffB); PG8_STAGE(PG8_SA(1, 0), a3, voffA);
            PG8_WAIT_V(8); PG8_WAIT_L(0); PG8_BAR; PG8_MMA(1, 0, At, B0); PG8_MMA(1, 1, At, B1); PG8_BAR; PG8_SCHED;
            } else {
            PG8_LDB(B0, 0, 0); PG8_SCHED; PG8_LDA(At, 0, 0); PG8_STAGE(PG8_SA(1, 1), a1 + hstep, voffA);
            PG8_WAIT_L(8); PG8_BAR; PG8_WAIT_L(0); PG8_MMA(0, 0, At, B0); PG8_BAR; PG8_SCHED;
            PG8_LDB(B1, 0, 1); PG8_STAGE(PG8_SB(0, 0), b2, voffB);
            PG8_BAR; PG8_WAIT_L(0); PG8_MMA(0, 1, At, B1); PG8_BAR;
            PG8_LDA(At, 0, 1); PG8_STAGE(PG8_SA(0, 0), a2, voffA);
            PG8_BAR; PG8_WAIT_L(0); PG8_MMA(1, 0, At, B0); PG8_BAR; PG8_SCHED;
            PG8_STAGE(PG8_SB(0, 1), b2 + hstep, voffB);
            PG8_WAIT_V(6); PG8_BAR; PG8_MMA(1, 1, At, B1); PG8_BAR;
            PG8_LDB(B0, 1, 0); PG8_SCHED; PG8_LDA(At, 1, 0); PG8_STAGE(PG8_SA(0, 1), a2 + hstep, voffA);
            PG8_WAIT_L(8); PG8_BAR; PG8_WAIT_L(0); PG8_MMA(0, 0, At, B0); PG8_BAR; PG8_SCHED;
            PG8_LDB(B1, 1, 1); PG8_STAGE(PG8_SB(1, 0), b3, voffB);
            PG8_BAR; PG8_WAIT_L(0); PG8_MMA(0, 1, At, B1); PG8_BAR;
            PG8_LDA(At, 1, 1); PG8_STAGE(PG8_SA(1, 0), a3, voffA);
            PG8_BAR; PG8_WAIT_L(0); PG8_MMA(1, 0, At, B0); PG8_BAR; PG8_SCHED;
            PG8_STAGE(PG8_SB(1, 1), b3 + hstep, voffB);
            PG8_WAIT_V(6); PG8_BAR; PG8_MMA(1, 1, At, B1); PG8_BAR;
            }
        }
        if constexpr (ALIGN_EPI) { if (wr == 0) PG8_BAR; }
        if constexpr (!Epi::AFTER_DRAIN) { E(acc, cur, wr, wc, fr, fq); S.done(cur); }
        if (!has_next) break;
#pragma unroll
        for (int a = 0; a < 2; ++a)
#pragma unroll
            for (int b = 0; b < 2; ++b)
#pragma unroll
                for (int m = 0; m < 4; ++m)
#pragma unroll
                    for (int n = 0; n < 2; ++n) acc[a][b][m][n] = (f32x4){0.f, 0.f, 0.f, 0.f};
        cur = nxt; cA = nA; cB = nB; ++ui;
        if constexpr (ALIGN_EPI) { if (wr == 1) PG8_BAR; }
    }
    PG8_WAIT_V(0);
    if constexpr (!ALIGN_EPI) { if (wr == 0) PG8_BAR; }
    PG8_BAR;
    if constexpr (Epi::AFTER_DRAIN) { E.fused(acc, cur, wr, wc, fr, fq, lds, wid, lane); S.done(cur); }
#undef PG8_SA
#undef PG8_SB
#undef PG8_STAGE
#undef PG8_LDA
#undef PG8_LDB
#undef PG8_MMA
#undef PG8_WAIT_V
#undef PG8_WAIT_L
#undef PG8_BAR
#undef PG8_SCHED
}
}

#define LAS __attribute__((address_space(3)))
typedef unsigned short bf16_t;
typedef unsigned char uchar;
typedef short bf16x8 __attribute__((ext_vector_type(8)));
typedef float f32x4 __attribute__((ext_vector_type(4)));
typedef float f32x16 __attribute__((ext_vector_type(16)));
typedef unsigned u32x2 __attribute__((ext_vector_type(2)));
typedef unsigned u32x4 __attribute__((ext_vector_type(4)));

constexpr int TL = 32768, TC = 4096, TT = 36864;
constexpr size_t MiB = 1u << 20;
constexpr size_t OFF_ROPE = 64 * 1024, OFF_MOD = 128 * 1024;
constexpr size_t OFF_WB = 1 * MiB;
constexpr size_t WB_W1 = 0, WB_WO = (size_t)2304 * 1024 * 2, WB_F1 = WB_WO + (size_t)1024 * 1024 * 2, WB_F2 = WB_F1 + (size_t)4096 * 1024 * 2, WB_LAYER = WB_F2 + (size_t)4096 * 1024 * 2;
constexpr size_t OFF_DFTL = 46 * MiB, OFF_DFTC = 62 * MiB, OFF_XC = 63 * MiB, OFF_H = 79 * MiB, OFF_M1 = 79 * MiB, OFF_M2 = 115 * MiB;
constexpr size_t OFF_GTL = 151 * MiB, OFF_GTC = 183 * MiB, OFF_Q = 187 * MiB, OFF_K = 223 * MiB, OFF_VTL = 232 * MiB, OFF_VTC = 240 * MiB, OFF_DQKV = 241 * MiB,
                 OFF_DZ = 295 * MiB, OFF_GB = 313 * MiB, OFF_O0T = 316 * MiB, OFF_S0T = 352 * MiB, OFF_ST = 388 * MiB, OFF_CAT = 424 * MiB, OFF_U = 151 * MiB, WS_END = 496 * MiB,
                 OFF_PART2 = 151 * MiB  ,
                 OFF_PARTF = 440 * MiB  ;
static_assert(OFF_WB + 2 * WB_LAYER <= OFF_DFTL, "ws map");
constexpr int LDS_BYTES = 163840, LDS_MISC = 155648;

struct Params { const float* in[18]; float* out; unsigned char* ws; };

typedef float f32x2_t __attribute__((ext_vector_type(2))); typedef __bf16 bf16x2_t __attribute__((ext_vector_type(2)));
__device__ __forceinline__ unsigned pk(float lo, float hi) { f32x2_t v = {lo, hi}; bf16x2_t b = __builtin_convertvector(v, bf16x2_t); return __builtin_bit_cast(unsigned, b); }
__device__ __forceinline__ bf16_t f2bf(float x) { return (bf16_t)(pk(x, 0.f) & 0xffffu); }
__device__ __forceinline__ float bf2f(unsigned h) { return __uint_as_float(h << 16); }
__device__ __forceinline__ float bflo(unsigned w) { return __uint_as_float(w << 16); }
__device__ __forceinline__ float bfhi(unsigned w) { return __uint_as_float(w & 0xffff0000u); }
__device__ __forceinline__ float silu_f(float x) { return x * __builtin_amdgcn_rcpf(1.f + __expf(-x)); }
template <int M> __device__ __forceinline__ float sxor(float v) {
    static_assert(M >= 1 && M <= 16, "sxor: mask 1..16");
    return __int_as_float(__builtin_amdgcn_ds_swizzle(__float_as_int(v), (M << 10) | 0x1f));
}
__device__ __forceinline__ float sum32(float v) { auto r = __builtin_amdgcn_permlane32_swap(__float_as_uint(v), __float_as_uint(v), false, false); return __uint_as_float(r[0]) + __uint_as_float(r[1]); }
__device__ __forceinline__ float max32(float v) { auto r = __builtin_amdgcn_permlane32_swap(__float_as_uint(v), __float_as_uint(v), false, false); return fmaxf(__uint_as_float(r[0]), __uint_as_float(r[1])); }
__device__ __forceinline__ float wave_sum(float v) {
    v += sxor<1>(v); v += sxor<2>(v); v += sxor<4>(v); v += sxor<8>(v); v += sxor<16>(v); return sum32(v);
}
__device__ __forceinline__ f32x4 mfma16(bf16x8 a, bf16x8 b, f32x4 c) { return __builtin_amdgcn_mfma_f32_16x16x32_bf16(a, b, c, 0, 0, 0); }
__device__ __forceinline__ f32x16 mfma32(bf16x8 a, bf16x8 b, f32x16 c) { return __builtin_amdgcn_mfma_f32_32x32x16_bf16(a, b, c, 0, 0, 0); }

struct EpiProj {
    static constexpr bool PERM = false, AFTER_DRAIN = false;
    unsigned char* ws; const float *qg, *kg;
    __device__ __forceinline__ void operator()(const f32x4 (&acc)[2][2][4][2], const pg8::Unit& u, int wr, int wc, int fr, int fq) const {
        asm volatile("" : "+v"(fr), "+v"(fq));
        bf16_t* const GTl = (bf16_t*)(ws + OFF_GTL); bf16_t* const GTc = (bf16_t*)(ws + OFF_GTC); bf16_t* const Qb = (bf16_t*)(ws + OFF_Q); bf16_t* const Kb = (bf16_t*)(ws + OFF_K);
        bf16_t* const VTl = (bf16_t*)(ws + OFF_VTL); bf16_t* const VTc = (bf16_t*)(ws + OFF_VTC); bf16_t* const DQKV = (bf16_t*)(ws + OFF_DQKV); bf16_t* const DZ = (bf16_t*)(ws + OFF_DZ);
        const float2* const rope = (const float2*)(ws + OFF_ROPE);
        const int pn = u.pn, rowt = u.pm * 256;
        const bool ctx = rowt >= TL;
        const int b = ctx ? (rowt - TL) >> 8 : rowt >> 11;
        const int s0 = ctx ? 0 : (rowt & 2047);
        const int Ls = ctx ? 256 : 2048;
        if (pn < 2) {
            bf16_t* G = (ctx ? GTc : GTl);
#pragma unroll
            for (int ai = 0; ai < 2; ++ai)
#pragma unroll
                for (int m = 0; m < 4; ++m) {
                    const int s = s0 + ai * 128 + wr * 64 + m * 16 + fr;
#pragma unroll
                    for (int bj = 0; bj < 2; ++bj)
#pragma unroll
                        for (int n = 0; n < 2; ++n)
#pragma unroll
                            for (int j = 0; j < 4; ++j) {
                                const int c = bj * 128 + wc * 32 + n * 16 + fq * 4 + j;
                                G[((size_t)((b * 256 + c) * 2 + pn)) * Ls + s] = f2bf(acc[ai][bj][m][n][j]);
                            }
                }
        } else if (pn < 5) {
            const bool isv = (pn == 4) && (wc >= 2);
            if (isv) {
                const int kvh = wc - 2; bf16_t* V = ctx ? VTc : VTl;
#pragma unroll
                for (int ai = 0; ai < 2; ++ai)
#pragma unroll
                    for (int m = 0; m < 4; ++m) {
                        const int s = s0 + ai * 128 + wr * 64 + m * 16 + fr;
#pragma unroll
                        for (int bj = 0; bj < 2; ++bj)
#pragma unroll
                            for (int n = 0; n < 2; ++n)
#pragma unroll
                                for (int j = 0; j < 4; ++j) {
                                    const int d = bj * 32 + n * 16 + fq * 4 + j;
                                    V[((size_t)((b * 2 + kvh) * 64 + d)) * Ls + s] = f2bf(acc[ai][bj][m][n][j]);
                                }
                    }
            } else {
                const bool isq = pn < 4;
                const float* gw = isq ? qg : kg;
                const float osc = isq ? 0.125f : 1.0f;
                f32x4 gv[2][2];
#pragma unroll
                for (int bj = 0; bj < 2; ++bj)
#pragma unroll
                    for (int n = 0; n < 2; ++n) gv[bj][n] = *(const f32x4*)(gw + bj * 32 + n * 16 + fq * 4);
#pragma unroll
                for (int ai = 0; ai < 2; ++ai)
#pragma unroll
                    for (int m = 0; m < 4; ++m) {
                        const int rl = ai * 128 + wr * 64 + m * 16 + fr;
                        const int s = s0 + rl; const size_t row = (size_t)rowt + rl;
                        float ss = 0.f;
#pragma unroll
                        for (int bj = 0; bj < 2; ++bj)
#pragma unroll
                            for (int n = 0; n < 2; ++n) { const f32x4 v = acc[ai][bj][m][n]; ss += (v[0] * v[0] + v[1] * v[1]) + (v[2] * v[2] + v[3] * v[3]); }
                        ss += sxor<16>(ss); ss = sum32(ss);
                        const float rinv = rsqrtf(ss * (1.f / 64.f) + 1e-6f);
                        bf16_t* dst = isq ? (Qb + row * 512 + ((pn - 2) * 4 + wc) * 64) : (Kb + row * 128 + wc * 64);
#pragma unroll
                        for (int bj = 0; bj < 2; ++bj) {
                            f32x4 x0 = acc[ai][bj][m][0] * rinv * gv[bj][0], x1 = acc[ai][bj][m][1] * rinv * gv[bj][1];
                            if (!ctx) {
                                const int pos = bj == 0 ? (s >> 6) : (s & 63);
                                const float2* rp = rope + pos * 16 + fq * 4;
                                f32x4 o0, o1;
#pragma unroll
                                for (int j = 0; j < 4; ++j) { const float2 cs = rp[j]; o0[j] = x0[j] * cs.x - x1[j] * cs.y; o1[j] = x1[j] * cs.x + x0[j] * cs.y; }
                                x0 = o0; x1 = o1;
                            }
                            x0 = x0 * osc; x1 = x1 * osc;
                            u32x2 w0, w1; w0.x = pk(x0[0], x0[1]); w0.y = pk(x0[2], x0[3]); w1.x = pk(x1[0], x1[1]); w1.y = pk(x1[2], x1[3]);
                            *(u32x2*)(dst + bj * 32 + fq * 4) = w0; *(u32x2*)(dst + bj * 32 + 16 + fq * 4) = w1;
                        }
                    }
            }
        } else {
            bf16_t* O = pn < 8 ? DQKV : DZ; const int ldo = pn < 8 ? 768 : 256; const int cb = pn < 8 ? (pn - 5) * 256 : 0;
#pragma unroll
            for (int ai = 0; ai < 2; ++ai)
#pragma unroll
                for (int m = 0; m < 4; ++m) {
                    bf16_t* rowp = O + ((size_t)rowt + ai * 128 + wr * 64 + m * 16 + fr) * ldo + cb + wc * 32 + fq * 4;
#pragma unroll
                    for (int bj = 0; bj < 2; ++bj)
#pragma unroll
                        for (int n = 0; n < 2; ++n) { const f32x4 v = acc[ai][bj][m][n]; u32x2 w; w.x = pk(v[0], v[1]); w.y = pk(v[2], v[3]); *(u32x2*)(rowp + bj * 128 + n * 16) = w; }
                }
        }
    }
};

struct EpiResid {
    static constexpr bool PERM = false, AFTER_DRAIN = false;
    const float* srcl; float* dstl; const float* srcc; float* dstc; const float* gate;
    __device__ __forceinline__ void operator()(const f32x4 (&acc)[2][2][4][2], const pg8::Unit& u, int wr, int wc, int fr, int fq) const {
        const int rowt = u.pm * 256; const bool ctx = rowt >= TL;
        const int bb = ctx ? 16 : rowt >> 11;
        const float* src = ctx ? srcc + (size_t)(rowt - TL) * 1024 : srcl + (size_t)rowt * 1024;
        float* dst = ctx ? dstc + (size_t)(rowt - TL) * 1024 : dstl + (size_t)rowt * 1024;
        const int col0 = u.pn * 256 + wc * 32 + fq * 4;
        f32x4 gv[2][2];
#pragma unroll
        for (int bj = 0; bj < 2; ++bj)
#pragma unroll
            for (int n = 0; n < 2; ++n) gv[bj][n] = *(const f32x4*)(gate + bb * 6144 + col0 + bj * 128 + n * 16);
#pragma unroll
        for (int ai = 0; ai < 2; ++ai)
#pragma unroll
            for (int m = 0; m < 4; ++m) {
                const size_t off = (size_t)(ai * 128 + wr * 64 + m * 16 + fr) * 1024 + col0;
#pragma unroll
                for (int bj = 0; bj < 2; ++bj)
#pragma unroll
                    for (int n = 0; n < 2; ++n) { const f32x4 sv = *(const f32x4*)(src + off + bj * 128 + n * 16); *(f32x4*)(dst + off + bj * 128 + n * 16) = sv + gv[bj][n] * acc[ai][bj][m][n]; }
            }
    }
};

struct EpiRelu2 {
    static constexpr bool PERM = false, AFTER_DRAIN = false;
    bf16_t* U;
    __device__ __forceinline__ void operator()(const f32x4 (&acc)[2][2][4][2], const pg8::Unit& u, int wr, int wc, int fr, int fq) const {
        const int col0 = u.pn * 256 + wc * 32 + fq * 4;
#pragma unroll
        for (int ai = 0; ai < 2; ++ai)
#pragma unroll
            for (int m = 0; m < 4; ++m) {
                bf16_t* rowp = U + ((size_t)u.pm * 256 + ai * 128 + wr * 64 + m * 16 + fr) * 4096 + col0;
#pragma unroll
                for (int bj = 0; bj < 2; ++bj)
#pragma unroll
                    for (int n = 0; n < 2; ++n) { f32x4 v = acc[ai][bj][m][n];
#pragma unroll
                        for (int j = 0; j < 4; ++j) { const float t = fmaxf(v[j], 0.f); v[j] = t * t; }
                        u32x2 w; w.x = pk(v[0], v[1]); w.y = pk(v[2], v[3]); *(u32x2*)(rowp + bj * 128 + n * 16) = w; }
            }
    }
};

struct EpiFourier {
    static constexpr bool PERM = false, AFTER_DRAIN = false;
    bf16_t* CAT; int rowbase, Ls;
    __device__ __forceinline__ void operator()(const f32x4 (&acc)[2][2][4][2], const pg8::Unit& u, int wr, int wc, int fr, int fq) const {
        const int b = u.pn;
#pragma unroll
        for (int ai = 0; ai < 2; ++ai)
#pragma unroll
            for (int m = 0; m < 4; ++m) {
                const int k1 = u.pm * 256 + ai * 128 + wr * 64 + m * 16 + fr;
                bf16_t* rowp = CAT + ((size_t)rowbase + (size_t)b * Ls + k1) * 1024 + wc * 32 + fq * 4;
#pragma unroll
                for (int bj = 0; bj < 2; ++bj)
#pragma unroll
                    for (int n = 0; n < 2; ++n) { const f32x4 v = acc[ai][bj][m][n]; u32x2 w; w.x = pk(v[0], v[1]); w.y = pk(v[2], v[3]); *(u32x2*)(rowp + bj * 128 + n * 16) = w; }
            }
    }
};

struct EpiSplit {
    static constexpr bool PERM = false, AFTER_DRAIN = false;
    const float* src; float* dst; const float* gate;
    __device__ __forceinline__ void operator()(const f32x4 (&acc)[2][2][4][2], const pg8::Unit& u, int wr, int wc, int fr, int fq) const {
        const int col0 = u.pn * 256 + wc * 32 + fq * 4;
        f32x4 gv[2][2];
#pragma unroll
        for (int bj = 0; bj < 2; ++bj)
#pragma unroll
            for (int n = 0; n < 2; ++n) gv[bj][n] = *(const f32x4*)(gate + col0 + bj * 128 + n * 16);
#pragma unroll
        for (int ai = 0; ai < 2; ++ai)
#pragma unroll
            for (int m = 0; m < 4; ++m) {
                const size_t off = ((size_t)u.pm * 256 + ai * 128 + wr * 64 + m * 16 + fr) * 1024 + col0;
#pragma unroll
                for (int bj = 0; bj < 2; ++bj)
#pragma unroll
                    for (int n = 0; n < 2; ++n) { f32x4 o = gv[bj][n] * acc[ai][bj][m][n]; if (src) o += *(const f32x4*)(src + off + bj * 128 + n * 16); *(f32x4*)(dst + off + bj * 128 + n * 16) = o; }
            }
    }
};
struct OrderL1 {
    pg8::StaticOrder so; int G, c;
    __device__ void init(int G_, int c_) { so.init(TL, 2304, G_, c_); G = G_; c = c_; }
    __device__ bool next(int i, pg8::Unit& u) const {
        if (so.next(i, u)) return true;
        const long Lx = (long)i * G + c - so.nwg; if (Lx < 0 || Lx >= 64) return false;
        u.pm = 128 + (int)(Lx >> 2); u.pn = 4 + (int)(Lx & 3); return true;
    }
    __device__ __forceinline__ void a_ready(const pg8::Unit&) const {}
    __device__ __forceinline__ void done(const pg8::Unit&) const {}
};

struct RevOrder {
    pg8::StaticOrder so; int nM;
    __device__ void init(int M, int N, int G_, int c_) { so.init(M, N, G_, c_); nM = M / 256; }
    __device__ bool next(int i, pg8::Unit& u) const { if (!so.next(i, u)) return false; u.pm = nM - 1 - u.pm; return true; }
    __device__ __forceinline__ void a_ready(const pg8::Unit&) const {}
    __device__ __forceinline__ void done(const pg8::Unit&) const {}
};

struct EpiRelu2P {
    static constexpr bool PERM = true, AFTER_DRAIN = false;
    bf16_t* U;
    __device__ __forceinline__ void operator()(const f32x4 (&acc)[2][2][4][2], const pg8::Unit& u, int wr, int wc, int fr, int fq) const {
        const int col0 = u.pn * 256 + wc * 32 + fq * 8;
#pragma unroll
        for (int ai = 0; ai < 2; ++ai)
#pragma unroll
            for (int m = 0; m < 4; ++m) {
                bf16_t* rowp = U + ((size_t)u.pm * 256 + ai * 128 + wr * 64 + m * 16 + fr) * 4096 + col0;
#pragma unroll
                for (int bj = 0; bj < 2; ++bj) { f32x4 v0 = acc[ai][bj][m][0], v1 = acc[ai][bj][m][1];
#pragma unroll
                    for (int j = 0; j < 4; ++j) { const float t0 = fmaxf(v0[j], 0.f), t1 = fmaxf(v1[j], 0.f); v0[j] = t0 * t0; v1[j] = t1 * t1; }
                    u32x4 w; w.x = pk(v0[0], v0[1]); w.y = pk(v0[2], v0[3]); w.z = pk(v1[0], v1[1]); w.w = pk(v1[2], v1[3]);
                    *(u32x4*)(rowp + bj * 128) = w; }
            }
    }
};

__device__ __forceinline__ void tr_item(const float* Wsrc, int ld, bf16_t* dst, int K, LAS float* scr, int lane) {
#pragma unroll 8
    for (int i = 0; i < 32; ++i) { const int kk = 2 * i + (lane >> 5); scr[kk * 33 + (lane & 31)] = Wsrc[(size_t)kk * ld + (lane & 31)]; }
    asm volatile("s_waitcnt lgkmcnt(0)" ::: "memory");
    const int c = lane & 7;
#pragma unroll
    for (int j = 0; j < 4; ++j) { const int n = (lane >> 3) + 8 * j; const LAS float* s = scr + (8 * c) * 33 + n;
        u32x4 o; o.x = pk(s[0 * 33], s[1 * 33]); o.y = pk(s[2 * 33], s[3 * 33]); o.z = pk(s[4 * 33], s[5 * 33]); o.w = pk(s[6 * 33], s[7 * 33]);
        *(u32x4*)(dst + (size_t)n * K + 8 * c) = o; }
    asm volatile("s_waitcnt lgkmcnt(0)" ::: "memory");
}
__device__ __forceinline__ int w1_orig_col(int n0) {
    const int tile = n0 >> 8, c = n0 & 255, bj = c >> 7, wc = (c & 127) >> 5;
    if (tile < 4) return 256 + (tile - 2) * 256 + 64 * wc + 32 * bj;
    if (tile == 4) return wc < 2 ? 768 + 64 * wc + 32 * bj : 896 + 64 * (wc - 2) + 32 * bj;
    if (tile < 8) return 1024 + (tile - 5) * 256 + c;
    return 1792 + c;
}

typedef const __attribute__((address_space(4))) Params CParamsP;
__device__ __forceinline__ void phase_prologue(CParamsP* pp, LAS uchar* L, int tid, int lane, int wave) {
    uchar* ws = pp->ws;
    LAS float* trig = (LAS float*)(L + LDS_MISC);
    if (tid < 64) { float s, c; sincospif((float)tid / 32.f, &s, &c); trig[tid] = c; trig[64 + tid] = s; }
    if (blockIdx.x < 192) {
        const int item = blockIdx.x;
        LAS float* sc = (LAS float*)L;
        LAS float* red = (LAS float*)(L + 17 * 1024 * 4);
        const float* c = pp->in[1]; const float* cctx = pp->in[3];
        for (int i = tid; i < 17 * 1024; i += 512) { const int bb = i >> 10, k = i & 1023; const float v = bb < 16 ? c[bb * 1024 + k] : cctx[k]; sc[i] = silu_f(v); }
        __syncthreads();
        const int l = item / 96, cb = item % 96, n = cb * 64 + lane;
        const float* W = pp->in[6] + (size_t)l * 1024 * 6144;
        float acc[17];
#pragma unroll
        for (int bb = 0; bb < 17; ++bb) acc[bb] = 0.f;
#pragma unroll 4
        for (int kk = 0; kk < 128; ++kk) { const int k = wave * 128 + kk; const float wv = W[(size_t)k * 6144 + n];
#pragma unroll
            for (int bb = 0; bb < 17; ++bb) acc[bb] += sc[bb * 1024 + k] * wv; }
#pragma unroll
        for (int bb = 0; bb < 17; ++bb) red[(wave * 17 + bb) * 64 + lane] = acc[bb];
        __syncthreads();
        float* mod = (float*)(ws + OFF_MOD);
        const float* bm = pp->in[7];
        for (int i = tid; i < 17 * 64; i += 512) { const int bb = i >> 6, ln = i & 63; float s = 0.f;
#pragma unroll
            for (int w = 0; w < 8; ++w) s += red[(w * 17 + bb) * 64 + ln];
            const int nn = cb * 64 + ln; mod[(size_t)(l * 17 + bb) * 6144 + nn] = s + bm[l * 6144 + nn]; }
    }
    __syncthreads();
    LAS float* scr = (LAS float*)(L + wave * 16384);
    const int gw = blockIdx.x * 8 + wave, NGW = gridDim.x * 8;
    constexpr int I_W1 = 56 * 16, I_WO = 32 * 16, I_F1 = 128 * 16, I_F2 = 32 * 64, I_FO = 4 * 16 * 8, I_LAYER = I_W1 + I_WO + I_F1 + I_F2 + I_FO;
    for (int it = gw; it < 2 * I_LAYER; it += NGW) {
        const int l = it / I_LAYER; int r = it % I_LAYER;
        uchar* wb = ws + OFF_WB + (size_t)l * WB_LAYER;
        const float* w_in = pp->in[8] + (size_t)l * 1024 * 2064;
        if (r < I_W1) { const int nb = 16 + r / 16, kb = r % 16; const int n0 = nb * 32, k0 = kb * 64;
            tr_item(w_in + (size_t)k0 * 2064 + w1_orig_col(n0), 2064, (bf16_t*)(wb + WB_W1) + (size_t)n0 * 1024 + k0, 1024, scr, lane); continue; }
        r -= I_W1;
        if (r < I_WO) { const int nb = r / 16, kb = r % 16; const int n0 = nb * 32, k0 = kb * 64;
            tr_item(pp->in[15] + (size_t)l * 1024 * 1024 + (size_t)k0 * 1024 + n0, 1024, (bf16_t*)(wb + WB_WO) + (size_t)n0 * 1024 + k0, 1024, scr, lane); continue; }
        r -= I_WO;
        if (r < I_F1) { const int nb = r / 16, kb = r % 16; const int n0 = nb * 32, k0 = kb * 64;
            tr_item(pp->in[16] + (size_t)l * 1024 * 4096 + (size_t)k0 * 4096 + n0, 4096, (bf16_t*)(wb + WB_F1) + (size_t)n0 * 1024 + k0, 1024, scr, lane); continue; }
        r -= I_F1;
        if (r < I_F2) { const int nb = r / 64, kb = r % 64; const int n0 = nb * 32, k0 = kb * 64;
            tr_item(pp->in[17] + (size_t)l * 4096 * 1024 + (size_t)k0 * 1024 + n0, 1024, (bf16_t*)(wb + WB_F2) + (size_t)n0 * 4096 + k0, 4096, scr, lane); continue; }
        r -= I_F2;
        {
            const int g = r >> 7, kb = (r >> 3) & 15, k2b = r & 7; const int k = kb * 64 + lane;
            const f32x4* src = (const f32x4*)(w_in + (size_t)k * 2064 + g * 64);
            float ac[8], as[8];
#pragma unroll
            for (int j = 0; j < 8; ++j) { ac[j] = 0.f; as[j] = 0.f; }
            for (int n4 = 0; n4 < 16; ++n4) { const f32x4 v = src[n4];
#pragma unroll
                for (int e = 0; e < 4; ++e) { const int n2 = n4 * 4 + e;
#pragma unroll
                    for (int j = 0; j < 8; ++j) { const int idx = ((k2b * 8 + j) * n2) & 63; ac[j] += v[e] * trig[idx]; as[j] += v[e] * trig[64 + idx]; } } }
            bf16_t* W1 = (bf16_t*)(wb + WB_W1);
#pragma unroll
            for (int j = 0; j < 8; ++j) { const int k2 = k2b * 8 + j; W1[(size_t)(g * 64 + k2) * 1024 + k] = f2bf(ac[j]); W1[(size_t)(256 + g * 64 + k2) * 1024 + k] = f2bf(as[j]); }
        }
    }
    {
        const size_t gt = (size_t)blockIdx.x * 512 + tid, NT = (size_t)gridDim.x * 512;
        bf16_t* AL = (bf16_t*)(ws + OFF_DFTL);
        const float nl = 0.00276213586f;
        for (size_t it = gt; it < (size_t)2048 * 512; it += NT) { const int k1 = (int)(it >> 9), cg_ = (int)(it & 511), cs = cg_ >> 8, n0 = (cg_ & 255) * 8;
            float v[8];
#pragma unroll
            for (int e = 0; e < 8; ++e) { const int m = (k1 * (n0 + e)) & 2047; float s, c; sincospif((float)m * (1.f / 1024.f), &s, &c); v[e] = (cs ? -s : c) * nl; }
            u32x4 o; o.x = pk(v[0], v[1]); o.y = pk(v[2], v[3]); o.z = pk(v[4], v[5]); o.w = pk(v[6], v[7]);
            *(u32x4*)(AL + (size_t)k1 * 4096 + cs * 2048 + n0) = o; }
        bf16_t* AC = (bf16_t*)(ws + OFF_DFTC);
        const float nc = 1.f / 128.f;
        for (size_t it = gt; it < (size_t)256 * 64; it += NT) { const int k1 = (int)(it >> 6), cg_ = (int)(it & 63), cs = cg_ >> 5, n0 = (cg_ & 31) * 8;
            float v[8];
#pragma unroll
            for (int e = 0; e < 8; ++e) { const int m = (k1 * (n0 + e)) & 255; float s, c; sincospif((float)m * (1.f / 128.f), &s, &c); v[e] = (cs ? -s : c) * nc; }
            u32x4 o; o.x = pk(v[0], v[1]); o.y = pk(v[2], v[3]); o.z = pk(v[4], v[5]); o.w = pk(v[6], v[7]);
            *(u32x4*)(AC + (size_t)k1 * 512 + cs * 256 + n0) = o; }
        for (size_t it = gt; it < (size_t)TC * 256; it += NT) ((f32x4*)(ws + OFF_XC))[it] = ((const f32x4*)pp->in[2])[it];
        if (blockIdx.x == 0) { float2* rope = (float2*)(ws + OFF_ROPE);
            for (int i = tid; i < 1024; i += 512) { const int pos = i >> 4, pp = i & 15; const float invf = powf(10000.f, -(float)pp * 2.0f / 32.f); const float ang = (float)pos * invf; rope[i] = make_float2(cosf(ang), sinf(ang)); } }
    }
}

template <bool GATES, bool PART>
__device__ __forceinline__ void phase_norm(const float* xl, const float* xc, int nrows, const float* ng, const float* modl, int shIdx, int scIdx, bf16_t* H,
                                           const float* w_in_l, const float* a_log_l, const float* dt_bias_l, float* GB, LAS uchar* L, int tid, int lane, int wave,
                                           const float* part = nullptr, float* xcw = nullptr) {
    LAS float* wgT = (LAS float*)L;
    if (GATES) { for (int i = tid; i < 16384; i += 512) { const int k = i >> 4, e = i & 15; wgT[e * 1024 + k] = w_in_l[(size_t)k * 2064 + 2048 + e]; } __syncthreads(); }
    const int NW = gridDim.x * 8, gw = blockIdx.x * 8 + wave;
    const int rpw = ((nrows + NW - 1) / NW + 1) & ~1;
    const int r0 = gw * rpw, r1 = min(nrows, r0 + rpw);
    f32x4 ga[4], gb[4]; int cur_bb = -1;
    for (int r = r0; r < r1; r += 2) {
        const int bb = r < TL ? r >> 11 : 16;
        if (bb != cur_bb) { cur_bb = bb;
            const float* scp = modl + (size_t)bb * 6144 + scIdx * 1024; const float* shp = modl + (size_t)bb * 6144 + shIdx * 1024;
#pragma unroll
            for (int j = 0; j < 4; ++j) { const f32x4 g = ((const f32x4*)ng)[lane + 64 * j], sc = ((const f32x4*)scp)[lane + 64 * j]; ga[j] = g * (sc + 1.f); gb[j] = ((const f32x4*)shp)[lane + 64 * j]; } }
        const float* xr = r < TL ? xl + (size_t)r * 1024 : xc + (size_t)(r - TL) * 1024;
        f32x4 v[2][4]; float ss0 = 0.f, ss1 = 0.f;
#pragma unroll
        for (int j = 0; j < 4; ++j) { v[0][j] = ((const f32x4*)xr)[lane + 64 * j]; v[1][j] = ((const f32x4*)(xr + 1024))[lane + 64 * j]; }
        if (PART && r >= TL) {
            const size_t po = (size_t)(r - TL) * 1024;
#pragma unroll
            for (int k = 0; k < 3; ++k)
#pragma unroll
                for (int j = 0; j < 4; ++j) { v[0][j] += ((const f32x4*)(part + (size_t)k * TC * 1024 + po))[lane + 64 * j]; v[1][j] += ((const f32x4*)(part + (size_t)k * TC * 1024 + po + 1024))[lane + 64 * j]; }
            if (xcw != nullptr) {
#pragma unroll
                for (int j = 0; j < 4; ++j) { ((f32x4*)(xcw + po))[lane + 64 * j] = v[0][j]; ((f32x4*)(xcw + po + 1024))[lane + 64 * j] = v[1][j]; } }
        }
#pragma unroll
        for (int j = 0; j < 4; ++j) { ss0 += (v[0][j][0] * v[0][j][0] + v[0][j][1] * v[0][j][1]) + (v[0][j][2] * v[0][j][2] + v[0][j][3] * v[0][j][3]);
                                      ss1 += (v[1][j][0] * v[1][j][0] + v[1][j][1] * v[1][j][1]) + (v[1][j][2] * v[1][j][2] + v[1][j][3] * v[1][j][3]); }
        ss0 = wave_sum(ss0); ss1 = wave_sum(ss1);
        const float rs0 = rsqrtf(ss0 * (1.f / 1024.f) + 1e-6f), rs1 = rsqrtf(ss1 * (1.f / 1024.f) + 1e-6f);
#pragma unroll
        for (int j = 0; j < 4; ++j) {
            v[0][j] = v[0][j] * rs0 * ga[j] + gb[j]; v[1][j] = v[1][j] * rs1 * ga[j] + gb[j];
            u32x2 w0, w1; w0.x = pk(v[0][j][0], v[0][j][1]); w0.y = pk(v[0][j][2], v[0][j][3]); w1.x = pk(v[1][j][0], v[1][j][1]); w1.y = pk(v[1][j][2], v[1][j][3]);
            *(u32x2*)(H + (size_t)r * 1024 + 4 * (lane + 64 * j)) = w0; *(u32x2*)(H + (size_t)(r + 1) * 1024 + 4 * (lane + 64 * j)) = w1; }
        if (GATES) {
            LAS float* wg = wgT; asm volatile("" : "+v"(wg));
            float a0[16], a1[16];
#pragma unroll
            for (int e = 0; e < 16; ++e) { float s0 = 0.f, s1 = 0.f;
#pragma unroll
                for (int j = 0; j < 4; ++j) { const f32x4 w = *(const LAS f32x4*)(wg + e * 1024 + 4 * (lane + 64 * j));
                    s0 += (v[0][j][0] * w[0] + v[0][j][1] * w[1]) + (v[0][j][2] * w[2] + v[0][j][3] * w[3]);
                    s1 += (v[1][j][0] * w[0] + v[1][j][1] * w[1]) + (v[1][j][2] * w[2] + v[1][j][3] * w[3]); }
                a0[e] = s0; a1[e] = s1; }
#define NRM_STEP(N, BIT, SRC0, SRC1, DST0, DST1) { const bool up = (lane >> BIT) & 1; _Pragma("unroll") for (int m = 0; m < N; ++m) { \
                const float k0 = up ? SRC0[2 * m + 1] : SRC0[2 * m], s0_ = up ? SRC0[2 * m] : SRC0[2 * m + 1]; const float k1 = up ? SRC1[2 * m + 1] : SRC1[2 * m], s1_ = up ? SRC1[2 * m] : SRC1[2 * m + 1]; \
                DST0[m] = k0 + sxor<(1 << BIT)>(s0_); DST1[m] = k1 + sxor<(1 << BIT)>(s1_); } }
            float b0[8], b1[8], c0[4], c1[4], d0[2], d1[2], e0[1], e1[1];
            NRM_STEP(8, 0, a0, a1, b0, b1) NRM_STEP(4, 1, b0, b1, c0, c1) NRM_STEP(2, 2, c0, c1, d0, d1) NRM_STEP(1, 3, d0, d1, e0, e1)
#undef NRM_STEP
            float m0 = e0[0], m1 = e1[0];
            m0 += sxor<16>(m0); m1 += sxor<16>(m1); m0 = sum32(m0); m1 = sum32(m1);
            if (lane < 32) { const int e = lane & 15; const float mine = lane < 16 ? m0 : m1; float o;
                if (e < 8) o = 1.f / (1.f + expf(-mine));
                else { const int dh = e - 8; const float xx = mine + dt_bias_l[dh]; const float sp = xx > 20.f ? xx : log1pf(expf(xx)); o = -expf(a_log_l[dh]) * sp; }
                GB[(size_t)(r + (lane >> 4)) * 16 + e] = o; }
        }
    }
}

__device__ __forceinline__ f32x4 mm16(const LAS uchar* X, int x0, const LAS uchar* Y, int y0, int lane) {
    const int r = lane & 15, q = lane >> 4;
    const LAS uchar* xp = X + (x0 + r) * 144 + q * 16; const LAS uchar* yp = Y + (y0 + r) * 144 + q * 16;
    const bf16x8 a0 = *(const LAS bf16x8*)xp, a1 = *(const LAS bf16x8*)(xp + 64), b0 = *(const LAS bf16x8*)yp, b1 = *(const LAS bf16x8*)(yp + 64);
    f32x4 acc = {0.f, 0.f, 0.f, 0.f};
    acc = mfma16(a0, b0, acc); acc = mfma16(a1, b1, acc);
    return acc;
}
__device__ __forceinline__ f32x4 mm16k32(const LAS uchar* X, int x0, int xk, const LAS uchar* Y, int y0, int yk, int lane) {
    const int r = lane & 15, q = lane >> 4;
    const bf16x8 a0 = *(const LAS bf16x8*)(X + (x0 + r) * 144 + xk * 2 + q * 16), b0 = *(const LAS bf16x8*)(Y + (y0 + r) * 144 + yk * 2 + q * 16);
    f32x4 acc = {0.f, 0.f, 0.f, 0.f};
    return mfma16(a0, b0, acc);
}
constexpr int GL_QH = 0, GL_KH = 9216, GL_VT = 18432, GL_KBT = 27648, GL_KTT = 36864, GL_T = 46080, GL_QKM = 55296, GL_UT = 64512, GL_WT = 73728, GL_A = 82944, GL_GAM = 100352, GL_BET = 100608, GL_AB = 100864, GL_CW = 110080;

struct GdnRaw { u32x4 raw[3][3]; float g, be; };
__device__ __forceinline__ void gdn_decode(int v, int& h, int& dir, int& b, int& cidx) { h = v & 3; const int c = v >> 2; dir = c / 576; const int rem = c % 576; b = rem / 36; cidx = rem % 36; }
__device__ __forceinline__ void gdn_load(GdnRaw& R, int v, const bf16_t* DQKV, const float* GB, int tid, int lane, int wave) {
    int h, dir, b, cidx; gdn_decode(v, h, dir, b, cidx);
    const bool isctx = cidx < 4; const int Ls = isctx ? 256 : 2048;
    const int chunk = isctx ? (dir ? 3 - cidx : cidx) : (dir ? 35 - cidx : cidx - 4);
    const int base = chunk * 64; const size_t row0 = isctx ? (size_t)TL + b * 256 : (size_t)b * 2048;
    const int i = tid >> 3, part = tid & 7; const int pos = base + (dir ? 63 - i : i);
#pragma unroll
    for (int which = 0; which < 3; ++which)
#pragma unroll
        for (int j = 0; j < 3; ++j) { const int pp = pos + j - 1;
            R.raw[which][j] = (pp >= 0 && pp < Ls) ? *(const u32x4*)(DQKV + (row0 + pp) * 768 + which * 256 + h * 64 + part * 8) : (u32x4){0u, 0u, 0u, 0u}; }
    if (wave == 0) { const int p0 = base + (dir ? 63 - lane : lane); const float* gb = GB + (row0 + p0) * 16; R.g = gb[8 + dir * 4 + h]; R.be = gb[dir * 4 + h]; }
}

__device__ __forceinline__ void phase_gdn_pre(uchar* ws, const float* conv_w_l, LAS uchar* L_in, int tid_in, int lane_in, int wave) {
    const bf16_t* DQKV = (const bf16_t*)(ws + OFF_DQKV); const float* GB = (const float*)(ws + OFF_GB);
    bf16_t* M1g = (bf16_t*)(ws + OFF_M1); bf16_t* M2g = (bf16_t*)(ws + OFF_M2); bf16_t* O0Tg = (bf16_t*)(ws + OFF_O0T); bf16_t* S0Tg = (bf16_t*)(ws + OFF_S0T);
    (void)lane_in;
    int cur_h = -1;
    GdnRaw cur, nxt;
    if ((int)blockIdx.x < 4608) gdn_load(cur, blockIdx.x, DQKV, GB, tid_in, tid_in & 63, wave);
    for (int v = blockIdx.x; v < 4608; v += gridDim.x) {
        int tid = tid_in; asm volatile("" : "+v"(tid)); const int lane = tid & 63;
        LAS uchar* L = L_in; asm volatile("" : "+v"(L));
        LAS float* gam = (LAS float*)(L + GL_GAM); LAS float* bet = (LAS float*)(L + GL_BET); LAS float* A = (LAS float*)(L + GL_A);
        int h, dir, b, cidx; gdn_decode(v, h, dir, b, cidx);
        const size_t slot = (size_t)((dir * 16 + b) * 4 + h) * 36 + cidx;
        if (h != cur_h) { cur_h = h;
            for (int i = tid; i < 576; i += 512) { const int wj = i >> 6, d = i & 63; ((LAS float*)(L + GL_CW))[i] = conv_w_l[(wj % 3) * 768 + (wj / 3) * 256 + h * 64 + d]; } }
        if (v + (int)gridDim.x < 4608) gdn_load(nxt, v + gridDim.x, DQKV, GB, tid, lane, wave); else nxt = cur;
        if (wave == 0) { float s = cur.g;
#pragma unroll
            for (int o = 1; o < 64; o <<= 1) { const float t = __shfl_up(s, o); if (lane >= o) s += t; }
            gam[lane] = s; bet[lane] = cur.be; }
        __syncthreads();
        {
            const int i = tid >> 3, part = tid & 7;
            const float gi = gam[i], bi = bet[i], g63 = gam[63];
            const float eg = __expf(gi), ek = __expf(g63 - gi);
#pragma unroll
            for (int which = 0; which < 3; ++which) {
                float y[8];
#pragma unroll
                for (int e = 0; e < 8; ++e) y[e] = 0.f;
#pragma unroll
                for (int j = 0; j < 3; ++j) { const u32x4 raw = cur.raw[which][j]; const LAS float* wp = (const LAS float*)(L + GL_CW) + (which * 3 + j) * 64 + part * 8; const f32x4 w0 = *(const LAS f32x4*)wp, w1 = *(const LAS f32x4*)(wp + 4);
                    y[0] += w0[0] * bflo(raw.x); y[1] += w0[1] * bfhi(raw.x); y[2] += w0[2] * bflo(raw.y); y[3] += w0[3] * bfhi(raw.y);
                    y[4] += w1[0] * bflo(raw.z); y[5] += w1[1] * bfhi(raw.z); y[6] += w1[2] * bflo(raw.w); y[7] += w1[3] * bfhi(raw.w); }
                float ss = 0.f;
#pragma unroll
                for (int e = 0; e < 8; ++e) { y[e] = silu_f(y[e]); ss += y[e] * y[e]; }
                if (which < 2) { ss += sxor<1>(ss); ss += sxor<2>(ss); ss += sxor<4>(ss); const float rn = rsqrtf(ss + 1e-6f) * (which == 0 ? 0.125f : 1.f);
#pragma unroll
                    for (int e = 0; e < 8; ++e) y[e] *= rn; }
                if (which < 2) { u32x4 o; o.x = pk(y[0], y[1]); o.y = pk(y[2], y[3]); o.z = pk(y[4], y[5]); o.w = pk(y[6], y[7]);
                    *(LAS u32x4*)(L + (which == 0 ? GL_QH : GL_KH) + i * 144 + part * 16) = o; }
                if (which == 1) {
#pragma unroll
                    for (int e = 0; e < 8; ++e) { const int d = part * 8 + e; *(LAS bf16_t*)(L + GL_KBT + d * 144 + i * 2) = f2bf(bi * eg * y[e]); *(LAS bf16_t*)(L + GL_KTT + d * 144 + i * 2) = f2bf(ek * y[e]); } }
                if (which == 2) {
#pragma unroll
                    for (int e = 0; e < 8; ++e) { const int d = part * 8 + e; *(LAS bf16_t*)(L + GL_VT + d * 144 + i * 2) = f2bf(bi * y[e]); } }
            }
        }
        __syncthreads();
        {
#pragma unroll
            for (int tt = 0; tt < 2; ++tt) { const int tile = 2 * wave + tt, ti = tile >> 2, tj = tile & 3;
                const f32x4 kk = mm16(L + GL_KH, ti * 16, L + GL_KH, tj * 16, lane);
                const f32x4 qk = mm16(L + GL_QH, ti * 16, L + GL_KH, tj * 16, lane);
                const int j = tj * 16 + (lane & 15); const float gj = gam[j];
#pragma unroll
                for (int idx = 0; idx < 4; ++idx) { const int i = ti * 16 + 4 * (lane >> 4) + idx; const float gi = gam[i], bi = bet[i]; const float dec = __expf(fminf(gi - gj, 0.f));
                    const float av = (i > j) ? bi * kk[idx] * dec : 0.f;
                    *(LAS bf16_t*)(L + GL_AB + i * 144 + j * 2) = f2bf(av);
                    *(LAS bf16_t*)(L + GL_QKM + i * 144 + j * 2) = f2bf((i >= j) ? qk[idx] * dec : 0.f); } }
        }
        __syncthreads();
        if (wave == 0) {
            float t[32]; int c = lane & 31; const int half = lane >> 5, r0 = 32 * half; asm volatile("" : "+v"(c));
            const LAS uchar* ABp = L + GL_AB + r0 * 144 + r0 * 2;
            const unsigned oh = 1u << c;
            u32x4 buf[2][8];
#define SUB_LOAD(G, B) { const LAS uchar* pg_ = ABp; asm volatile("" : "+v"(pg_) : "v"(tdep)); _Pragma("unroll") for (int rr = 0; rr < 2; ++rr) { _Pragma("unroll") for (int j8 = 0; j8 < (2 * (G) + rr + 7) / 8; ++j8) buf[B][rr * 4 + j8] = *(const LAS u32x4*)(pg_ + (2 * (G) + rr) * 144 + j8 * 16); } }
            float tdep = 0.f;
            SUB_LOAD(0, 0) SUB_LOAD(1, 1)
#pragma unroll
            for (int g = 0; g < 16; ++g) {
#pragma unroll
                for (int rr = 0; rr < 2; ++rr) { const int i = 2 * g + rr; float s0 = (float)((oh >> i) & 1u), s1 = 0.f;
#pragma unroll
                    for (int j8 = 0; j8 < (i + 7) / 8; ++j8) { const u32x4 w = buf[g & 1][rr * 4 + j8];
#pragma unroll
                        for (int e = 0; e < 8; ++e) { const int j = 8 * j8 + e;
                            if (j < i) { if (e & 1) s1 -= bfhi(w[e >> 1]) * t[j]; else s0 -= bflo(w[e >> 1]) * t[j]; } } }
                    t[i] = s0 + s1; }
                tdep = t[2 * g + 1];
                if (g + 2 < 16) SUB_LOAD(g + 2, g & 1)
            }
#undef SUB_LOAD
#pragma unroll
            for (int i = 0; i < 32; ++i) *(LAS bf16_t*)(L + GL_T + (r0 + i) * 144 + (r0 + c) * 2) = f2bf(t[i]);
            if (half == 0) {
#pragma unroll
                for (int i = 0; i < 32; ++i) *(LAS bf16_t*)(L + GL_T + i * 144 + (32 + c) * 2) = (bf16_t)0;
#pragma unroll
                for (int j8 = 0; j8 < 4; ++j8) { u32x4 o; o.x = pk(t[8 * j8], t[8 * j8 + 1]); o.y = pk(t[8 * j8 + 2], t[8 * j8 + 3]); o.z = pk(t[8 * j8 + 4], t[8 * j8 + 5]); o.w = pk(t[8 * j8 + 6], t[8 * j8 + 7]);
                    *(LAS u32x4*)(L + GL_UT + c * 144 + j8 * 16) = o; }
            }
        }
        __syncthreads();
        if (wave < 4) {
            const int tm = wave >> 1, tc = wave & 1;
            const f32x4 acc = mm16k32(L + GL_AB, 32 + 16 * tm, 0, L + GL_UT, 16 * tc, 0, lane);
            const int cc = 16 * tc + (lane & 15), m0 = 16 * tm + 4 * (lane >> 4);
            u32x2 w; w.x = pk(acc[0], acc[1]); w.y = pk(acc[2], acc[3]);
            *(LAS u32x2*)(L + GL_WT + cc * 144 + m0 * 2) = w;
        }
        __syncthreads();
        if (wave < 4) {
            const int ti = wave >> 1, tc = wave & 1;
            const f32x4 acc = mm16k32(L + GL_T, 32 + 16 * ti, 32, L + GL_WT, 16 * tc, 0, lane);
            const int cc = 16 * tc + (lane & 15), i0 = 32 + 16 * ti + 4 * (lane >> 4);
#pragma unroll
            for (int idx = 0; idx < 4; ++idx) *(LAS bf16_t*)(L + GL_T + (i0 + idx) * 144 + cc * 2) = f2bf(-acc[idx]);
        }
        __syncthreads();
        {
#pragma unroll
            for (int tt = 0; tt < 4; ++tt) { const int tile = 4 * wave + tt, mat = tile >> 4, t16 = tile & 15, ti = t16 >> 2, te = t16 & 3;
                const f32x4 acc = mm16(L + GL_T, ti * 16, L + (mat ? GL_KBT : GL_VT), te * 16, lane);
                const int y = te * 16 + (lane & 15), i0 = ti * 16 + 4 * (lane >> 4);
                u32x2 w; w.x = pk(acc[0], acc[1]); w.y = pk(acc[2], acc[3]);
                *(LAS u32x2*)(L + (mat ? GL_WT : GL_UT) + y * 144 + i0 * 2) = w; }
        }
        __syncthreads();
        {
            const int mi = wave >> 1;
            const LAS uchar* X = L + (mi == 1 ? GL_UT : (mi == 3 ? GL_KTT : GL_WT));
            const LAS uchar* Y = L + ((mi == 0 || mi == 1) ? GL_QKM : (mi == 2 ? GL_KTT : GL_UT));
            const float a63 = __expf(gam[63]);
#pragma unroll
            for (int tt = 0; tt < 8; ++tt) { const int t16 = (wave & 1) * 8 + tt, tx = t16 >> 2, ty = t16 & 3;
                const f32x4 acc = mm16(X, tx * 16, Y, ty * 16, lane);
                const int y = ty * 16 + (lane & 15), x0 = tx * 16 + 4 * (lane >> 4);
                if (mi == 0) {
                    const u32x2 qq = *(const LAS u32x2*)(L + GL_QH + y * 144 + x0 * 2); const float eg = __expf(gam[y]);
                    u32x2 w; w.x = pk(bflo(qq.x) * eg - acc[0], bfhi(qq.x) * eg - acc[1]); w.y = pk(bflo(qq.y) * eg - acc[2], bfhi(qq.y) * eg - acc[3]);
                    const int ir = dir ? 63 - y : y; *(u32x2*)(M1g + slot * 4096 + ir * 64 + x0) = w;
                } else if (mi == 1) {
                    u32x2 w; w.x = pk(acc[0], acc[1]); w.y = pk(acc[2], acc[3]);
                    const int ir = dir ? 63 - y : y; *(u32x2*)(O0Tg + slot * 4096 + ir * 64 + x0) = w;
                } else if (mi == 2) {
                    u32x2 w; w.x = pk((y == x0 ? a63 : 0.f) - acc[0], (y == x0 + 1 ? a63 : 0.f) - acc[1]); w.y = pk((y == x0 + 2 ? a63 : 0.f) - acc[2], (y == x0 + 3 ? a63 : 0.f) - acc[3]);
                    *(u32x2*)(M2g + slot * 4096 + y * 64 + x0) = w;
                } else {
                    u32x2 w; w.x = pk(acc[0], acc[1]); w.y = pk(acc[2], acc[3]); *(u32x2*)(S0Tg + slot * 4096 + y * 64 + x0) = w;
                }
            }
        }
        __syncthreads();
        cur = nxt;
    }
}


struct Frag2 { bf16x8 a0, a1; };
__device__ __forceinline__ Frag2 ldfrag(const LAS uchar* M, int row0, int lane) { const LAS uchar* p = M + (row0 + (lane & 15)) * 144 + (lane >> 4) * 16; Frag2 f; f.a0 = *(const LAS bf16x8*)p; f.a1 = *(const LAS bf16x8*)(p + 64); return f; }
__device__ __forceinline__ f32x4 mmf(const Frag2& x, const Frag2& y) { f32x4 acc = {0.f, 0.f, 0.f, 0.f}; acc = mfma16(x.a0, y.a0, acc); return mfma16(x.a1, y.a1, acc); }
constexpr int G2_QH = 0, G2_KH = 9216  , G2_VT = 18432, G2_KBT = 27648, G2_KTT = 36864, G2_QKM = 46080, G2_AB = 55296  , G2_WT = 64512  ,
              G2_GAM = 73728, G2_BET = 73984, G2_CW = 74240, G2_HALF = 76544;
static_assert(2 * G2_HALF <= LDS_MISC, "gdn2 LDS map");
struct GdnRaw2 { u32x4 raw[2][3][3]; float g, be; };
__device__ __forceinline__ void gdn_load2(GdnRaw2& R, int v, const bf16_t* DQKV, const float* GB, int t2, int lane, int wl) {
    int h, dir, b, cidx; gdn_decode(v, h, dir, b, cidx);
    const bool isctx = cidx < 4; const int Ls = isctx ? 256 : 2048;
    const int chunk = isctx ? (dir ? 3 - cidx : cidx) : (dir ? 35 - cidx : cidx - 4);
    const int base = chunk * 64; const size_t row0 = isctx ? (size_t)TL + b * 256 : (size_t)b * 2048;
    const int i = t2 >> 2, part = t2 & 3; const int pos = base + (dir ? 63 - i : i);
#pragma unroll
    for (int p2 = 0; p2 < 2; ++p2)
#pragma unroll
        for (int which = 0; which < 3; ++which)
#pragma unroll
            for (int j = 0; j < 3; ++j) { const int pp = pos + j - 1;
                R.raw[p2][which][j] = (pp >= 0 && pp < Ls) ? *(const u32x4*)(DQKV + (row0 + pp) * 768 + which * 256 + h * 64 + part * 16 + p2 * 8) : (u32x4){0u, 0u, 0u, 0u}; }
    if (wl == 0) { const int p0 = base + (dir ? 63 - lane : lane); const float* gb = GB + (row0 + p0) * 16; R.g = gb[8 + dir * 4 + h]; R.be = gb[dir * 4 + h]; }
}

__device__ __forceinline__ void phase_gdn_pre2(uchar* ws, const float* conv_w_l, LAS uchar* L_in, int tid_in, int wave) {
    const bf16_t* DQKV = (const bf16_t*)(ws + OFF_DQKV); const float* GB = (const float*)(ws + OFF_GB);
    bf16_t* M1g = (bf16_t*)(ws + OFF_M1); bf16_t* M2g = (bf16_t*)(ws + OFF_M2); bf16_t* O0g = (bf16_t*)(ws + OFF_O0T); bf16_t* S0Tg = (bf16_t*)(ws + OFF_S0T);
    const int half = wave >> 2, wl = wave & 3, G = gridDim.x, bid = blockIdx.x;
    int cur_h = -1;
    GdnRaw2 cur, nxt;
    { const int v0 = bid + half * G; if (v0 < 4608) gdn_load2(cur, v0, DQKV, GB, tid_in & 255, tid_in & 63, wl); }
    for (int it = 0; bid + 2 * it * G < 4608; ++it) {
        int tid = tid_in; asm volatile("" : "+v"(tid)); const int lane = tid & 63, t2 = tid & 255;
        LAS uchar* L = L_in + half * G2_HALF; asm volatile("" : "+v"(L));
        LAS float* gam = (LAS float*)(L + G2_GAM); LAS float* bet = (LAS float*)(L + G2_BET);
        const int v = bid + (2 * it + half) * G; const bool act = v < 4608;
        int h = 0, dir = 0, b = 0, cidx = 0; if (act) gdn_decode(v, h, dir, b, cidx);
        const size_t slot = (size_t)((dir * 16 + b) * 4 + h) * 36 + cidx;
        if (act && h != cur_h) { cur_h = h;
            for (int i = t2; i < 576; i += 256) { const int wj = i >> 6, d = i & 63; ((LAS float*)(L + G2_CW))[i] = conv_w_l[(wj % 3) * 768 + (wj / 3) * 256 + h * 64 + d]; } }
        { const int vn = v + 2 * G; if (vn < 4608) gdn_load2(nxt, vn, DQKV, GB, t2, lane, wl); else nxt = cur; }
        if (act && wl == 0) { float s = cur.g;
#pragma unroll
            for (int o = 1; o < 64; o <<= 1) { const float t = __shfl_up(s, o); if (lane >= o) s += t; }
            gam[lane] = s; bet[lane] = cur.be; }
        __syncthreads();
        if (act) {
            const int i = t2 >> 2, part = t2 & 3;
            const float gi = gam[i], bi = bet[i], g63 = gam[63];
            const float eg = __expf(gi), ek = __expf(g63 - gi);
#pragma unroll
            for (int which = 0; which < 3; ++which) {
                float y[16]; float ss = 0.f;
#pragma unroll
                for (int p2 = 0; p2 < 2; ++p2) {
#pragma unroll
                    for (int e = 0; e < 8; ++e) y[p2 * 8 + e] = 0.f;
#pragma unroll
                    for (int j = 0; j < 3; ++j) { const u32x4 raw = cur.raw[p2][which][j]; const LAS float* wp = (const LAS float*)(L + G2_CW) + (which * 3 + j) * 64 + part * 16 + p2 * 8; const f32x4 w0 = *(const LAS f32x4*)wp, w1 = *(const LAS f32x4*)(wp + 4);
                        y[p2 * 8 + 0] += w0[0] * bflo(raw.x); y[p2 * 8 + 1] += w0[1] * bfhi(raw.x); y[p2 * 8 + 2] += w0[2] * bflo(raw.y); y[p2 * 8 + 3] += w0[3] * bfhi(raw.y);
                        y[p2 * 8 + 4] += w1[0] * bflo(raw.z); y[p2 * 8 + 5] += w1[1] * bfhi(raw.z); y[p2 * 8 + 6] += w1[2] * bflo(raw.w); y[p2 * 8 + 7] += w1[3] * bfhi(raw.w); }
                }
#pragma unroll
                for (int e = 0; e < 16; ++e) { y[e] = silu_f(y[e]); ss += y[e] * y[e]; }
                if (which < 2) { ss += sxor<1>(ss); ss += sxor<2>(ss); const float rn = rsqrtf(ss + 1e-6f) * (which == 0 ? 0.125f : 1.f);
#pragma unroll
                    for (int e = 0; e < 16; ++e) y[e] *= rn;
#pragma unroll
                    for (int p2 = 0; p2 < 2; ++p2) { u32x4 o; o.x = pk(y[p2 * 8], y[p2 * 8 + 1]); o.y = pk(y[p2 * 8 + 2], y[p2 * 8 + 3]); o.z = pk(y[p2 * 8 + 4], y[p2 * 8 + 5]); o.w = pk(y[p2 * 8 + 6], y[p2 * 8 + 7]);
                        *(LAS u32x4*)(L + (which == 0 ? G2_QH : G2_KH) + i * 144 + part * 32 + p2 * 16) = o; } }
                if (which == 1) {
#pragma unroll
                    for (int e = 0; e < 16; ++e) { const int d = part * 16 + e; *(LAS bf16_t*)(L + G2_KBT + d * 144 + i * 2) = f2bf(bi * eg * y[e]); *(LAS bf16_t*)(L + G2_KTT + d * 144 + i * 2) = f2bf(ek * y[e]); } }
                if (which == 2) {
#pragma unroll
                    for (int e = 0; e < 16; ++e) { const int d = part * 16 + e; *(LAS bf16_t*)(L + G2_VT + d * 144 + i * 2) = f2bf(bi * y[e]); } }
            }
        }
        __syncthreads();
        if (act) {
            const int ti = wl;
            const Frag2 kx = ldfrag(L + G2_KH, ti * 16, lane), qx = ldfrag(L + G2_QH, ti * 16, lane);
            Frag2 ky[4];
#pragma unroll
            for (int tj = 0; tj < 4; ++tj) ky[tj] = ldfrag(L + G2_KH, tj * 16, lane);
#pragma unroll
            for (int tj = 0; tj < 4; ++tj) {
                const f32x4 kk = mmf(kx, ky[tj]);
                const f32x4 qk = mmf(qx, ky[tj]);
                const int j = tj * 16 + (lane & 15); const float gj = gam[j];
#pragma unroll
                for (int idx = 0; idx < 4; ++idx) { const int i = ti * 16 + 4 * (lane >> 4) + idx; const float gi = gam[i], bi = bet[i]; const float dec = __expf(fminf(gi - gj, 0.f));
                    *(LAS bf16_t*)(L + G2_AB + i * 144 + j * 2) = f2bf((i > j) ? bi * kk[idx] * dec : 0.f);
                    *(LAS bf16_t*)(L + G2_QKM + i * 144 + j * 2) = f2bf((i >= j) ? qk[idx] * dec : 0.f); } }
        }
        __syncthreads();
        if (act && wl == half) {
            float t[32]; int c = lane & 31; const int hf = lane >> 5, r0 = 32 * hf; asm volatile("" : "+v"(c));
            const LAS uchar* ABp = L + G2_AB + r0 * 144 + r0 * 2;
            const unsigned oh = 1u << c;
            u32x4 buf[2][8];
#define SUB_LOAD(G_, B_) { const LAS uchar* pg_ = ABp; asm volatile("" : "+v"(pg_) : "v"(tdep)); _Pragma("unroll") for (int rr = 0; rr < 2; ++rr) { _Pragma("unroll") for (int j8 = 0; j8 < (2 * (G_) + rr + 7) / 8; ++j8) buf[B_][rr * 4 + j8] = *(const LAS u32x4*)(pg_ + (2 * (G_) + rr) * 144 + j8 * 16); } }
            float tdep = 0.f;
            SUB_LOAD(0, 0) SUB_LOAD(1, 1)
#pragma unroll
            for (int g = 0; g < 16; ++g) {
#pragma unroll
                for (int rr = 0; rr < 2; ++rr) { const int i = 2 * g + rr; float s0 = (float)((oh >> i) & 1u), s1 = 0.f;
#pragma unroll
                    for (int j8 = 0; j8 < (i + 7) / 8; ++j8) { const u32x4 w = buf[g & 1][rr * 4 + j8];
#pragma unroll
                        for (int e = 0; e < 8; ++e) { const int j = 8 * j8 + e;
                            if (j < i) { if (e & 1) s1 -= bfhi(w[e >> 1]) * t[j]; else s0 -= bflo(w[e >> 1]) * t[j]; } } }
                    t[i] = s0 + s1; }
                tdep = t[2 * g + 1];
                if (g + 2 < 16) SUB_LOAD(g + 2, g & 1)
            }
#undef SUB_LOAD
#pragma unroll
            for (int i = 0; i < 32; ++i) *(LAS bf16_t*)(L + G2_KH + (r0 + i) * 144 + (r0 + c) * 2) = f2bf(t[i]);
            if (hf == 0) {
#pragma unroll
                for (int i = 0; i < 32; ++i) *(LAS bf16_t*)(L + G2_KH + i * 144 + (32 + c) * 2) = (bf16_t)0;
#pragma unroll
                for (int j8 = 0; j8 < 4; ++j8) { u32x4 o; o.x = pk(t[8 * j8], t[8 * j8 + 1]); o.y = pk(t[8 * j8 + 2], t[8 * j8 + 3]); o.z = pk(t[8 * j8 + 4], t[8 * j8 + 5]); o.w = pk(t[8 * j8 + 6], t[8 * j8 + 7]);
                    *(LAS u32x4*)(L + G2_WT + c * 144 + j8 * 16) = o; }
            }
        }
        __syncthreads();
        if (act) {
            const int tm = wl >> 1, tc = wl & 1;
            const f32x4 acc = mm16k32(L + G2_AB, 32 + 16 * tm, 0, L + G2_WT, 16 * tc, 0, lane);
            const int cc = 16 * tc + (lane & 15), m0 = 16 * tm + 4 * (lane >> 4);
            u32x2 w; w.x = pk(acc[0], acc[1]); w.y = pk(acc[2], acc[3]);
            *(LAS u32x2*)(L + G2_WT + (32 + cc) * 144 + m0 * 2) = w;
        }
        __syncthreads();
        if (act) {
            const int ti = wl >> 1, tc = wl & 1;
            const f32x4 acc = mm16k32(L + G2_KH, 32 + 16 * ti, 32, L + G2_WT, 32 + 16 * tc, 0, lane);
            const int cc = 16 * tc + (lane & 15), i0 = 32 + 16 * ti + 4 * (lane >> 4);
#pragma unroll
            for (int idx = 0; idx < 4; ++idx) *(LAS bf16_t*)(L + G2_KH + (i0 + idx) * 144 + cc * 2) = f2bf(-acc[idx]);
        }
        __syncthreads();
        if (act) {
            const int ti = wl;
            const Frag2 tfr = ldfrag(L + G2_KH, ti * 16, lane);
            Frag2 yv[8];
#pragma unroll
            for (int tt = 0; tt < 8; ++tt) yv[tt] = ldfrag(L + ((tt >> 2) ? G2_KBT : G2_VT), (tt & 3) * 16, lane);
#pragma unroll
            for (int tt = 0; tt < 8; ++tt) { const int mat = tt >> 2, te = tt & 3;
                const f32x4 acc = mmf(tfr, yv[tt]);
                const int y = te * 16 + (lane & 15), i0 = ti * 16 + 4 * (lane >> 4);
                u32x2 w; w.x = pk(acc[0], acc[1]); w.y = pk(acc[2], acc[3]);
                *(LAS u32x2*)(L + (mat ? G2_WT : G2_AB) + y * 144 + i0 * 2) = w; }
        }
        __syncthreads();
        if (act) {
            const int mi = wl;
            const LAS uchar* X = L + (mi == 1 ? G2_AB : (mi == 3 ? G2_KTT : G2_WT));
            const LAS uchar* Y = L + ((mi == 0 || mi == 1) ? G2_QKM : (mi == 2 ? G2_KTT : G2_AB));
            const float a63 = __expf(gam[63]);
            Frag2 xf[4], yf[4];
#pragma unroll
            for (int a = 0; a < 4; ++a) { xf[a] = ldfrag(X, a * 16, lane); yf[a] = ldfrag(Y, a * 16, lane); }
#pragma unroll
            for (int tt = 0; tt < 16; ++tt) { const int tx = tt >> 2, ty = tt & 3;
                const f32x4 acc = mmf(xf[tx], yf[ty]);
                const int y = ty * 16 + (lane & 15), x0 = tx * 16 + 4 * (lane >> 4);
                if (mi == 0) {
                    const u32x2 qq = *(const LAS u32x2*)(L + G2_QH + y * 144 + x0 * 2); const float eg = __expf(gam[y]);
                    u32x2 w; w.x = pk(bflo(qq.x) * eg - acc[0], bfhi(qq.x) * eg - acc[1]); w.y = pk(bflo(qq.y) * eg - acc[2], bfhi(qq.y) * eg - acc[3]);
                    const int ir = dir ? 63 - y : y; *(u32x2*)(M1g + slot * 4096 + ir * 64 + x0) = w;
                } else if (mi == 1) {
                    u32x2 w; w.x = pk(acc[0], acc[1]); w.y = pk(acc[2], acc[3]);
                    const int ir = dir ? 63 - y : y; *(u32x2*)(O0g + slot * 4096 + ir * 64 + x0) = w;
                } else if (mi == 2) {
                    u32x2 w; w.x = pk((y == x0 ? a63 : 0.f) - acc[0], (y == x0 + 1 ? a63 : 0.f) - acc[1]); w.y = pk((y == x0 + 2 ? a63 : 0.f) - acc[2], (y == x0 + 3 ? a63 : 0.f) - acc[3]);
                    *(u32x2*)(M2g + slot * 4096 + y * 64 + x0) = w;
                } else {
                    u32x2 w; w.x = pk(acc[0], acc[1]); w.y = pk(acc[2], acc[3]); *(u32x2*)(S0Tg + slot * 4096 + y * 64 + x0) = w;
                }
            }
        }
        __syncthreads();
        cur = nxt;
    }
}

struct ScanIn { u32x2 m[16]; u32x2 c[4]; };
__device__ __forceinline__ void scan_load(ScanIn& in, const bf16_t* M2g, const bf16_t* S0Tg, size_t so, int e, int r, int q) {
#pragma unroll
    for (int t = 0; t < 4; ++t) { in.c[t] = *(const u32x2*)(S0Tg + so + e * 64 + 16 * t + 4 * q);
        const bf16_t* mrow = M2g + so + (16 * t + r) * 64 + 4 * q;
        in.m[4 * t + 0] = *(const u32x2*)(mrow); in.m[4 * t + 1] = *(const u32x2*)(mrow + 16); in.m[4 * t + 2] = *(const u32x2*)(mrow + 32); in.m[4 * t + 3] = *(const u32x2*)(mrow + 48); }
}
__device__ __forceinline__ void phase_scan(uchar* ws, int lane, int wave) {
    const int first = gridDim.x >> 1, nsb = gridDim.x - first;
    if ((int)blockIdx.x < first || wave >= 4) return;
    const bf16_t* M2g = (const bf16_t*)(ws + OFF_M2); const bf16_t* S0Tg = (const bf16_t*)(ws + OFF_S0T); bf16_t* STg = (bf16_t*)(ws + OFF_ST);
    const int r = lane & 15, q = lane >> 4;
    for (int item = ((int)blockIdx.x - first) * 4 + wave; item < 512; item += nsb * 4) {
        const int chain = item >> 2, e = (item & 3) * 16 + r;
        f32x4 S[4];
#pragma unroll
        for (int t = 0; t < 4; ++t) S[t] = (f32x4){0.f, 0.f, 0.f, 0.f};
        ScanIn in0, in1, in2;
        const size_t cb0 = (size_t)chain * 36 * 4096;
        scan_load(in0, M2g, S0Tg, cb0, e, r, q); scan_load(in1, M2g, S0Tg, cb0 + 4096, e, r, q); scan_load(in2, M2g, S0Tg, cb0 + 2 * 4096, e, r, q);
#define SCAN_STEP(IN, n_) do { const size_t so = cb0 + (size_t)(n_) * 4096; \
            u32x4 y0, y1; \
            y0.x = pk(S[0][0], S[0][1]); y0.y = pk(S[0][2], S[0][3]); y0.z = pk(S[1][0], S[1][1]); y0.w = pk(S[1][2], S[1][3]); \
            y1.x = pk(S[2][0], S[2][1]); y1.y = pk(S[2][2], S[2][3]); y1.z = pk(S[3][0], S[3][1]); y1.w = pk(S[3][2], S[3][3]); \
            *(u32x2*)(STg + so + e * 64 + 4 * q) = (u32x2){y0.x, y0.y}; *(u32x2*)(STg + so + e * 64 + 16 + 4 * q) = (u32x2){y0.z, y0.w}; \
            *(u32x2*)(STg + so + e * 64 + 32 + 4 * q) = (u32x2){y1.x, y1.y}; *(u32x2*)(STg + so + e * 64 + 48 + 4 * q) = (u32x2){y1.z, y1.w}; \
            const bf16x8 yb0 = __builtin_bit_cast(bf16x8, y0), yb1 = __builtin_bit_cast(bf16x8, y1); \
            _Pragma("unroll") for (int t = 0; t < 4; ++t) { const u32x2 c = IN.c[t]; f32x4 C = {bflo(c.x), bfhi(c.x), bflo(c.y), bfhi(c.y)}; \
                const bf16x8 x0 = __builtin_bit_cast(bf16x8, (u32x4){IN.m[4 * t].x, IN.m[4 * t].y, IN.m[4 * t + 1].x, IN.m[4 * t + 1].y}); \
                const bf16x8 x1 = __builtin_bit_cast(bf16x8, (u32x4){IN.m[4 * t + 2].x, IN.m[4 * t + 2].y, IN.m[4 * t + 3].x, IN.m[4 * t + 3].y}); \
                C = mfma16(x0, yb0, C); C = mfma16(x1, yb1, C); S[t] = C; } \
            if ((n_) + 3 < 36) scan_load(IN, M2g, S0Tg, so + 3 * 4096, e, r, q); } while (0)
        for (int n = 0; n < 36; n += 3) { SCAN_STEP(in0, n); SCAN_STEP(in1, n + 1); SCAN_STEP(in2, n + 2); }
#undef SCAN_STEP
    }
}

__device__ __forceinline__ void phase_gdn_out(uchar* ws, const float* ong, bool need_ctx, int lane, int wave) {
    const bf16_t* M1g = (const bf16_t*)(ws + OFF_M1); const bf16_t* O0g = (const bf16_t*)(ws + OFF_O0T); const bf16_t* STg = (const bf16_t*)(ws + OFF_ST);
    const bf16_t* DZ = (const bf16_t*)(ws + OFF_DZ); bf16_t* CAT = (bf16_t*)(ws + OFF_CAT);
    const int r = lane & 15, q = lane >> 4, ti = wave & 3;
    for (int unit = blockIdx.x * 2 + (wave >> 2); unit < 2304; unit += gridDim.x * 2) {
        const int b = unit / 144, rem = unit % 144, h = rem / 36, cpos = rem % 36;
        const bool isctx = cpos < 4; if (isctx && !need_ctx) continue;
        const int cb = isctx ? 3 - cpos : 39 - cpos;
        const size_t sof = ((size_t)((0 * 16 + b) * 4 + h) * 36 + cpos) * 4096, sob = ((size_t)((16 + b) * 4 + h) * 36 + cb) * 4096;
        const int i = 16 * ti + r;
        f32x4 acc[4];
#pragma unroll
        for (int te = 0; te < 4; ++te) { const int e0 = te * 16 + 4 * q;
            const u32x2 cf = *(const u32x2*)(O0g + sof + i * 64 + e0), cbk = *(const u32x2*)(O0g + sob + i * 64 + e0);
            acc[te] = (f32x4){bflo(cf.x) + bflo(cbk.x), bfhi(cf.x) + bfhi(cbk.x), bflo(cf.y) + bflo(cbk.y), bfhi(cf.y) + bfhi(cbk.y)}; }
#pragma unroll
        for (int dn = 0; dn < 2; ++dn) { const size_t so = dn ? sob : sof;
#pragma unroll
            for (int ks = 0; ks < 2; ++ks) { const bf16x8 y = *(const bf16x8*)(M1g + so + i * 64 + 32 * ks + 8 * q);
#pragma unroll
                for (int te = 0; te < 4; ++te) { const bf16x8 x = *(const bf16x8*)(STg + so + (te * 16 + r) * 64 + 32 * ks + 8 * q); acc[te] = mfma16(x, y, acc[te]); } } }
        float ss = 0.f;
#pragma unroll
        for (int te = 0; te < 4; ++te) ss += (acc[te][0] * acc[te][0] + acc[te][1] * acc[te][1]) + (acc[te][2] * acc[te][2] + acc[te][3] * acc[te][3]);
        ss += sxor<16>(ss); ss = sum32(ss);
        const float rinv = rsqrtf(ss * (1.f / 64.f) + 1e-6f);
        const size_t tok = (isctx ? (size_t)TL + b * 256 + cpos * 64 : (size_t)b * 2048 + (cpos - 4) * 64) + i;
#pragma unroll
        for (int te = 0; te < 4; ++te) { const int e0 = te * 16 + 4 * q;
            const u32x2 dz = *(const u32x2*)(DZ + tok * 256 + h * 64 + e0); const f32x4 og = *(const f32x4*)(ong + e0);
            u32x2 w; w.x = pk(acc[te][0] * rinv * og[0] * silu_f(bflo(dz.x)), acc[te][1] * rinv * og[1] * silu_f(bfhi(dz.x)));
            w.y = pk(acc[te][2] * rinv * og[2] * silu_f(bflo(dz.y)), acc[te][3] * rinv * og[3] * silu_f(bfhi(dz.y)));
            *(u32x2*)(CAT + tok * 1024 + 768 + h * 64 + e0) = w; }
    }
}

constexpr int AL_K = 0, AL_V = 18432;
__device__ __forceinline__ void attn_unit(LAS uchar* L, const bf16_t* Qb, const bf16_t* Kb, const bf16_t* VTl, const bf16_t* VTc, bf16_t* CAT,
                                          int b, int head, size_t qrow0, bool lat, int tid, int lane, int wave) {
    const int kvh = head >> 2, ntile = lat ? 36 : 4;
    const int r32 = lane & 31, hi = lane >> 5;
    const size_t qrow = qrow0 + wave * 32 + r32;
    bf16x8 qf[4];
#pragma unroll
    for (int ks = 0; ks < 4; ++ks) qf[ks] = *(const bf16x8*)(Qb + qrow * 512 + head * 64 + 16 * ks + 8 * hi);
    f32x16 o0, o1;
#pragma unroll
    for (int i = 0; i < 16; ++i) { o0[i] = 0.f; o1[i] = 0.f; }
    float mrun = -INFINITY, lsum = 0.f;
    const int lrow = tid >> 3, lch = tid & 7;
    const float LOG2E = 1.4426950408889634f;
    const bf16_t* kl = Kb + ((size_t)b * 2048 + lrow) * 128 + kvh * 64 + 8 * lch;
    const bf16_t* kc = Kb + ((size_t)TL + b * 256 + lrow) * 128 + kvh * 64 + 8 * lch;
    const bf16_t* vl = VTl + ((size_t)(b * 2 + kvh) * 64 + lrow) * 2048 + 8 * lch;
    const bf16_t* vc = VTc + ((size_t)(b * 2 + kvh) * 64 + lrow) * 256 + 8 * lch;
    u32x4 kreg, vreg;
#define ATT_LOAD(t) do { const int t_ = (t); if (lat && t_ < 32) { kreg = *(const u32x4*)(kl + (size_t)t_ * 64 * 128); vreg = *(const u32x4*)(vl + t_ * 64); } \
        else { const int tc_ = lat ? t_ - 32 : t_; kreg = *(const u32x4*)(kc + (size_t)tc_ * 64 * 128); vreg = *(const u32x4*)(vc + tc_ * 64); } } while (0)
#define ATT_STORE(buf) do { *(LAS u32x4*)(L + AL_K + (buf) * 9216 + lrow * 144 + lch * 16) = kreg; *(LAS u32x2*)(L + AL_V + (buf) * 9216 + lrow * 136 + lch * 16) = (u32x2){vreg.x, vreg.y}; *(LAS u32x2*)(L + AL_V + (buf) * 9216 + lrow * 136 + lch * 16 + 8) = (u32x2){vreg.z, vreg.w}; } while (0)
    __syncthreads();
    ATT_LOAD(0); ATT_STORE(0);
    __syncthreads();
    for (int t = 0; t < ntile; ++t) {
        const int buf = t & 1;
        if (t + 1 < ntile) ATT_LOAD(t + 1);
        const LAS uchar* Kt = L + AL_K + buf * 9216; const LAS uchar* Vt = L + AL_V + buf * 9216;
        f32x16 s0, s1;
#pragma unroll
        for (int i = 0; i < 16; ++i) { s0[i] = 0.f; s1[i] = 0.f; }
#pragma unroll
        for (int ks = 0; ks < 4; ++ks) {
            const bf16x8 k0 = *(const LAS bf16x8*)(Kt + r32 * 144 + ks * 32 + hi * 16);
            const bf16x8 k1 = *(const LAS bf16x8*)(Kt + (32 + r32) * 144 + ks * 32 + hi * 16);
            s0 = mfma32(k0, qf[ks], s0); s1 = mfma32(k1, qf[ks], s1);
        }
        float mx = s0[0];
#pragma unroll
        for (int i = 1; i < 16; ++i) mx = fmaxf(mx, s0[i]);
#pragma unroll
        for (int i = 0; i < 16; ++i) mx = fmaxf(mx, s1[i]);
        mx = max32(mx);
        const float mnew = fmaxf(mrun, mx * LOG2E);
        const float alpha = __builtin_amdgcn_exp2f(mrun - mnew);
        mrun = mnew;
        float ps = 0.f;
#pragma unroll
        for (int i = 0; i < 16; ++i) { s0[i] = __builtin_amdgcn_exp2f(s0[i] * LOG2E - mnew); s1[i] = __builtin_amdgcn_exp2f(s1[i] * LOG2E - mnew); ps += s0[i] + s1[i]; }
        lsum = lsum * alpha + ps;
        if (__any(alpha != 1.f)) {
#pragma unroll
            for (int i = 0; i < 16; ++i) { o0[i] *= alpha; o1[i] *= alpha; } }
#pragma unroll
        for (int kk = 0; kk < 2; ++kk)
#pragma unroll
            for (int kst = 0; kst < 2; ++kst) {
                u32x4 pw;
                if (kk == 0) { pw.x = pk(s0[8 * kst + 0], s0[8 * kst + 1]); pw.y = pk(s0[8 * kst + 2], s0[8 * kst + 3]); pw.z = pk(s0[8 * kst + 4], s0[8 * kst + 5]); pw.w = pk(s0[8 * kst + 6], s0[8 * kst + 7]); }
                else         { pw.x = pk(s1[8 * kst + 0], s1[8 * kst + 1]); pw.y = pk(s1[8 * kst + 2], s1[8 * kst + 3]); pw.z = pk(s1[8 * kst + 4], s1[8 * kst + 5]); pw.w = pk(s1[8 * kst + 6], s1[8 * kst + 7]); }
                const bf16x8 pf = __builtin_bit_cast(bf16x8, pw);
                const int kof = (32 * kk + 16 * kst + 4 * hi) * 2;
                const u32x2 a0 = *(const LAS u32x2*)(Vt + r32 * 136 + kof), a1 = *(const LAS u32x2*)(Vt + r32 * 136 + kof + 16);
                const u32x2 c0 = *(const LAS u32x2*)(Vt + (32 + r32) * 136 + kof), c1 = *(const LAS u32x2*)(Vt + (32 + r32) * 136 + kof + 16);
                o0 = mfma32(__builtin_bit_cast(bf16x8, (u32x4){a0.x, a0.y, a1.x, a1.y}), pf, o0);
                o1 = mfma32(__builtin_bit_cast(bf16x8, (u32x4){c0.x, c0.y, c1.x, c1.y}), pf, o1);
            }
        if (t + 1 < ntile) ATT_STORE(buf ^ 1);
        __syncthreads();
    }
#undef ATT_LOAD
#undef ATT_STORE
    lsum = sum32(lsum);
    const float inv = __builtin_amdgcn_rcpf(lsum);
    bf16_t* dst = CAT + qrow * 1024 + 256 + head * 64 + 4 * hi;
#pragma unroll
    for (int g = 0; g < 4; ++g) {
        u32x2 w0, w1; w0.x = pk(o0[4 * g] * inv, o0[4 * g + 1] * inv); w0.y = pk(o0[4 * g + 2] * inv, o0[4 * g + 3] * inv);
        w1.x = pk(o1[4 * g] * inv, o1[4 * g + 1] * inv); w1.y = pk(o1[4 * g + 2] * inv, o1[4 * g + 3] * inv);
        *(u32x2*)(dst + 8 * g) = w0; *(u32x2*)(dst + 32 + 8 * g) = w1;
    }
}

__device__ __forceinline__ void phase_attn(uchar* ws, unsigned* counter, bool need_ctx, LAS uchar* L, int tid, int lane, int wave) {
    const bf16_t* Qb = (const bf16_t*)(ws + OFF_Q); const bf16_t* Kb = (const bf16_t*)(ws + OFF_K);
    const bf16_t* VTl = (const bf16_t*)(ws + OFF_VTL); const bf16_t* VTc = (const bf16_t*)(ws + OFF_VTC); bf16_t* CAT = (bf16_t*)(ws + OFF_CAT);
    const int nunits = 1024 + (need_ctx ? 128 : 0);
    volatile LAS int* ubox = (volatile LAS int*)(L + LDS_MISC + 1040);
    for (;;) {
        __syncthreads();
        if (tid == 0) *ubox = (int)atomicAdd(counter, 1u);
        __syncthreads();
        const int u = *ubox;
        if (u >= nunits) break;
        if (u < 1024) { const int b = u >> 6, head = (u >> 3) & 7, qb = u & 7; attn_unit(L, Qb, Kb, VTl, VTc, CAT, b, head, (size_t)b * 2048 + qb * 256, true, tid, lane, wave); }
        else { const int v = u - 1024, b = v >> 3, head = v & 7; attn_unit(L, Qb, Kb, VTl, VTc, CAT, b, head, (size_t)TL + b * 256, false, tid, lane, wave); }
    }
}

#define GAS __attribute__((address_space(1)))
typedef GAS unsigned gu32;
typedef GAS unsigned long long gu64;
#define RLX_AGENT __ATOMIC_RELAXED, __HIP_MEMORY_SCOPE_AGENT
#define LDS_WAIT() asm volatile("s_waitcnt lgkmcnt(0)" ::: "memory")
#define VM_WAIT() asm volatile("s_waitcnt vmcnt(0)" ::: "memory")
__device__ __forceinline__ unsigned long long rt() { return __builtin_amdgcn_s_memrealtime(); }
#define XB_TMO      128
#define XB_XCNT(j)  (256  + 64 * (j))
#define XB_XSUB(j)  (1280 + 64 * (j))
#define XB_XGEN(j)  (2304 + 64 * (j))
#define XB_TOP      3328
#define XB_TOPGEN   3392
#define XCD_BAR_WORDS 3456
#define XB_SPIN_CAP (1u << 18)

__device__ __forceinline__ unsigned xb_ld(unsigned* p)              { return __hip_atomic_load(p, __ATOMIC_RELAXED, __HIP_MEMORY_SCOPE_AGENT); }
__device__ __forceinline__ unsigned xb_add(unsigned* p, unsigned v) { return __hip_atomic_fetch_add(p, v, __ATOMIC_RELAXED, __HIP_MEMORY_SCOPE_AGENT); }
__device__ __forceinline__ unsigned xb_xcc_id() { return (unsigned)__builtin_amdgcn_s_getreg((3 << 11) | 20) & 0xFu; }
#define XB_SPIN(cond, bar) do { unsigned _sp = 0; while (cond) { __builtin_amdgcn_s_sleep(1); \
    if ((++_sp & 255u) == 0u) { if (xb_ld(&(bar)[XB_TMO])) break; if (_sp > XB_SPIN_CAP) { atomicAdd(&(bar)[XB_TMO], 1u); break; } } } } while (0)

struct XcdBarrier {
    unsigned* bar; unsigned x;
    volatile LAS unsigned* st;
};

__device__ __forceinline__ XcdBarrier xcd_barrier_post(unsigned* bar, volatile LAS unsigned* st, bool leader) {
    XcdBarrier b; b.bar = bar; b.x = xb_xcc_id(); b.st = st;
    if (leader) (void)xb_add(&bar[XB_XCNT(b.x)], 1u);
    return b;
}
__device__ __forceinline__ void xcd_barrier_complete(unsigned* bar, unsigned x, unsigned& nloc, unsigned& nx) {
    const unsigned G = gridDim.x * gridDim.y * gridDim.z;
    unsigned sum, cnt, mine, sp = 0u;
    for (;;) {
        sum = 0u; cnt = 0u; mine = 0u;
#pragma unroll
        for (unsigned j = 0; j < 16; ++j) { const unsigned c = xb_ld(&bar[XB_XCNT(j)]); sum += c; cnt += (c > 0u) ? 1u : 0u; mine = (j == x) ? c : mine; }
        if (sum == G) break;
        __builtin_amdgcn_s_sleep(1);
        if ((++sp & 255u) == 0u) { if (xb_ld(&bar[XB_TMO])) break; if (sp > XB_SPIN_CAP) { atomicAdd(&bar[XB_TMO], 1u); break; } }
    }
    nloc = mine > 0u ? mine : 1u; nx = cnt > 0u ? cnt : 1u;
}

__device__ __forceinline__ void xcd_barrier(const XcdBarrier& b, bool leader) {
    asm volatile("s_waitcnt vmcnt(0)" ::: "memory");
    __syncthreads();
    if (leader) {
        unsigned* bar = b.bar;
        __builtin_amdgcn_s_waitcnt(0);
        unsigned nloc = b.st[0], nx = b.st[1];
        if (nloc == 0u) { xcd_barrier_complete(bar, b.x, nloc, nx); b.st[0] = nloc; b.st[1] = nx; }
        const unsigned old = xb_add(&bar[XB_XSUB(b.x)], 1u);
        const unsigned gen = old / nloc;
        if (old + 1u == (gen + 1u) * nloc) {
            __builtin_amdgcn_fence(__ATOMIC_RELEASE, "agent");
            asm volatile("s_waitcnt vmcnt(0)" ::: "memory");
            const unsigned og = xb_add(&bar[XB_TOP], 1u);
            const unsigned tg = og / nx;
            if (og + 1u == (tg + 1u) * nx) xb_add(&bar[XB_TOPGEN], 1u);
            else XB_SPIN(xb_ld(&bar[XB_TOPGEN]) == tg, bar);
            __builtin_amdgcn_fence(__ATOMIC_ACQUIRE, "agent");
            xb_add(&bar[XB_XGEN(b.x)], 1u);
            asm volatile("s_waitcnt vmcnt(0)" ::: "memory");
        } else {
            XB_SPIN(xb_ld(&bar[XB_XGEN(b.x)]) == gen, bar);
            __builtin_amdgcn_fence(__ATOMIC_ACQUIRE, "agent");
            asm volatile("s_waitcnt vmcnt(0)" ::: "memory");
        }
    }
    __syncthreads();
}

#ifndef REP_PRE
#define REP_PRE 1
#endif
#ifndef REP_SCAN
#define REP_SCAN 1
#endif
#ifndef REP_ATTN
#define REP_ATTN 1
#endif
#ifndef REP_OUT
#define REP_OUT 1
#endif
#ifndef REP_NORM
#define REP_NORM 1
#endif
#ifndef REP_PRO
#define REP_PRO 1
#endif
#ifndef REP_G1
#define REP_G1 1
#endif
#ifndef REP_FOUR
#define REP_FOUR 1
#endif
#ifndef REP_F1
#define REP_F1 1
#endif
#ifndef REP_SYNC
#define REP_SYNC 1
#endif
typedef const __attribute__((address_space(4))) Params CParams;
#define PH_BEGIN { CParams* kp = (CParams*)__builtin_amdgcn_kernarg_segment_ptr(); int w0_ = wave0; unsigned on_ = ~0u; asm volatile("" : "+s"(w0_), "+s"(on_)); int tid = w0_ * 64 + (int)__builtin_amdgcn_mbcnt_hi(on_, __builtin_amdgcn_mbcnt_lo(on_, 0u)); LAS uchar* Lv = L; asm volatile("" : "+s"(kp), "+v"(tid), "+v"(Lv)); (void)Lv; \
    uchar* ws = kp->ws; const int lane = tid & 63, wave = __builtin_amdgcn_readfirstlane(tid >> 6); const int G = gridDim.x, bid = blockIdx.x; \
    const float* mod = (const float*)(ws + OFF_MOD); float* XC = (float*)(ws + OFF_XC); bf16_t* H = (bf16_t*)(ws + OFF_H); bf16_t* CAT = (bf16_t*)(ws + OFF_CAT); bf16_t* U = (bf16_t*)(ws + OFF_U); \
    const float* modl = mod + (size_t)l * 17 * 6144; uchar* wb = ws + OFF_WB + (size_t)l * WB_LAYER; float* OUT = kp->out; \
    (void)lane; (void)wave; (void)XC; (void)H; (void)CAT; (void)U; (void)modl; (void)wb; (void)G; (void)bid; (void)OUT;
#define PH_END }
#define GSYNC() do { CParams* kq_ = (CParams*)__builtin_amdgcn_kernarg_segment_ptr(); asm volatile("" : "+s"(kq_)); XcdBarrier xb_; xb_.bar = (unsigned*)(kq_->ws + 8192); xb_.x = xb_xcc_id(); \
    xb_.st = (volatile LAS unsigned*)(L + LDS_MISC + 1024); unsigned on2_ = ~0u; asm volatile("" : "+s"(on2_)); const bool ld_ = (wave0 == 0) && (__builtin_amdgcn_mbcnt_hi(on2_, __builtin_amdgcn_mbcnt_lo(on2_, 0u)) == 0u); for (int rs_ = 0; rs_ < REP_SYNC; ++rs_) xcd_barrier(xb_, ld_); } while (0)
#define IN(k) (kp->in[k])

__global__ void __launch_bounds__(512) mega(Params p) {
    extern __shared__ __attribute__((aligned(16))) unsigned char lds[];
    cg::grid_group grid = cg::this_grid();
    LAS uchar* L = (LAS uchar*)lds;
    const int wave0 = __builtin_amdgcn_readfirstlane(threadIdx.x >> 6);
    if (blockIdx.x == 0) { unsigned* bw = (unsigned*)(p.ws + 8192); for (int i = threadIdx.x; i < XCD_BAR_WORDS; i += 512) bw[i] = 0u; if (threadIdx.x < 128) ((unsigned*)(p.ws + 8192 + 16384))[threadIdx.x] = 0u; }
    if (threadIdx.x < 2) ((volatile LAS unsigned*)(L + LDS_MISC + 1024))[threadIdx.x] = 0u;
    if (blockIdx.x == 0) __threadfence();
    grid.sync();
    (void)xcd_barrier_post((unsigned*)(p.ws + 8192), (volatile LAS unsigned*)(L + LDS_MISC + 1024), threadIdx.x == 0);
    { const int l = 0;
    for (int rep_ = 0; rep_ < REP_PRO; ++rep_) { PH_BEGIN phase_prologue(kp, Lv, tid, lane, wave); PH_END __syncthreads(); }
    GSYNC();
    PH_BEGIN phase_norm<true, false>(IN(0), IN(2), TT, IN(4), mod, 0, 1, H, IN(8), IN(12), IN(13), (float*)(ws + OFF_GB), Lv, tid, lane, wave); PH_END
    GSYNC();
    }
#pragma unroll
    for (int l = 0; l < 2; ++l) {
        const bool last = (l == 1);
        const int Mrows = last ? TL : TT;
        PH_BEGIN {
            pg8::Gemm g{H, (const bf16_t*)(wb + WB_W1), TT, 2304, 1024, 1024};
            EpiProj E{ws, IN(10) + l * 64, IN(11) + l * 64};
            if (!last) { pg8::StaticOrder S; S.init(TT, 2304, G, bid); pg8::gemm_phase<EpiProj, pg8::StaticOrder, true, true>(L, g, S, E, tid); }
            else { OrderL1 S; S.init(G, bid); pg8::gemm_phase<EpiProj, OrderL1, true, true>(L, g, S, E, tid); }
        } PH_END
        GSYNC();
        for (int rep_ = 0; rep_ < REP_PRE; ++rep_) { PH_BEGIN phase_gdn_pre2(ws, IN(9) + (size_t)l * 3 * 768, Lv, tid, wave); PH_END if (rep_ + 1 < REP_PRE) GSYNC(); }
        GSYNC();
        for (int rep_ = 0; rep_ < REP_SCAN; ++rep_) { PH_BEGIN phase_scan(ws, lane, wave); PH_END __syncthreads(); }
        __syncthreads();
        PH_BEGIN {
            pg8::Gemm g{(const bf16_t*)(ws + OFF_DFTL), (const bf16_t*)(ws + OFF_GTL), 2048, 4096, 4096, 4096}; pg8::StaticOrder S; S.init(2048, 4096, G, bid);
            EpiFourier E{CAT, 0, 2048};
            for (int rep_ = 0; rep_ < REP_FOUR; ++rep_) { pg8::gemm_phase<EpiFourier, pg8::StaticOrder, true, true>(L, g, S, E, tid); __syncthreads(); }
        } PH_END
        if (!last) PH_BEGIN {
            __syncthreads();
            pg8::Gemm g{(const bf16_t*)(ws + OFF_DFTC), (const bf16_t*)(ws + OFF_GTC), 256, 4096, 512, 512}; pg8::StaticOrder S; S.init(256, 4096, G, bid);
            EpiFourier E{CAT, TL, 256};
            pg8::gemm_phase<EpiFourier, pg8::StaticOrder, true, true>(L, g, S, E, tid);
        } PH_END
        __syncthreads();
        for (int rep_ = 0; rep_ < REP_ATTN; ++rep_) { PH_BEGIN phase_attn(ws, (unsigned*)(ws + 8192 + 16384) + l * 64, !last, Lv, tid, lane, wave); PH_END __syncthreads(); }
        GSYNC();
        for (int rep_ = 0; rep_ < REP_OUT; ++rep_) { PH_BEGIN phase_gdn_out(ws, IN(14) + l * 64, !last, lane, wave); PH_END __syncthreads(); }
        GSYNC();
        PH_BEGIN {
            const bool split = false;
            pg8::Gemm g{CAT, (const bf16_t*)(wb + WB_WO), split ? TL : Mrows, 1024, 1024, 1024}; pg8::StaticOrder S; S.init(split ? TL : Mrows, 1024, G, bid);
            EpiResid E{last ? (const float*)OUT : IN(0), OUT, last ? (const float*)XC : IN(2), XC, modl + 2 * 1024};
            pg8::gemm_phase<EpiResid, pg8::StaticOrder, true, true>(L, g, S, E, tid);
            if (split) {
                __syncthreads();
                const int kq = bid >> 6;
                pg8::Gemm g2{CAT + (size_t)TL * 1024 + kq * 256, (const bf16_t*)(wb + WB_WO) + kq * 256, TC, 1024, 256, 1024}; pg8::StaticOrder S2; S2.init(TC, 1024, 64, bid & 63);
                EpiSplit E2{kq == 0 ? IN(2) : nullptr, kq == 0 ? XC : (float*)(ws + OFF_PART2) + (size_t)(kq - 1) * TC * 1024, modl + 2 * 1024 + 16 * 6144};
                pg8::gemm_phase<EpiSplit, pg8::StaticOrder, true, true>(L, g2, S2, E2, tid);
            }
        } PH_END
        GSYNC();
        for (int rep_ = 0; rep_ < REP_NORM; ++rep_) { PH_BEGIN if (false) phase_norm<false, true>(OUT, XC, Mrows, IN(5) + l * 1024, modl, 3, 4, H, nullptr, nullptr, nullptr, nullptr, Lv, tid, lane, wave, (const float*)(ws + OFF_PART2), XC); else phase_norm<false, false>(OUT, XC, Mrows, IN(5) + l * 1024, modl, 3, 4, H, nullptr, nullptr, nullptr, nullptr, Lv, tid, lane, wave); PH_END __syncthreads(); }
        GSYNC();
        PH_BEGIN {
            pg8::Gemm g{H, (const bf16_t*)(wb + WB_F1), Mrows, 4096, 1024, 1024}; pg8::StaticOrder S; S.init(Mrows, 4096, G, bid);
            EpiRelu2P E{U};
for (int rep_ = 0; rep_ < REP_F1; ++rep_) { pg8::gemm_phase<EpiRelu2P, pg8::StaticOrder, true, true>(L, g, S, E, tid); __syncthreads(); }
        } PH_END
        GSYNC();
        PH_BEGIN {
            const bool split = false;
            pg8::Gemm g{U, (const bf16_t*)(wb + WB_F2), split ? TL : Mrows, 1024, 4096, 4096}; RevOrder S; S.init(split ? TL : Mrows, 1024, G, bid);
            EpiResid E{OUT, OUT, XC, XC, modl + 5 * 1024};
            pg8::gemm_phase<EpiResid, RevOrder, true, true>(L, g, S, E, tid);
            if (split) {
                __syncthreads();
                const int kq = bid >> 6;
                pg8::Gemm g2{U + (size_t)TL * 4096 + kq * 1024, (const bf16_t*)(wb + WB_F2) + kq * 1024, TC, 1024, 1024, 4096}; pg8::StaticOrder S2; S2.init(TC, 1024, 64, bid & 63);
                EpiSplit E2{kq == 0 ? (const float*)XC : nullptr, kq == 0 ? XC : (float*)(ws + OFF_PARTF) + (size_t)(kq - 1) * TC * 1024, modl + 5 * 1024 + 16 * 6144};
                pg8::gemm_phase<EpiSplit, pg8::StaticOrder, true, true>(L, g2, S2, E2, tid);
            }
        } PH_END
#if NAN_SCRUB
        if (last) {
            GSYNC();
            PH_BEGIN for (size_t i = (size_t)bid * 512 + tid; i < (size_t)TL * 1024; i += (size_t)G * 512) { float v = OUT[i]; if (!(fabsf(v) < 1e30f)) OUT[i] = 0.f; } PH_END
        }
#endif
        if (!last) {
            GSYNC();
            for (int rep_ = 0; rep_ < REP_NORM; ++rep_) { PH_BEGIN if (false) phase_norm<true, true>(OUT, XC, TT, IN(4) + 1024, mod + (size_t)17 * 6144, 0, 1, H, IN(8) + (size_t)1024 * 2064, IN(12) + 8, IN(13) + 8, (float*)(ws + OFF_GB), Lv, tid, lane, wave, (const float*)(ws + OFF_PARTF), nullptr); else phase_norm<true, false>(OUT, XC, TT, IN(4) + 1024, mod + (size_t)17 * 6144, 0, 1, H, IN(8) + (size_t)1024 * 2064, IN(12) + 8, IN(13) + 8, (float*)(ws + OFF_GB), Lv, tid, lane, wave); PH_END __syncthreads(); }
            GSYNC();
        }
    }
}

extern "C" void kernel_launch(void* const* d_in, const int* in_sizes, int n_in, void* d_out, int out_size, void* d_ws, size_t ws_size, hipStream_t stream) {
    static int grid = 0;
    if (!grid) {
        int dev = 0, cus = 0, per_cu = 0;
        (void)hipGetDevice(&dev);
        (void)hipDeviceGetAttribute(&cus, hipDeviceAttributeMultiprocessorCount, dev);
        (void)hipFuncSetAttribute((const void*)mega, hipFuncAttributeMaxDynamicSharedMemorySize, LDS_BYTES);
        (void)hipOccupancyMaxActiveBlocksPerMultiprocessor(&per_cu, (const void*)mega, 512, LDS_BYTES);
        if (per_cu < 1) per_cu = 1;
        grid = cus * per_cu;
        if (ws_size < WS_END) { fprintf(stderr, "kernel_launch: workspace too small: %zu < %zu\n", ws_size, (size_t)WS_END); grid = -1; }
    }
    if (grid < 0) return;
    Params p{};
    for (int i = 0; i < 18; ++i) p.in[i] = (const float*)d_in[i];
    p.out = (float*)d_out; p.ws = (unsigned char*)d_ws;
    void* args[] = {&p};
    hipError_t e = hipLaunchCooperativeKernel((const void*)mega, dim3(grid), dim3(512), args, LDS_BYTES, stream);
    if (e != hipSuccess) fprintf(stderr, "cooperative launch failed: %s (grid %d)\n", hipGetErrorString(e), grid);
}
```

```cpp
#include <hip/hip_runtime.h>
#include <hip/hip_cooperative_groups.h>
#include <cstdio>
#include <cstdint>
#include <cmath>
namespace cg = cooperative_groups;
#define NAN_SCRUB 0
#define DIAG 0
namespace pg8 {
#define PG8_LAS __attribute__((address_space(3)))
typedef unsigned short bf16_t;
typedef short bf16x8 __attribute__((ext_vector_type(8)));
typedef float f32x4 __attribute__((ext_vector_type(4)));
typedef unsigned u32x4 __attribute__((ext_vector_type(4)));
constexpr int BM = 256, BK = 64, HALF = 128, HTB = HALF * BK * 2  , STAGE_BYTES = 8 * HTB, NXCD = 8, WGM = 4;

__host__ __device__ __forceinline__ int lds_byte(int r, int c) { const int st = (r >> 4) * 2 + (c >> 5), rr = r & 15, cc = c & 31, ob = rr * 64 + cc * 2; return st * 1024 + (ob ^ (((ob >> 9) & 1) << 5)); }
__host__ __device__ __forceinline__ void stage_rc(int b, int& R, int& C) { const int st = b / 1024, sb = b % 1024, swz = sb ^ (((sb >> 9) & 1) << 5); R = (st >> 1) * 16 + swz / 64; C = (st & 1) * 32 + (swz % 64) / 2; }
__host__ __device__ __forceinline__ int perm32(int rho) { const int n = rho >> 4, i = rho & 15; return 8 * (i >> 2) + 4 * n + (i & 3); }

struct Unit { int pm, pn; };
struct Gemm { const bf16_t* A; const bf16_t* Bt; int M, N, K, ld; };

struct StaticOrder {
    int nM, nN, nwg, G, c;
    __host__ __device__ void init(int M, int N, int G_, int c_) { nM = M / BM; nN = N / BM; nwg = nM * nN; G = G_; c = c_; }
    __host__ __device__ bool next(int i, Unit& u) const {
        const long L = (long)i * G + c; if (L >= nwg) return false;
        int wgid = (int)L; { const int q = nwg / NXCD, r = nwg % NXCD, xcd = wgid % NXCD, off = wgid / NXCD; wgid = (xcd < r ? xcd * (q + 1) : r * (q + 1) + (xcd - r) * q) + off; }
        const int nig = WGM * nN, gid = wgid / nig, fm = gid * WGM, gsz = (nM - fm) < WGM ? (nM - fm) : WGM;
        u.pm = fm + ((wgid % nig) % gsz); u.pn = (wgid % nig) / gsz; return true;
    }
    __device__ __forceinline__ void a_ready(const Unit&) const {}
    __device__ __forceinline__ void done(const Unit&) const {}
};

__device__ __forceinline__ unsigned cvt_pk_bf16(float lo, float hi) { unsigned r; asm volatile("v_cvt_pk_bf16_f32 %0, %1, %2" : "=v"(r) : "v"(lo), "v"(hi)); return r; }
typedef float f32x2 __attribute__((ext_vector_type(2)));
template <class Epi, class Sched, bool ALIGN_EPI = false, bool SP2 = false>
__device__ __forceinline__ void gemm_phase(PG8_LAS unsigned char* lds, const Gemm g, const Sched& S, const Epi& E, int tid_in) {
    int tid_l = tid_in; asm volatile("" : "+v"(tid_l)); const int tid = tid_l, wid = __builtin_amdgcn_readfirstlane(tid >> 6), lane = tid & 63, wr = wid >> 2, wc = wid & 3, fr = lane & 15, fq = lane >> 4;
    const int K = g.K, nt = K / BK, LD = g.ld;
    unsigned voffA[2], voffB[2];
#pragma unroll
    for (int i = 0; i < 2; ++i) { int R, C; stage_rc(tid * 16 + i * 8192, R, C); const int Rb = Epi::PERM ? ((R & ~31) + perm32(R & 31)) : R;
        voffA[i] = (unsigned)(R * LD + C) * 2u; voffB[i] = (unsigned)(Rb * LD + C) * 2u; }
    const size_t kstep = (size_t)(BK * 2);
    const size_t hstep = (size_t)HALF * LD * 2;
    const size_t tstep = 2 * hstep;
    const unsigned ldsw = (unsigned)wid * 1024u;
    const int aoff = lds_byte(wr * 64 + fr, fq * 8), boff = lds_byte(wc * 32 + fr, fq * 8);
#define PG8_SA(b, h) (((b) * 2 + (h)) * HTB)
#define PG8_SB(b, h) ((4 + (b) * 2 + (h)) * HTB)
#define PG8_STAGE(bufoff, gbase, voff) do { _Pragma("unroll") for (int _i = 0; _i < 2; ++_i) \
        __builtin_amdgcn_global_load_lds((const unsigned*)((const char*)(gbase) + (voff)[_i]), (PG8_LAS unsigned*)(lds + (bufoff) + ldsw + _i * 8192), 16, 0, 0); } while (0)
#define PG8_LDA(dst, b, h) do { _Pragma("unroll") for (int m = 0; m < 4; ++m) _Pragma("unroll") for (int k = 0; k < 2; ++k) dst[m][k] = *(const PG8_LAS bf16x8*)(lds + PG8_SA(b, h) + aoff + m * 2048 + k * 1024); } while (0)
#define PG8_LDB(dst, b, h) do { _Pragma("unroll") for (int n = 0; n < 2; ++n) _Pragma("unroll") for (int k = 0; k < 2; ++k) dst[n][k] = *(const PG8_LAS bf16x8*)(lds + PG8_SB(b, h) + boff + n * 2048 + k * 1024); } while (0)
#define PG8_MMA(ai, bj, At, Bt) do { __builtin_amdgcn_s_setprio(1); _Pragma("unroll") for (int m = 0; m < 4; ++m) _Pragma("unroll") for (int n = 0; n < 2; ++n) _Pragma("unroll") for (int k = 0; k < 2; ++k) \
        acc[ai][bj][m][n] = __builtin_amdgcn_mfma_f32_16x16x32_bf16(Bt[n][k], At[m][k], acc[ai][bj][m][n], 0, 0, 0); __builtin_amdgcn_s_setprio(0); } while (0)
#define PG8_WAIT_V(n) asm volatile("s_waitcnt vmcnt(" #n ")" ::: "memory")
#define PG8_WAIT_L(n) asm volatile("s_waitcnt lgkmcnt(" #n ")" ::: "memory")
#define PG8_BAR __builtin_amdgcn_s_barrier()
#define PG8_SCHED __builtin_amdgcn_sched_barrier(0)
    Unit cur, nxt; int ui = 0;
    if (!S.next(0, cur)) return;
    f32x4 acc[2][2][4][2];
#pragma unroll
    for (int a = 0; a < 2; ++a)
#pragma unroll
        for (int b = 0; b < 2; ++b)
#pragma unroll
            for (int m = 0; m < 4; ++m)
#pragma unroll
                for (int n = 0; n < 2; ++n) acc[a][b][m][n] = (f32x4){0.f, 0.f, 0.f, 0.f};
    bf16x8 At[4][2], B0[2][2], B1[2][2];
    const char* cA = (const char*)g.A + (size_t)cur.pm * tstep; const char* cB = (const char*)g.Bt + (size_t)cur.pn * tstep;
    S.a_ready(cur);
    if constexpr (SP2) {
        PG8_STAGE(PG8_SB(0, 0), cB, voffB); PG8_STAGE(PG8_SB(0, 1), cB + hstep, voffB); PG8_STAGE(PG8_SA(0, 0), cA, voffA); PG8_STAGE(PG8_SA(0, 1), cA + hstep, voffA);
        if (wr == 1) PG8_BAR;
        PG8_WAIT_V(2); PG8_BAR;
        PG8_STAGE(PG8_SB(1, 0), cB + kstep, voffB); PG8_STAGE(PG8_SA(1, 0), cA + kstep, voffA); PG8_STAGE(PG8_SB(1, 1), cB + hstep + kstep, voffB);
        PG8_WAIT_V(6); PG8_BAR;
    } else {
        PG8_STAGE(PG8_SB(0, 0), cB, voffB); PG8_STAGE(PG8_SA(0, 0), cA, voffA); PG8_STAGE(PG8_SB(0, 1), cB + hstep, voffB); PG8_STAGE(PG8_SA(0, 1), cA + hstep, voffA);
        if (wr == 1) PG8_BAR;
        PG8_WAIT_V(4); PG8_BAR;
        PG8_STAGE(PG8_SB(1, 0), cB + kstep, voffB); PG8_STAGE(PG8_SA(1, 0), cA + kstep, voffA); PG8_STAGE(PG8_SB(1, 1), cB + hstep + kstep, voffB);
        PG8_WAIT_V(6); PG8_BAR;
    }
    for (;;) {
        const bool has_next = S.next(ui + 1, nxt);
        const char* nA = has_next ? (const char*)g.A + (size_t)nxt.pm * tstep : cA; const char* nB = has_next ? (const char*)g.Bt + (size_t)nxt.pn * tstep : cB;
        for (int t = 0; t < nt; t += 2) {
            const bool last = (t == nt - 2);
            const char* a1 = cA + (size_t)(t + 1) * kstep;
            const char* a2 = last ? nA : cA + (size_t)(t + 2) * kstep; const char* b2 = last ? nB : cB + (size_t)(t + 2) * kstep;
            const char* a3 = a2 + kstep; const char* b3 = b2 + kstep;
            if (last && has_next) S.a_ready(nxt);
            if constexpr (SP2) {
            PG8_LDB(B0, 0, 0); PG8_LDB(B1, 0, 1); PG8_SCHED; PG8_LDA(At, 0, 0); PG8_STAGE(PG8_SA(1, 1), a1 + hstep, voffA);
            PG8_WAIT_V(8); PG8_WAIT_L(0); PG8_BAR; PG8_MMA(0, 0, At, B0); PG8_MMA(0, 1, At, B1); PG8_BAR; PG8_SCHED;
            PG8_LDA(At, 0, 1); PG8_STAGE(PG8_SB(0, 0), b2, voffB); PG8_STAGE(PG8_SB(0, 1), b2 + hstep, voffB); PG8_STAGE(PG8_SA(0, 0), a2, voffA);
            PG8_WAIT_V(8); PG8_WAIT_L(0); PG8_BAR; PG8_MMA(1, 0, At, B0); PG8_MMA(1, 1, At, B1); PG8_BAR; PG8_SCHED;
            PG8_LDB(B0, 1, 0); PG8_LDB(B1, 1, 1); PG8_SCHED; PG8_LDA(At, 1, 0); PG8_STAGE(PG8_SA(0, 1), a2 + hstep, voffA);
            PG8_WAIT_V(8); PG8_WAIT_L(0); PG8_BAR; PG8_MMA(0, 0, At, B0); PG8_MMA(0, 1, At, B1); PG8_BAR; PG8_SCHED;
            PG8_LDA(At, 1, 1); PG8_STAGE(PG8_SB(1, 0), b3, voffB); PG8_STAGE(PG8_SB(1, 1), b3 + hstep, voffB); PG8_STAGE(PG8_SA(1, 0), a3, voffA);
            PG8_WAIT_V(8); PG8_WAIT_L(0); PG8_BAR; PG8_MMA(1, 0, At, B0); PG8_MMA(1, 1, At, B1); PG8_BAR; PG8_SCHED;
            } else {
            PG8_LDB(B0, 0, 0); PG8_SCHED; PG8_LDA(At, 0, 0); PG8_STAGE(PG8_SA(1, 1), a1 + hstep, voffA);
            PG8_WAIT_L(8); PG8_BAR; PG8_WAIT_L(0); PG8_MMA(0, 0, At, B0); PG8_BAR; PG8_SCHED;
            PG8_LDB(B1, 0, 1); PG8_STAGE(PG8_SB(0, 0), b2, voffB);
            PG8_BAR; PG8_WAIT_L(0); PG8_MMA(0, 1, At, B1); PG8_BAR;
            PG8_LDA(At, 0, 1); PG8_STAGE(PG8_SA(0, 0), a2, voffA);
            PG8_BAR; PG8_WAIT_L(0); PG8_MMA(1, 0, At, B0); PG8_BAR; PG8_SCHED;
            PG8_STAGE(PG8_SB(0, 1), b2 + hstep, voffB);
            PG8_WAIT_V(6); PG8_BAR; PG8_MMA(1, 1, At, B1); PG8_BAR;
            PG8_LDB(B0, 1, 0); PG8_SCHED; PG8_LDA(At, 1, 0); PG8_STAGE(PG8_SA(0, 1), a2 + hstep, voffA);
            PG8_WAIT_L(8); PG8_BAR; PG8_WAIT_L(0); PG8_MMA(0, 0, At, B0); PG8_BAR; PG8_SCHED;
            PG8_LDB(B1, 1, 1); PG8_STAGE(PG8_SB(1, 0), b3, voffB);
            PG8_BAR; PG8_WAIT_L(0); PG8_MMA(0, 1, At, B1); PG8_BAR;
            PG8_LDA(At, 1, 1); PG8_STAGE(PG8_SA(1, 0), a3, voffA);
            PG8_BAR; PG8_WAIT_L(0); PG8_MMA(1, 0, At, B0); PG8_BAR; PG8_SCHED;
            PG8_STAGE(PG8_SB(1, 1), b3 + hstep, voffB);
            PG8_WAIT_V(6); PG8_BAR; PG8_MMA(1, 1, At, B1); PG8_BAR;
            }
        }
        if constexpr (ALIGN_EPI) { if (wr == 0) PG8_BAR; }
        if constexpr (!Epi::AFTER_DRAIN) { E(acc, cur, wr, wc, fr, fq); S.done(cur); }
        if (!has_next) break;
#pragma unroll
        for (int a = 0; a < 2; ++a)
#pragma unroll
            for (int b = 0; b < 2; ++b)
#pragma unroll
                for (int m = 0; m < 4; ++m)
#pragma unroll
                    for (int n = 0; n < 2; ++n) acc[a][b][m][n] = (f32x4){0.f, 0.f, 0.f, 0.f};
        cur = nxt; cA = nA; cB = nB; ++ui;
        if constexpr (ALIGN_EPI) { if (wr == 1) PG8_BAR; }
    }
    PG8_WAIT_V(0);
    if constexpr (!ALIGN_EPI) { if (wr == 0) PG8_BAR; }
    PG8_BAR;
    if constexpr (Epi::AFTER_DRAIN) { E.fused(acc, cur, wr, wc, fr, fq, lds, wid, lane); S.done(cur); }
#undef PG8_SA
#undef PG8_SB
#undef PG8_STAGE
#undef PG8_LDA
#undef PG8_LDB
#undef PG8_MMA
#undef PG8_WAIT_V
#undef PG8_WAIT_L
#undef PG8_BAR
#undef PG8_SCHED
}
}

#define LAS __attribute__((address_space(3)))
typedef unsigned short bf16_t;
typedef unsigned char uchar;
typedef short bf16x8 __attribute__((ext_vector_type(8)));
typedef float f32x4 __attribute__((ext_vector_type(4)));
typedef float f32x16 __attribute__((ext_vector_type(16)));
typedef unsigned u32x2 __attribute__((ext_vector_type(2)));
typedef unsigned u32x4 __attribute__((ext_vector_type(4)));

constexpr int TL = 32768, TC = 4096, TT = 36864;
constexpr size_t MiB = 1u << 20;
constexpr size_t OFF_ROPE = 64 * 1024, OFF_MOD = 128 * 1024;
constexpr size_t OFF_WB = 1 * MiB;
constexpr size_t WB_W1 = 0, WB_WO = (size_t)2304 * 1024 * 2, WB_F1 = WB_WO + (size_t)1024 * 1024 * 2, WB_F2 = WB_F1 + (size_t)4096 * 1024 * 2, WB_LAYER = WB_F2 + (size_t)4096 * 1024 * 2;
constexpr size_t OFF_DFTL = 46 * MiB, OFF_DFTC = 62 * MiB, OFF_XC = 63 * MiB, OFF_H = 79 * MiB, OFF_M1 = 79 * MiB, OFF_M2 = 115 * MiB;
constexpr size_t OFF_GTL = 151 * MiB, OFF_GTC = 183 * MiB, OFF_Q = 187 * MiB, OFF_K = 223 * MiB, OFF_VTL = 232 * MiB, OFF_VTC = 240 * MiB, OFF_DQKV = 241 * MiB,
                 OFF_DZ = 295 * MiB, OFF_GB = 313 * MiB, OFF_O0T = 316 * MiB, OFF_S0T = 352 * MiB, OFF_ST = 388 * MiB, OFF_CAT = 424 * MiB, OFF_U = 151 * MiB, WS_END = 496 * MiB,
                 OFF_PART2 = 151 * MiB  ,
                 OFF_PARTF = 440 * MiB  ;
static_assert(OFF_WB + 2 * WB_LAYER <= OFF_DFTL, "ws map");
constexpr int LDS_BYTES = 163840, LDS_MISC = 155648;

struct Params { const float* in[18]; float* out; unsigned char* ws; };

typedef float f32x2_t __attribute__((ext_vector_type(2))); typedef __bf16 bf16x2_t __attribute__((ext_vector_type(2)));
__device__ __forceinline__ unsigned pk(float lo, float hi) { f32x2_t v = {lo, hi}; bf16x2_t b = __builtin_convertvector(v, bf16x2_t); return __builtin_bit_cast(unsigned, b); }
__device__ __forceinline__ bf16_t f2bf(float x) { return (bf16_t)(pk(x, 0.f) & 0xffffu); }
__device__ __forceinline__ float bf2f(unsigned h) { return __uint_as_float(h << 16); }
__device__ __forceinline__ float bflo(unsigned w) { return __uint_as_float(w << 16); }
__device__ __forceinline__ float bfhi(unsigned w) { return __uint_as_float(w & 0xffff0000u); }
__device__ __forceinline__ float silu_f(float x) { return x * __builtin_amdgcn_rcpf(1.f + __expf(-x)); }
template <int M> __device__ __forceinline__ float sxor(float v) {
    static_assert(M >= 1 && M <= 16, "sxor: mask 1..16");
    return __int_as_float(__builtin_amdgcn_ds_swizzle(__float_as_int(v), (M << 10) | 0x1f));
}
__device__ __forceinline__ float sum32(float v) { auto r = __builtin_amdgcn_permlane32_swap(__float_as_uint(v), __float_as_uint(v), false, false); return __uint_as_float(r[0]) + __uint_as_float(r[1]); }
__device__ __forceinline__ float max32(float v) { auto r = __builtin_amdgcn_permlane32_swap(__float_as_uint(v), __float_as_uint(v), false, false); return fmaxf(__uint_as_float(r[0]), __uint_as_float(r[1])); }
__device__ __forceinline__ float wave_sum(float v) {
    v += sxor<1>(v); v += sxor<2>(v); v += sxor<4>(v); v += sxor<8>(v); v += sxor<16>(v); return sum32(v);
}
__device__ __forceinline__ f32x4 mfma16(bf16x8 a, bf16x8 b, f32x4 c) { return __builtin_amdgcn_mfma_f32_16x16x32_bf16(a, b, c, 0, 0, 0); }
__device__ __forceinline__ f32x16 mfma32(bf16x8 a, bf16x8 b, f32x16 c) { return __builtin_amdgcn_mfma_f32_32x32x16_bf16(a, b, c, 0, 0, 0); }

struct EpiProj {
    static constexpr bool PERM = false, AFTER_DRAIN = false;
    unsigned char* ws; const float *qg, *kg;
    __device__ __forceinline__ void operator()(const f32x4 (&acc)[2][2][4][2], const pg8::Unit& u, int wr, int wc, int fr, int fq) const {
        asm volatile("" : "+v"(fr), "+v"(fq));
        bf16_t* const GTl = (bf16_t*)(ws + OFF_GTL); bf16_t* const GTc = (bf16_t*)(ws + OFF_GTC); bf16_t* const Qb = (bf16_t*)(ws + OFF_Q); bf16_t* const Kb = (bf16_t*)(ws + OFF_K);
        bf16_t* const VTl = (bf16_t*)(ws + OFF_VTL); bf16_t* const VTc = (bf16_t*)(ws + OFF_VTC); bf16_t* const DQKV = (bf16_t*)(ws + OFF_DQKV); bf16_t* const DZ = (bf16_t*)(ws + OFF_DZ);
        const float2* const rope = (const float2*)(ws + OFF_ROPE);
        const int pn = u.pn, rowt = u.pm * 256;
        const bool ctx = rowt >= TL;
        const int b = ctx ? (rowt - TL) >> 8 : rowt >> 11;
        const int s0 = ctx ? 0 : (rowt & 2047);
        const int Ls = ctx ? 256 : 2048;
        if (pn < 2) {
            bf16_t* G = (ctx ? GTc : GTl);
#pragma unroll
            for (int ai = 0; ai < 2; ++ai)
#pragma unroll
                for (int m = 0; m < 4; ++m) {
                    const int s = s0 + ai * 128 + wr * 64 + m * 16 + fr;
#pragma unroll
                    for (int bj = 0; bj < 2; ++bj)
#pragma unroll
                        for (int n = 0; n < 2; ++n)
#pragma unroll
                            for (int j = 0; j < 4; ++j) {
                                const int c = bj * 128 + wc * 32 + n * 16 + fq * 4 + j;
                                G[((size_t)((b * 256 + c) * 2 + pn)) * Ls + s] = f2bf(acc[ai][bj][m][n][j]);
                            }
                }
        } else if (pn < 5) {
            const bool isv = (pn == 4) && (wc >= 2);
            if (isv) {
                const int kvh = wc - 2; bf16_t* V = ctx ? VTc : VTl;
#pragma unroll
                for (int ai = 0; ai < 2; ++ai)
#pragma unroll
                    for (int m = 0; m < 4; ++m) {
                        const int s = s0 + ai * 128 + wr * 64 + m * 16 + fr;
#pragma unroll
                        for (int bj = 0; bj < 2; ++bj)
#pragma unroll
                            for (int n = 0; n < 2; ++n)
#pragma unroll
                                for (int j = 0; j < 4; ++j) {
                                    const int d = bj * 32 + n * 16 + fq * 4 + j;
                                    V[((size_t)((b * 2 + kvh) * 64 + d)) * Ls + s] = f2bf(acc[ai][bj][m][n][j]);
                                }
                    }
            } else {
                const bool isq = pn < 4;
                const float* gw = isq ? qg : kg;
                const float osc = isq ? 0.125f : 1.0f;
                f32x4 gv[2][2];
#pragma unroll
                for (int bj = 0; bj < 2; ++bj)
#pragma unroll
                    for (int n = 0; n < 2; ++n) gv[bj][n] = *(const f32x4*)(gw + bj * 32 + n * 16 + fq * 4);
#pragma unroll
                for (int ai = 0; ai < 2; ++ai)
#pragma unroll
                    for (int m = 0; m < 4; ++m) {
                        const int rl = ai * 128 + wr * 64 + m * 16 + fr;
                        const int s = s0 + rl; const size_t row = (size_t)rowt + rl;
                        float ss = 0.f;
#pragma unroll
                        for (int bj = 0; bj < 2; ++bj)
#pragma unroll
                            for (int n = 0; n < 2; ++n) { const f32x4 v = acc[ai][bj][m][n]; ss += (v[0] * v[0] + v[1] * v[1]) + (v[2] * v[2] + v[3] * v[3]); }
                        ss += sxor<16>(ss); ss = sum32(ss);
                        const float rinv = rsqrtf(ss * (1.f / 64.f) + 1e-6f);
                        bf16_t* dst = isq ? (Qb + row * 512 + ((pn - 2) * 4 + wc) * 64) : (Kb + row * 128 + wc * 64);
#pragma unroll
                        for (int bj = 0; bj < 2; ++bj) {
                            f32x4 x0 = acc[ai][bj][m][0] * rinv * gv[bj][0], x1 = acc[ai][bj][m][1] * rinv * gv[bj][1];
                            if (!ctx) {
                                const int pos = bj == 0 ? (s >> 6) : (s & 63);
                                const float2* rp = rope + pos * 16 + fq * 4;
                                f32x4 o0, o1;
#pragma unroll
                                for (int j = 0; j < 4; ++j) { const float2 cs = rp[j]; o0[j] = x0[j] * cs.x - x1[j] * cs.y; o1[j] = x1[j] * cs.x + x0[j] * cs.y; }
                                x0 = o0; x1 = o1;
                            }
                            x0 = x0 * osc; x1 = x1 * osc;
                            u32x2 w0, w1; w0.x = pk(x0[0], x0[1]); w0.y = pk(x0[2], x0[3]); w1.x = pk(x1[0], x1[1]); w1.y = pk(x1[2], x1[3]);
                            *(u32x2*)(dst + bj * 32 + fq * 4) = w0; *(u32x2*)(dst + bj * 32 + 16 + fq * 4) = w1;
                        }
                    }
            }
        } else {
            bf16_t* O = pn < 8 ? DQKV : DZ; const int ldo = pn < 8 ? 768 : 256; const int cb = pn < 8 ? (pn - 5) * 256 : 0;
#pragma unroll
            for (int ai = 0; ai < 2; ++ai)
#pragma unroll
                for (int m = 0; m < 4; ++m) {
                    bf16_t* rowp = O + ((size_t)rowt + ai * 128 + wr * 64 + m * 16 + fr) * ldo + cb + wc * 32 + fq * 4;
#pragma unroll
                    for (int bj = 0; bj < 2; ++bj)
#pragma unroll
                        for (int n = 0; n < 2; ++n) { const f32x4 v = acc[ai][bj][m][n]; u32x2 w; w.x = pk(v[0], v[1]); w.y = pk(v[2], v[3]); *(u32x2*)(rowp + bj * 128 + n * 16) = w; }
                }
        }
    }
};

struct EpiResid {
    static constexpr bool PERM = false, AFTER_DRAIN = false;
    const float* srcl; float* dstl; const float* srcc; float* dstc; const float* gate;
    __device__ __forceinline__ void operator()(const f32x4 (&acc)[2][2][4][2], const pg8::Unit& u, int wr, int wc, int fr, int fq) const {
        const int rowt = u.pm * 256; const bool ctx = rowt >= TL;
        const int bb = ctx ? 16 : rowt >> 11;
        const float* src = ctx ? srcc + (size_t)(rowt - TL) * 1024 : srcl + (size_t)rowt * 1024;
        float* dst = ctx ? dstc + (size_t)(rowt - TL) * 1024 : dstl + (size_t)rowt * 1024;
        const int col0 = u.pn * 256 + wc * 32 + fq * 4;
        f32x4 gv[2][2];
#pragma unroll
        for (int bj = 0; bj < 2; ++bj)
#pragma unroll
            for (int n = 0; n < 2; ++n) gv[bj][n] = *(const f32x4*)(gate + bb * 6144 + col0 + bj * 128 + n * 16);
#pragma unroll
        for (int ai = 0; ai < 2; ++ai)
#pragma unroll
            for (int m = 0; m < 4; ++m) {
                const size_t off = (size_t)(ai * 128 + wr * 64 + m * 16 + fr) * 1024 + col0;
#pragma unroll
                for (int bj = 0; bj < 2; ++bj)
#pragma unroll
                    for (int n = 0; n < 2; ++n) { const f32x4 sv = *(const f32x4*)(src + off + bj * 128 + n * 16); *(f32x4*)(dst + off + bj * 128 + n * 16) = sv + gv[bj][n] * acc[ai][bj][m][n]; }
            }
    }
};

struct EpiRelu2 {
    static constexpr bool PERM = false, AFTER_DRAIN = false;
    bf16_t* U;
    __device__ __forceinline__ void operator()(const f32x4 (&acc)[2][2][4][2], const pg8::Unit& u, int wr, int wc, int fr, int fq) const {
        const int col0 = u.pn * 256 + wc * 32 + fq * 4;
#pragma unroll
        for (int ai = 0; ai < 2; ++ai)
#pragma unroll
            for (int m = 0; m < 4; ++m) {
                bf16_t* rowp = U + ((size_t)u.pm * 256 + ai * 128 + wr * 64 + m * 16 + fr) * 4096 + col0;
#pragma unroll
                for (int bj = 0; bj < 2; ++bj)
#pragma unroll
                    for (int n = 0; n < 2; ++n) { f32x4 v = acc[ai][bj][m][n];
#pragma unroll
                        for (int j = 0; j < 4; ++j) { const float t = fmaxf(v[j], 0.f); v[j] = t * t; }
                        u32x2 w; w.x = pk(v[0], v[1]); w.y = pk(v[2], v[3]); *(u32x2*)(rowp + bj * 128 + n * 16) = w; }
            }
    }
};

struct EpiFourier {
    static constexpr bool PERM = false, AFTER_DRAIN = false;
    bf16_t* CAT; int rowbase, Ls;
    __device__ __forceinline__ void operator()(const f32x4 (&acc)[2][2][4][2], const pg8::Unit& u, int wr, int wc, int fr, int fq) const {
        const int b = u.pn;
#pragma unroll
        for (int ai = 0; ai < 2; ++ai)
#pragma unroll
            for (int m = 0; m < 4; ++m) {
                const int k1 = u.pm * 256 + ai * 128 + wr * 64 + m * 16 + fr;
                bf16_t* rowp = CAT + ((size_t)rowbase + (size_t)b * Ls + k1) * 1024 + wc * 32 + fq * 4;
#pragma unroll
                for (int bj = 0; bj < 2; ++bj)
#pragma unroll
                    for (int n = 0; n < 2; ++n) { const f32x4 v = acc[ai][bj][m][n]; u32x2 w; w.x = pk(v[0], v[1]); w.y = pk(v[2], v[3]); *(u32x2*)(rowp + bj * 128 + n * 16) = w; }
            }
    }
};

struct EpiSplit {
    static constexpr bool PERM = false, AFTER_DRAIN = false;
    const float* src; float* dst; const float* gate;
    __device__ __forceinline__ void operator()(const f32x4 (&acc)[2][2][4][2], const pg8::Unit& u, int wr, int wc, int fr, int fq) const {
        const int col0 = u.pn * 256 + wc * 32 + fq * 4;
        f32x4 gv[2][2];
#pragma unroll
        for (int bj = 0; bj < 2; ++bj)
#pragma unroll
            for (int n = 0; n < 2; ++n) gv[bj][n] = *(const f32x4*)(gate + col0 + bj * 128 + n * 16);
#pragma unroll
        for (int ai = 0; ai < 2; ++ai)
#pragma unroll
            for (int m = 0; m < 4; ++m) {
                const size_t off = ((size_t)u.pm * 256 + ai * 128 + wr * 64 + m * 16 + fr) * 1024 + col0;
#pragma unroll
                for (int bj = 0; bj < 2; ++bj)
#pragma unroll
                    for (int n = 0; n < 2; ++n) { f32x4 o = gv[bj][n] * acc[ai][bj][m][n]; if (src) o += *(const f32x4*)(src + off + bj * 128 + n * 16); *(f32x4*)(dst + off + bj * 128 + n * 16) = o; }
            }
    }
};
struct OrderL1 {
    pg8::StaticOrder so; int G, c;
    __device__ void init(int G_, int c_) { so.init(TL, 2304, G_, c_); G = G_; c = c_; }
    __device__ bool next(int i, pg8::Unit& u) const {
        if (so.next(i, u)) return true;
        const long Lx = (long)i * G + c - so.nwg; if (Lx < 0 || Lx >= 64) return false;
        u.pm = 128 + (int)(Lx >> 2); u.pn = 4 + (int)(Lx & 3); return true;
    }
    __device__ __forceinline__ void a_ready(const pg8::Unit&) const {}
    __device__ __forceinline__ void done(const pg8::Unit&) const {}
};

struct RevOrder {
    pg8::StaticOrder so; int nM;
    __device__ void init(int M, int N, int G_, int c_) { so.init(M, N, G_, c_); nM = M / 256; }
    __device__ bool next(int i, pg8::Unit& u) const { if (!so.next(i, u)) return false; u.pm = nM - 1 - u.pm; return true; }
    __device__ __forceinline__ void a_ready(const pg8::Unit&) const {}
    __device__ __forceinline__ void done(const pg8::Unit&) const {}
};

struct EpiRelu2P {
    static constexpr bool PERM = true, AFTER_DRAIN = false;
    bf16_t* U;
    __device__ __forceinline__ void operator()(const f32x4 (&acc)[2][2][4][2], const pg8::Unit& u, int wr, int wc, int fr, int fq) const {
        const int col0 = u.pn * 256 + wc * 32 + fq * 8;
#pragma unroll
        for (int ai = 0; ai < 2; ++ai)
#pragma unroll
            for (int m = 0; m < 4; ++m) {
                bf16_t* rowp = U + ((size_t)u.pm * 256 + ai * 128 + wr * 64 + m * 16 + fr) * 4096 + col0;
#pragma unroll
                for (int bj = 0; bj < 2; ++bj) { f32x4 v0 = acc[ai][bj][m][0], v1 = acc[ai][bj][m][1];
#pragma unroll
                    for (int j = 0; j < 4; ++j) { const float t0 = fmaxf(v0[j], 0.f), t1 = fmaxf(v1[j], 0.f); v0[j] = t0 * t0; v1[j] = t1 * t1; }
                    u32x4 w; w.x = pk(v0[0], v0[1]); w.y = pk(v0[2], v0[3]); w.z = pk(v1[0], v1[1]); w.w = pk(v1[2], v1[3]);
                    __builtin_nontemporal_store(w, (u32x4*)(rowp + bj * 128)); }
            }
    }
};

__device__ __forceinline__ void tr_item(const float* Wsrc, int ld, bf16_t* dst, int K, LAS float* scr, int lane) {
#pragma unroll 8
    for (int i = 0; i < 32; ++i) { const int kk = 2 * i + (lane >> 5); scr[kk * 33 + (lane & 31)] = Wsrc[(size_t)kk * ld + (lane & 31)]; }
    asm volatile("s_waitcnt lgkmcnt(0)" ::: "memory");
    const int c = lane & 7;
#pragma unroll
    for (int j = 0; j < 4; ++j) { const int n = (lane >> 3) + 8 * j; const LAS float* s = scr + (8 * c) * 33 + n;
        u32x4 o; o.x = pk(s[0 * 33], s[1 * 33]); o.y = pk(s[2 * 33], s[3 * 33]); o.z = pk(s[4 * 33], s[5 * 33]); o.w = pk(s[6 * 33], s[7 * 33]);
        *(u32x4*)(dst + (size_t)n * K + 8 * c) = o; }
    asm volatile("s_waitcnt lgkmcnt(0)" ::: "memory");
}
__device__ __forceinline__ int w1_orig_col(int n0) {
    const int tile = n0 >> 8, c = n0 & 255, bj = c >> 7, wc = (c & 127) >> 5;
    if (tile < 4) return 256 + (tile - 2) * 256 + 64 * wc + 32 * bj;
    if (tile == 4) return wc < 2 ? 768 + 64 * wc + 32 * bj : 896 + 64 * (wc - 2) + 32 * bj;
    if (tile < 8) return 1024 + (tile - 5) * 256 + c;
    return 1792 + c;
}

typedef const __attribute__((address_space(4))) Params CParamsP;
__device__ __forceinline__ void phase_prologue(CParamsP* pp, LAS uchar* L, int tid, int lane, int wave) {
    uchar* ws = pp->ws;
    LAS float* trig = (LAS float*)(L + LDS_MISC);
    if (tid < 64) { float s, c; sincospif((float)tid / 32.f, &s, &c); trig[tid] = c; trig[64 + tid] = s; }
    if (blockIdx.x < 192) {
        const int item = blockIdx.x;
        LAS float* sc = (LAS float*)L;
        LAS float* red = (LAS float*)(L + 17 * 1024 * 4);
        const float* c = pp->in[1]; const float* cctx = pp->in[3];
        for (int i = tid; i < 17 * 1024; i += 512) { const int bb = i >> 10, k = i & 1023; const float v = bb < 16 ? c[bb * 1024 + k] : cctx[k]; sc[i] = silu_f(v); }
        __syncthreads();
        const int l = item / 96, cb = item % 96, n = cb * 64 + lane;
        const float* W = pp->in[6] + (size_t)l * 1024 * 6144;
        float acc[17];
#pragma unroll
        for (int bb = 0; bb < 17; ++bb) acc[bb] = 0.f;
#pragma unroll 4
        for (int kk = 0; kk < 128; ++kk) { const int k = wave * 128 + kk; const float wv = W[(size_t)k * 6144 + n];
#pragma unroll
            for (int bb = 0; bb < 17; ++bb) acc[bb] += sc[bb * 1024 + k] * wv; }
#pragma unroll
        for (int bb = 0; bb < 17; ++bb) red[(wave * 17 + bb) * 64 + lane] = acc[bb];
        __syncthreads();
        float* mod = (float*)(ws + OFF_MOD);
        const float* bm = pp->in[7];
        for (int i = tid; i < 17 * 64; i += 512) { const int bb = i >> 6, ln = i & 63; float s = 0.f;
#pragma unroll
            for (int w = 0; w < 8; ++w) s += red[(w * 17 + bb) * 64 + ln];
            const int nn = cb * 64 + ln; mod[(size_t)(l * 17 + bb) * 6144 + nn] = s + bm[l * 6144 + nn]; }
    }
    __syncthreads();
    LAS float* scr = (LAS float*)(L + wave * 16384);
    const int gw = blockIdx.x * 8 + wave, NGW = gridDim.x * 8;
    constexpr int I_W1 = 56 * 16, I_WO = 32 * 16, I_F1 = 128 * 16, I_F2 = 32 * 64, I_FO = 4 * 16 * 8, I_LAYER = I_W1 + I_WO + I_F1 + I_F2 + I_FO;
    for (int it = gw; it < 2 * I_LAYER; it += NGW) {
        const int l = it / I_LAYER; int r = it % I_LAYER;
        uchar* wb = ws + OFF_WB + (size_t)l * WB_LAYER;
        const float* w_in = pp->in[8] + (size_t)l * 1024 * 2064;
        if (r < I_W1) { const int nb = 16 + r / 16, kb = r % 16; const int n0 = nb * 32, k0 = kb * 64;
            tr_item(w_in + (size_t)k0 * 2064 + w1_orig_col(n0), 2064, (bf16_t*)(wb + WB_W1) + (size_t)n0 * 1024 + k0, 1024, scr, lane); continue; }
        r -= I_W1;
        if (r < I_WO) { const int nb = r / 16, kb = r % 16; const int n0 = nb * 32, k0 = kb * 64;
            tr_item(pp->in[15] + (size_t)l * 1024 * 1024 + (size_t)k0 * 1024 + n0, 1024, (bf16_t*)(wb + WB_WO) + (size_t)n0 * 1024 + k0, 1024, scr, lane); continue; }
        r -= I_WO;
        if (r < I_F1) { const int nb = r / 16, kb = r % 16; const int n0 = nb * 32, k0 = kb * 64;
            tr_item(pp->in[16] + (size_t)l * 1024 * 4096 + (size_t)k0 * 4096 + n0, 4096, (bf16_t*)(wb + WB_F1) + (size_t)n0 * 1024 + k0, 1024, scr, lane); continue; }
        r -= I_F1;
        if (r < I_F2) { const int nb = r / 64, kb = r % 64; const int n0 = nb * 32, k0 = kb * 64;
            tr_item(pp->in[17] + (size_t)l * 4096 * 1024 + (size_t)k0 * 1024 + n0, 1024, (bf16_t*)(wb + WB_F2) + (size_t)n0 * 4096 + k0, 4096, scr, lane); continue; }
        r -= I_F2;
        {
            const int g = r >> 7, kb = (r >> 3) & 15, k2b = r & 7; const int k = kb * 64 + lane;
            const f32x4* src = (const f32x4*)(w_in + (size_t)k * 2064 + g * 64);
            float ac[8], as[8];
#pragma unroll
            for (int j = 0; j < 8; ++j) { ac[j] = 0.f; as[j] = 0.f; }
            for (int n4 = 0; n4 < 16; ++n4) { const f32x4 v = src[n4];
#pragma unroll
                for (int e = 0; e < 4; ++e) { const int n2 = n4 * 4 + e;
#pragma unroll
                    for (int j = 0; j < 8; ++j) { const int idx = ((k2b * 8 + j) * n2) & 63; ac[j] += v[e] * trig[idx]; as[j] += v[e] * trig[64 + idx]; } } }
            bf16_t* W1 = (bf16_t*)(wb + WB_W1);
#pragma unroll
            for (int j = 0; j < 8; ++j) { const int k2 = k2b * 8 + j; W1[(size_t)(g * 64 + k2) * 1024 + k] = f2bf(ac[j]); W1[(size_t)(256 + g * 64 + k2) * 1024 + k] = f2bf(as[j]); }
        }
    }
    {
        const size_t gt = (size_t)blockIdx.x * 512 + tid, NT = (size_t)gridDim.x * 512;
        bf16_t* AL = (bf16_t*)(ws + OFF_DFTL);
        const float nl = 0.00276213586f;
        for (size_t it = gt; it < (size_t)2048 * 512; it += NT) { const int k1 = (int)(it >> 9), cg_ = (int)(it & 511), cs = cg_ >> 8, n0 = (cg_ & 255) * 8;
            float v[8];
#pragma unroll
            for (int e = 0; e < 8; ++e) { const int m = (k1 * (n0 + e)) & 2047; float s, c; sincospif((float)m * (1.f / 1024.f), &s, &c); v[e] = (cs ? -s : c) * nl; }
            u32x4 o; o.x = pk(v[0], v[1]); o.y = pk(v[2], v[3]); o.z = pk(v[4], v[5]); o.w = pk(v[6], v[7]);
            *(u32x4*)(AL + (size_t)k1 * 4096 + cs * 2048 + n0) = o; }
        bf16_t* AC = (bf16_t*)(ws + OFF_DFTC);
        const float nc = 1.f / 128.f;
        for (size_t it = gt; it < (size_t)256 * 64; it += NT) { const int k1 = (int)(it >> 6), cg_ = (int)(it & 63), cs = cg_ >> 5, n0 = (cg_ & 31) * 8;
            float v[8];
#pragma unroll
            for (int e = 0; e < 8; ++e) { const int m = (k1 * (n0 + e)) & 255; float s, c; sincospif((float)m * (1.f / 128.f), &s, &c); v[e] = (cs ? -s : c) * nc; }
            u32x4 o; o.x = pk(v[0], v[1]); o.y = pk(v[2], v[3]); o.z = pk(v[4], v[5]); o.w = pk(v[6], v[7]);
            *(u32x4*)(AC + (size_t)k1 * 512 + cs * 256 + n0) = o; }
        for (size_t it = gt; it < (size_t)TC * 256; it += NT) ((f32x4*)(ws + OFF_XC))[it] = ((const f32x4*)pp->in[2])[it];
        if (blockIdx.x == 0) { float2* rope = (float2*)(ws + OFF_ROPE);
            for (int i = tid; i < 1024; i += 512) { const int pos = i >> 4, pp = i & 15; const float invf = powf(10000.f, -(float)pp * 2.0f / 32.f); const float ang = (float)pos * invf; rope[i] = make_float2(cosf(ang), sinf(ang)); } }
    }
}

template <bool GATES, bool PART>
__device__ __forceinline__ void phase_norm(const float* xl, const float* xc, int nrows, const float* ng, const float* modl, int shIdx, int scIdx, bf16_t* H,
                                           const float* w_in_l, const float* a_log_l, const float* dt_bias_l, float* GB, LAS uchar* L, int tid, int lane, int wave,
                                           const float* part = nullptr, float* xcw = nullptr) {
    LAS float* wgT = (LAS float*)L;
    if (GATES) { for (int i = tid; i < 16384; i += 512) { const int k = i >> 4, e = i & 15; wgT[e * 1024 + k] = w_in_l[(size_t)k * 2064 + 2048 + e]; } __syncthreads(); }
    const int NW = gridDim.x * 8, gw = blockIdx.x * 8 + wave;
    const int rpw = ((nrows + NW - 1) / NW + 1) & ~1;
    const int r0 = gw * rpw, r1 = min(nrows, r0 + rpw);
    f32x4 ga[4], gb[4]; int cur_bb = -1;
    for (int r = r0; r < r1; r += 2) {
        const int bb = r < TL ? r >> 11 : 16;
        if (bb != cur_bb) { cur_bb = bb;
            const float* scp = modl + (size_t)bb * 6144 + scIdx * 1024; const float* shp = modl + (size_t)bb * 6144 + shIdx * 1024;
#pragma unroll
            for (int j = 0; j < 4; ++j) { const f32x4 g = ((const f32x4*)ng)[lane + 64 * j], sc = ((const f32x4*)scp)[lane + 64 * j]; ga[j] = g * (sc + 1.f); gb[j] = ((const f32x4*)shp)[lane + 64 * j]; } }
        const float* xr = r < TL ? xl + (size_t)r * 1024 : xc + (size_t)(r - TL) * 1024;
        f32x4 v[2][4]; float ss0 = 0.f, ss1 = 0.f;
#pragma unroll
        for (int j = 0; j < 4; ++j) { v[0][j] = ((const f32x4*)xr)[lane + 64 * j]; v[1][j] = ((const f32x4*)(xr + 1024))[lane + 64 * j]; }
        if (PART && r >= TL) {
            const size_t po = (size_t)(r - TL) * 1024;
#pragma unroll
            for (int k = 0; k < 3; ++k)
#pragma unroll
                for (int j = 0; j < 4; ++j) { v[0][j] += ((const f32x4*)(part + (size_t)k * TC * 1024 + po))[lane + 64 * j]; v[1][j] += ((const f32x4*)(part + (size_t)k * TC * 1024 + po + 1024))[lane + 64 * j]; }
            if (xcw != nullptr) {
#pragma unroll
                for (int j = 0; j < 4; ++j) { ((f32x4*)(xcw + po))[lane + 64 * j] = v[0][j]; ((f32x4*)(xcw + po + 1024))[lane + 64 * j] = v[1][j]; } }
        }
#pragma unroll
        for (int j = 0; j < 4; ++j) { ss0 += (v[0][j][0] * v[0][j][0] + v[0][j][1] * v[0][j][1]) + (v[0][j][2] * v[0][j][2] + v[0][j][3] * v[0][j][3]);
                                      ss1 += (v[1][j][0] * v[1][j][0] + v[1][j][1] * v[1][j][1]) + (v[1][j][2] * v[1][j][2] + v[1][j][3] * v[1][j][3]); }
        ss0 = wave_sum(ss0); ss1 = wave_sum(ss1);
        const float rs0 = rsqrtf(ss0 * (1.f / 1024.f) + 1e-6f), rs1 = rsqrtf(ss1 * (1.f / 1024.f) + 1e-6f);
#pragma unroll
        for (int j = 0; j < 4; ++j) {
            v[0][j] = v[0][j] * rs0 * ga[j] + gb[j]; v[1][j] = v[1][j] * rs1 * ga[j] + gb[j];
            u32x2 w0, w1; w0.x = pk(v[0][j][0], v[0][j][1]); w0.y = pk(v[0][j][2], v[0][j][3]); w1.x = pk(v[1][j][0], v[1][j][1]); w1.y = pk(v[1][j][2], v[1][j][3]);
            *(u32x2*)(H + (size_t)r * 1024 + 4 * (lane + 64 * j)) = w0; *(u32x2*)(H + (size_t)(r + 1) * 1024 + 4 * (lane + 64 * j)) = w1; }
        if (GATES) {
            LAS float* wg = wgT; asm volatile("" : "+v"(wg));
            float a0[16], a1[16];
#pragma unroll
            for (int e = 0; e < 16; ++e) { float s0 = 0.f, s1 = 0.f;
#pragma unroll
                for (int j = 0; j < 4; ++j) { const f32x4 w = *(const LAS f32x4*)(wg + e * 1024 + 4 * (lane + 64 * j));
                    s0 += (v[0][j][0] * w[0] + v[0][j][1] * w[1]) + (v[0][j][2] * w[2] + v[0][j][3] * w[3]);
                    s1 += (v[1][j][0] * w[0] + v[1][j][1] * w[1]) + (v[1][j][2] * w[2] + v[1][j][3] * w[3]); }
                a0[e] = s0; a1[e] = s1; }
#define NRM_STEP(N, BIT, SRC0, SRC1, DST0, DST1) { const bool up = (lane >> BIT) & 1; _Pragma("unroll") for (int m = 0; m < N; ++m) { \
                const float k0 = up ? SRC0[2 * m + 1] : SRC0[2 * m], s0_ = up ? SRC0[2 * m] : SRC0[2 * m + 1]; const float k1 = up ? SRC1[2 * m + 1] : SRC1[2 * m], s1_ = up ? SRC1[2 * m] : SRC1[2 * m + 1]; \
                DST0[m] = k0 + sxor<(1 << BIT)>(s0_); DST1[m] = k1 + sxor<(1 << BIT)>(s1_); } }
            float b0[8], b1[8], c0[4], c1[4], d0[2], d1[2], e0[1], e1[1];
            NRM_STEP(8, 0, a0, a1, b0, b1) NRM_STEP(4, 1, b0, b1, c0, c1) NRM_STEP(2, 2, c0, c1, d0, d1) NRM_STEP(1, 3, d0, d1, e0, e1)
#undef NRM_STEP
            float m0 = e0[0], m1 = e1[0];
            m0 += sxor<16>(m0); m1 += sxor<16>(m1); m0 = sum32(m0); m1 = sum32(m1);
            if (lane < 32) { const int e = lane & 15; const float mine = lane < 16 ? m0 : m1; float o;
                if (e < 8) o = 1.f / (1.f + expf(-mine));
                else { const int dh = e - 8; const float xx = mine + dt_bias_l[dh]; const float sp = xx > 20.f ? xx : log1pf(expf(xx)); o = -expf(a_log_l[dh]) * sp; }
                GB[(size_t)(r + (lane >> 4)) * 16 + e] = o; }
        }
    }
}

__device__ __forceinline__ f32x4 mm16(const LAS uchar* X, int x0, const LAS uchar* Y, int y0, int lane) {
    const int r = lane & 15, q = lane >> 4;
    const LAS uchar* xp = X + (x0 + r) * 144 + q * 16; const LAS uchar* yp = Y + (y0 + r) * 144 + q * 16;
    const bf16x8 a0 = *(const LAS bf16x8*)xp, a1 = *(const LAS bf16x8*)(xp + 64), b0 = *(const LAS bf16x8*)yp, b1 = *(const LAS bf16x8*)(yp + 64);
    f32x4 acc = {0.f, 0.f, 0.f, 0.f};
    acc = mfma16(a0, b0, acc); acc = mfma16(a1, b1, acc);
    return acc;
}
__device__ __forceinline__ f32x4 mm16k32(const LAS uchar* X, int x0, int xk, const LAS uchar* Y, int y0, int yk, int lane) {
    const int r = lane & 15, q = lane >> 4;
    const bf16x8 a0 = *(const LAS bf16x8*)(X + (x0 + r) * 144 + xk * 2 + q * 16), b0 = *(const LAS bf16x8*)(Y + (y0 + r) * 144 + yk * 2 + q * 16);
    f32x4 acc = {0.f, 0.f, 0.f, 0.f};
    return mfma16(a0, b0, acc);
}
constexpr int GL_QH = 0, GL_KH = 9216, GL_VT = 18432, GL_KBT = 27648, GL_KTT = 36864, GL_T = 46080, GL_QKM = 55296, GL_UT = 64512, GL_WT = 73728, GL_A = 82944, GL_GAM = 100352, GL_BET = 100608, GL_AB = 100864, GL_CW = 110080;

struct GdnRaw { u32x4 raw[3][3]; float g, be; };
__device__ __forceinline__ void gdn_decode(int v, int& h, int& dir, int& b, int& cidx) { h = v & 3; const int c = v >> 2; dir = c / 576; const int rem = c % 576; b = rem / 36; cidx = rem % 36; }
__device__ __forceinline__ void gdn_load(GdnRaw& R, int v, const bf16_t* DQKV, const float* GB, int tid, int lane, int wave) {
    int h, dir, b, cidx; gdn_decode(v, h, dir, b, cidx);
    const bool isctx = cidx < 4; const int Ls = isctx ? 256 : 2048;
    const int chunk = isctx ? (dir ? 3 - cidx : cidx) : (dir ? 35 - cidx : cidx - 4);
    const int base = chunk * 64; const size_t row0 = isctx ? (size_t)TL + b * 256 : (size_t)b * 2048;
    const int i = tid >> 3, part = tid & 7; const int pos = base + (dir ? 63 - i : i);
#pragma unroll
    for (int which = 0; which < 3; ++which)
#pragma unroll
        for (int j = 0; j < 3; ++j) { const int pp = pos + j - 1;
            R.raw[which][j] = (pp >= 0 && pp < Ls) ? *(const u32x4*)(DQKV + (row0 + pp) * 768 + which * 256 + h * 64 + part * 8) : (u32x4){0u, 0u, 0u, 0u}; }
    if (wave == 0) { const int p0 = base + (dir ? 63 - lane : lane); const float* gb = GB + (row0 + p0) * 16; R.g = gb[8 + dir * 4 + h]; R.be = gb[dir * 4 + h]; }
}

__device__ __forceinline__ void phase_gdn_pre(uchar* ws, const float* conv_w_l, LAS uchar* L_in, int tid_in, int lane_in, int wave) {
    const bf16_t* DQKV = (const bf16_t*)(ws + OFF_DQKV); const float* GB = (const float*)(ws + OFF_GB);
    bf16_t* M1g = (bf16_t*)(ws + OFF_M1); bf16_t* M2g = (bf16_t*)(ws + OFF_M2); bf16_t* O0Tg = (bf16_t*)(ws + OFF_O0T); bf16_t* S0Tg = (bf16_t*)(ws + OFF_S0T);
    (void)lane_in;
    int cur_h = -1;
    GdnRaw cur, nxt;
    if ((int)blockIdx.x < 4608) gdn_load(cur, blockIdx.x, DQKV, GB, tid_in, tid_in & 63, wave);
    for (int v = blockIdx.x; v < 4608; v += gridDim.x) {
        int tid = tid_in; asm volatile("" : "+v"(tid)); const int lane = tid & 63;
        LAS uchar* L = L_in; asm volatile("" : "+v"(L));
        LAS float* gam = (LAS float*)(L + GL_GAM); LAS float* bet = (LAS float*)(L + GL_BET); LAS float* A = (LAS float*)(L + GL_A);
        int h, dir, b, cidx; gdn_decode(v, h, dir, b, cidx);
        const size_t slot = (size_t)((dir * 16 + b) * 4 + h) * 36 + cidx;
        if (h != cur_h) { cur_h = h;
            for (int i = tid; i < 576; i += 512) { const int wj = i >> 6, d = i & 63; ((LAS float*)(L + GL_CW))[i] = conv_w_l[(wj % 3) * 768 + (wj / 3) * 256 + h * 64 + d]; } }
        if (v + (int)gridDim.x < 4608) gdn_load(nxt, v + gridDim.x, DQKV, GB, tid, lane, wave); else nxt = cur;
        if (wave == 0) { float s = cur.g;
#pragma unroll
            for (int o = 1; o < 64; o <<= 1) { const float t = __shfl_up(s, o); if (lane >= o) s += t; }
            gam[lane] = s; bet[lane] = cur.be; }
        __syncthreads();
        {
            const int i = tid >> 3, part = tid & 7;
            const float gi = gam[i], bi = bet[i], g63 = gam[63];
            const float eg = __expf(gi), ek = __expf(g63 - gi);
#pragma unroll
            for (int which = 0; which < 3; ++which) {
                float y[8];
#pragma unroll
                for (int e = 0; e < 8; ++e) y[e] = 0.f;
#pragma unroll
                for (int j = 0; j < 3; ++j) { const u32x4 raw = cur.raw[which][j]; const LAS float* wp = (const LAS float*)(L + GL_CW) + (which * 3 + j) * 64 + part * 8; const f32x4 w0 = *(const LAS f32x4*)wp, w1 = *(const LAS f32x4*)(wp + 4);
                    y[0] += w0[0] * bflo(raw.x); y[1] += w0[1] * bfhi(raw.x); y[2] += w0[2] * bflo(raw.y); y[3] += w0[3] * bfhi(raw.y);
                    y[4] += w1[0] * bflo(raw.z); y[5] += w1[1] * bfhi(raw.z); y[6] += w1[2] * bflo(raw.w); y[7] += w1[3] * bfhi(raw.w); }
                float ss = 0.f;
#pragma unroll
                for (int e = 0; e < 8; ++e) { y[e] = silu_f(y[e]); ss += y[e] * y[e]; }
                if (which < 2) { ss += sxor<1>(ss); ss += sxor<2>(ss); ss += sxor<4>(ss); const float rn = rsqrtf(ss + 1e-6f) * (which == 0 ? 0.125f : 1.f);
#pragma unroll
                    for (int e = 0; e < 8; ++e) y[e] *= rn; }
                if (which < 2) { u32x4 o; o.x = pk(y[0], y[1]); o.y = pk(y[2], y[3]); o.z = pk(y[4], y[5]); o.w = pk(y[6], y[7]);
                    *(LAS u32x4*)(L + (which == 0 ? GL_QH : GL_KH) + i * 144 + part * 16) = o; }
                if (which == 1) {
#pragma unroll
                    for (int e = 0; e < 8; ++e) { const int d = part * 8 + e; *(LAS bf16_t*)(L + GL_KBT + d * 144 + i * 2) = f2bf(bi * eg * y[e]); *(LAS bf16_t*)(L + GL_KTT + d * 144 + i * 2) = f2bf(ek * y[e]); } }
                if (which == 2) {
#pragma unroll
                    for (int e = 0; e < 8; ++e) { const int d = part * 8 + e; *(LAS bf16_t*)(L + GL_VT + d * 144 + i * 2) = f2bf(bi * y[e]); } }
            }
        }
        __syncthreads();
        {
#pragma unroll
            for (int tt = 0; tt < 2; ++tt) { const int tile = 2 * wave + tt, ti = tile >> 2, tj = tile & 3;
                const f32x4 kk = mm16(L + GL_KH, ti * 16, L + GL_KH, tj * 16, lane);
                const f32x4 qk = mm16(L + GL_QH, ti * 16, L + GL_KH, tj * 16, lane);
                const int j = tj * 16 + (lane & 15); const float gj = gam[j];
#pragma unroll
                for (int idx = 0; idx < 4; ++idx) { const int i = ti * 16 + 4 * (lane >> 4) + idx; const float gi = gam[i], bi = bet[i]; const float dec = __expf(fminf(gi - gj, 0.f));
                    const float av = (i > j) ? bi * kk[idx] * dec : 0.f;
                    *(LAS bf16_t*)(L + GL_AB + i * 144 + j * 2) = f2bf(av);
                    *(LAS bf16_t*)(L + GL_QKM + i * 144 + j * 2) = f2bf((i >= j) ? qk[idx] * dec : 0.f); } }
        }
        __syncthreads();
        if (wave == 0) {
            float t[32]; int c = lane & 31; const int half = lane >> 5, r0 = 32 * half; asm volatile("" : "+v"(c));
            const LAS uchar* ABp = L + GL_AB + r0 * 144 + r0 * 2;
            const unsigned oh = 1u << c;
            u32x4 buf[2][8];
#define SUB_LOAD(G, B) { const LAS uchar* pg_ = ABp; asm volatile("" : "+v"(pg_) : "v"(tdep)); _Pragma("unroll") for (int rr = 0; rr < 2; ++rr) { _Pragma("unroll") for (int j8 = 0; j8 < (2 * (G) + rr + 7) / 8; ++j8) buf[B][rr * 4 + j8] = *(const LAS u32x4*)(pg_ + (2 * (G) + rr) * 144 + j8 * 16); } }
            float tdep = 0.f;
            SUB_LOAD(0, 0) SUB_LOAD(1, 1)
#pragma unroll
            for (int g = 0; g < 16; ++g) {
#pragma unroll
                for (int rr = 0; rr < 2; ++rr) { const int i = 2 * g + rr; float s0 = (float)((oh >> i) & 1u), s1 = 0.f;
#pragma unroll
                    for (int j8 = 0; j8 < (i + 7) / 8; ++j8) { const u32x4 w = buf[g & 1][rr * 4 + j8];
#pragma unroll
                        for (int e = 0; e < 8; ++e) { const int j = 8 * j8 + e;
                            if (j < i) { if (e & 1) s1 -= bfhi(w[e >> 1]) * t[j]; else s0 -= bflo(w[e >> 1]) * t[j]; } } }
                    t[i] = s0 + s1; }
                tdep = t[2 * g + 1];
                if (g + 2 < 16) SUB_LOAD(g + 2, g & 1)
            }
#undef SUB_LOAD
#pragma unroll
            for (int i = 0; i < 32; ++i) *(LAS bf16_t*)(L + GL_T + (r0 + i) * 144 + (r0 + c) * 2) = f2bf(t[i]);
            if (half == 0) {
#pragma unroll
                for (int i = 0; i < 32; ++i) *(LAS bf16_t*)(L + GL_T + i * 144 + (32 + c) * 2) = (bf16_t)0;
#pragma unroll
                for (int j8 = 0; j8 < 4; ++j8) { u32x4 o; o.x = pk(t[8 * j8], t[8 * j8 + 1]); o.y = pk(t[8 * j8 + 2], t[8 * j8 + 3]); o.z = pk(t[8 * j8 + 4], t[8 * j8 + 5]); o.w = pk(t[8 * j8 + 6], t[8 * j8 + 7]);
                    *(LAS u32x4*)(L + GL_UT + c * 144 + j8 * 16) = o; }
            }
        }
        __syncthreads();
        if (wave < 4) {
            const int tm = wave >> 1, tc = wave & 1;
            const f32x4 acc = mm16k32(L + GL_AB, 32 + 16 * tm, 0, L + GL_UT, 16 * tc, 0, lane);
            const int cc = 16 * tc + (lane & 15), m0 = 16 * tm + 4 * (lane >> 4);
            u32x2 w; w.x = pk(acc[0], acc[1]); w.y = pk(acc[2], acc[3]);
            *(LAS u32x2*)(L + GL_WT + cc * 144 + m0 * 2) = w;
        }
        __syncthreads();
        if (wave < 4) {
            const int ti = wave >> 1, tc = wave & 1;
            const f32x4 acc = mm16k32(L + GL_T, 32 + 16 * ti, 32, L + GL_WT, 16 * tc, 0, lane);
            const int cc = 16 * tc + (lane & 15), i0 = 32 + 16 * ti + 4 * (lane >> 4);
#pragma unroll
            for (int idx = 0; idx < 4; ++idx) *(LAS bf16_t*)(L + GL_T + (i0 + idx) * 144 + cc * 2) = f2bf(-acc[idx]);
        }
        __syncthreads();
        {
#pragma unroll
            for (int tt = 0; tt < 4; ++tt) { const int tile = 4 * wave + tt, mat = tile >> 4, t16 = tile & 15, ti = t16 >> 2, te = t16 & 3;
                const f32x4 acc = mm16(L + GL_T, ti * 16, L + (mat ? GL_KBT : GL_VT), te * 16, lane);
                const int y = te * 16 + (lane & 15), i0 = ti * 16 + 4 * (lane >> 4);
                u32x2 w; w.x = pk(acc[0], acc[1]); w.y = pk(acc[2], acc[3]);
                *(LAS u32x2*)(L + (mat ? GL_WT : GL_UT) + y * 144 + i0 * 2) = w; }
        }
        __syncthreads();
        {
            const int mi = wave >> 1;
            const LAS uchar* X = L + (mi == 1 ? GL_UT : (mi == 3 ? GL_KTT : GL_WT));
            const LAS uchar* Y = L + ((mi == 0 || mi == 1) ? GL_QKM : (mi == 2 ? GL_KTT : GL_UT));
            const float a63 = __expf(gam[63]);
#pragma unroll
            for (int tt = 0; tt < 8; ++tt) { const int t16 = (wave & 1) * 8 + tt, tx = t16 >> 2, ty = t16 & 3;
                const f32x4 acc = mm16(X, tx * 16, Y, ty * 16, lane);
                const int y = ty * 16 + (lane & 15), x0 = tx * 16 + 4 * (lane >> 4);
                if (mi == 0) {
                    const u32x2 qq = *(const LAS u32x2*)(L + GL_QH + y * 144 + x0 * 2); const float eg = __expf(gam[y]);
                    u32x2 w; w.x = pk(bflo(qq.x) * eg - acc[0], bfhi(qq.x) * eg - acc[1]); w.y = pk(bflo(qq.y) * eg - acc[2], bfhi(qq.y) * eg - acc[3]);
                    const int ir = dir ? 63 - y : y; *(u32x2*)(M1g + slot * 4096 + ir * 64 + x0) = w;
                } else if (mi == 1) {
                    u32x2 w; w.x = pk(acc[0], acc[1]); w.y = pk(acc[2], acc[3]);
                    const int ir = dir ? 63 - y : y; *(u32x2*)(O0Tg + slot * 4096 + ir * 64 + x0) = w;
                } else if (mi == 2) {
                    u32x2 w; w.x = pk((y == x0 ? a63 : 0.f) - acc[0], (y == x0 + 1 ? a63 : 0.f) - acc[1]); w.y = pk((y == x0 + 2 ? a63 : 0.f) - acc[2], (y == x0 + 3 ? a63 : 0.f) - acc[3]);
                    *(u32x2*)(M2g + slot * 4096 + y * 64 + x0) = w;
                } else {
                    u32x2 w; w.x = pk(acc[0], acc[1]); w.y = pk(acc[2], acc[3]); *(u32x2*)(S0Tg + slot * 4096 + y * 64 + x0) = w;
                }
            }
        }
        __syncthreads();
        cur = nxt;
    }
}


struct Frag2 { bf16x8 a0, a1; };
__device__ __forceinline__ Frag2 ldfrag(const LAS uchar* M, int row0, int lane) { const LAS uchar* p = M + (row0 + (lane & 15)) * 144 + (lane >> 4) * 16; Frag2 f; f.a0 = *(const LAS bf16x8*)p; f.a1 = *(const LAS bf16x8*)(p + 64); return f; }
__device__ __forceinline__ f32x4 mmf(const Frag2& x, const Frag2& y) { f32x4 acc = {0.f, 0.f, 0.f, 0.f}; acc = mfma16(x.a0, y.a0, acc); return mfma16(x.a1, y.a1, acc); }
constexpr int G2_QH = 0, G2_KH = 9216  , G2_VT = 18432, G2_KBT = 27648, G2_KTT = 36864, G2_QKM = 46080, G2_AB = 55296  , G2_WT = 64512  ,
              G2_GAM = 73728, G2_BET = 73984, G2_CW = 74240, G2_HALF = 76544;
static_assert(2 * G2_HALF <= LDS_MISC, "gdn2 LDS map");
struct GdnRaw2 { u32x4 raw[2][3][3]; float g, be; };
__device__ __forceinline__ void gdn_load2(GdnRaw2& R, int v, const bf16_t* DQKV, const float* GB, int t2, int lane, int wl) {
    int h, dir, b, cidx; gdn_decode(v, h, dir, b, cidx);
    const bool isctx = cidx < 4; const int Ls = isctx ? 256 : 2048;
    const int chunk = isctx ? (dir ? 3 - cidx : cidx) : (dir ? 35 - cidx : cidx - 4);
    const int base = chunk * 64; const size_t row0 = isctx ? (size_t)TL + b * 256 : (size_t)b * 2048;
    const int i = t2 >> 2, part = t2 & 3; const int pos = base + (dir ? 63 - i : i);
#pragma unroll
    for (int p2 = 0; p2 < 2; ++p2)
#pragma unroll
        for (int which = 0; which < 3; ++which)
#pragma unroll
            for (int j = 0; j < 3; ++j) { const int pp = pos + j - 1;
                R.raw[p2][which][j] = (pp >= 0 && pp < Ls) ? *(const u32x4*)(DQKV + (row0 + pp) * 768 + which * 256 + h * 64 + part * 16 + p2 * 8) : (u32x4){0u, 0u, 0u, 0u}; }
    if (wl == 0) { const int p0 = base + (dir ? 63 - lane : lane); const float* gb = GB + (row0 + p0) * 16; R.g = gb[8 + dir * 4 + h]; R.be = gb[dir * 4 + h]; }
}

__device__ __forceinline__ void phase_gdn_pre2(uchar* ws, const float* conv_w_l, LAS uchar* L_in, int tid_in, int wave) {
    const bf16_t* DQKV = (const bf16_t*)(ws + OFF_DQKV); const float* GB = (const float*)(ws + OFF_GB);
    bf16_t* M1g = (bf16_t*)(ws + OFF_M1); bf16_t* M2g = (bf16_t*)(ws + OFF_M2); bf16_t* O0g = (bf16_t*)(ws + OFF_O0T); bf16_t* S0Tg = (bf16_t*)(ws + OFF_S0T);
    const int half = wave >> 2, wl = wave & 3, G = gridDim.x, bid = blockIdx.x;
    int cur_h = -1;
    GdnRaw2 cur, nxt;
    { const int v0 = bid + half * G; if (v0 < 4608) gdn_load2(cur, v0, DQKV, GB, tid_in & 255, tid_in & 63, wl); }
    for (int it = 0; bid + 2 * it * G < 4608; ++it) {
        int tid = tid_in; asm volatile("" : "+v"(tid)); const int lane = tid & 63, t2 = tid & 255;
        LAS uchar* L = L_in + half * G2_HALF; asm volatile("" : "+v"(L));
        LAS float* gam = (LAS float*)(L + G2_GAM); LAS float* bet = (LAS float*)(L + G2_BET);
        const int v = bid + (2 * it + half) * G; const bool act = v < 4608;
        int h = 0, dir = 0, b = 0, cidx = 0; if (act) gdn_decode(v, h, dir, b, cidx);
        const size_t slot = (size_t)((dir * 16 + b) * 4 + h) * 36 + cidx;
        if (act && h != cur_h) { cur_h = h;
            for (int i = t2; i < 576; i += 256) { const int wj = i >> 6, d = i & 63; ((LAS float*)(L + G2_CW))[i] = conv_w_l[(wj % 3) * 768 + (wj / 3) * 256 + h * 64 + d]; } }
        { const int vn = v + 2 * G; if (vn < 4608) gdn_load2(nxt, vn, DQKV, GB, t2, lane, wl); else nxt = cur; }
        if (act && wl == 0) { float s = cur.g;
#pragma unroll
            for (int o = 1; o < 64; o <<= 1) { const float t = __shfl_up(s, o); if (lane >= o) s += t; }
            gam[lane] = s; bet[lane] = cur.be; }
        __syncthreads();
        if (act) {
            const int i = t2 >> 2, part = t2 & 3;
            const float gi = gam[i], bi = bet[i], g63 = gam[63];
            const float eg = __expf(gi), ek = __expf(g63 - gi);
#pragma unroll
            for (int which = 0; which < 3; ++which) {
                float y[16]; float ss = 0.f;
#pragma unroll
                for (int p2 = 0; p2 < 2; ++p2) {
#pragma unroll
                    for (int e = 0; e < 8; ++e) y[p2 * 8 + e] = 0.f;
#pragma unroll
                    for (int j = 0; j < 3; ++j) { const u32x4 raw = cur.raw[p2][which][j]; const LAS float* wp = (const LAS float*)(L + G2_CW) + (which * 3 + j) * 64 + part * 16 + p2 * 8; const f32x4 w0 = *(const LAS f32x4*)wp, w1 = *(const LAS f32x4*)(wp + 4);
                        y[p2 * 8 + 0] += w0[0] * bflo(raw.x); y[p2 * 8 + 1] += w0[1] * bfhi(raw.x); y[p2 * 8 + 2] += w0[2] * bflo(raw.y); y[p2 * 8 + 3] += w0[3] * bfhi(raw.y);
                        y[p2 * 8 + 4] += w1[0] * bflo(raw.z); y[p2 * 8 + 5] += w1[1] * bfhi(raw.z); y[p2 * 8 + 6] += w1[2] * bflo(raw.w); y[p2 * 8 + 7] += w1[3] * bfhi(raw.w); }
                }
#pragma unroll
                for (int e = 0; e < 16; ++e) { y[e] = silu_f(y[e]); ss += y[e] * y[e]; }
                if (which < 2) { ss += sxor<1>(ss); ss += sxor<2>(ss); const float rn = rsqrtf(ss + 1e-6f) * (which == 0 ? 0.125f : 1.f);
#pragma unroll
                    for (int e = 0; e < 16; ++e) y[e] *= rn;
#pragma unroll
                    for (int p2 = 0; p2 < 2; ++p2) { u32x4 o; o.x = pk(y[p2 * 8], y[p2 * 8 + 1]); o.y = pk(y[p2 * 8 + 2], y[p2 * 8 + 3]); o.z = pk(y[p2 * 8 + 4], y[p2 * 8 + 5]); o.w = pk(y[p2 * 8 + 6], y[p2 * 8 + 7]);
                        *(LAS u32x4*)(L + (which == 0 ? G2_QH : G2_KH) + i * 144 + part * 32 + p2 * 16) = o; } }
                if (which == 1) {
#pragma unroll
                    for (int e = 0; e < 16; ++e) { const int d = part * 16 + e; *(LAS bf16_t*)(L + G2_KBT + d * 144 + i * 2) = f2bf(bi * eg * y[e]); *(LAS bf16_t*)(L + G2_KTT + d * 144 + i * 2) = f2bf(ek * y[e]); } }
                if (which == 2) {
#pragma unroll
                    for (int e = 0; e < 16; ++e) { const int d = part * 16 + e; *(LAS bf16_t*)(L + G2_VT + d * 144 + i * 2) = f2bf(bi * y[e]); } }
            }
        }
        __syncthreads();
        if (act) {
            const int ti = wl;
            const Frag2 kx = ldfrag(L + G2_KH, ti * 16, lane), qx = ldfrag(L + G2_QH, ti * 16, lane);
            Frag2 ky[4];
#pragma unroll
            for (int tj = 0; tj < 4; ++tj) ky[tj] = ldfrag(L + G2_KH, tj * 16, lane);
#pragma unroll
            for (int tj = 0; tj < 4; ++tj) {
                const f32x4 kk = mmf(kx, ky[tj]);
                const f32x4 qk = mmf(qx, ky[tj]);
                const int j = tj * 16 + (lane & 15); const float gj = gam[j];
#pragma unroll
                for (int idx = 0; idx < 4; ++idx) { const int i = ti * 16 + 4 * (lane >> 4) + idx; const float gi = gam[i], bi = bet[i]; const float dec = __expf(fminf(gi - gj, 0.f));
                    *(LAS bf16_t*)(L + G2_AB + i * 144 + j * 2) = f2bf((i > j) ? bi * kk[idx] * dec : 0.f);
                    *(LAS bf16_t*)(L + G2_QKM + i * 144 + j * 2) = f2bf((i >= j) ? qk[idx] * dec : 0.f); } }
        }
        __syncthreads();
        if (act && wl == half) {
            float t[32]; int c = lane & 31; const int hf = lane >> 5, r0 = 32 * hf; asm volatile("" : "+v"(c));
            const LAS uchar* ABp = L + G2_AB + r0 * 144 + r0 * 2;
            const unsigned oh = 1u << c;
            u32x4 buf[2][8];
#define SUB_LOAD(G_, B_) { const LAS uchar* pg_ = ABp; asm volatile("" : "+v"(pg_) : "v"(tdep)); _Pragma("unroll") for (int rr = 0; rr < 2; ++rr) { _Pragma("unroll") for (int j8 = 0; j8 < (2 * (G_) + rr + 7) / 8; ++j8) buf[B_][rr * 4 + j8] = *(const LAS u32x4*)(pg_ + (2 * (G_) + rr) * 144 + j8 * 16); } }
            float tdep = 0.f;
            SUB_LOAD(0, 0) SUB_LOAD(1, 1)
#pragma unroll
            for (int g = 0; g < 16; ++g) {
#pragma unroll
                for (int rr = 0; rr < 2; ++rr) { const int i = 2 * g + rr; float s0 = (float)((oh >> i) & 1u), s1 = 0.f;
#pragma unroll
                    for (int j8 = 0; j8 < (i + 7) / 8; ++j8) { const u32x4 w = buf[g & 1][rr * 4 + j8];
#pragma unroll
                        for (int e = 0; e < 8; ++e) { const int j = 8 * j8 + e;
                            if (j < i) { if (e & 1) s1 -= bfhi(w[e >> 1]) * t[j]; else s0 -= bflo(w[e >> 1]) * t[j]; } } }
                    t[i] = s0 + s1; }
                tdep = t[2 * g + 1];
                if (g + 2 < 16) SUB_LOAD(g + 2, g & 1)
            }
#undef SUB_LOAD
#pragma unroll
            for (int i = 0; i < 32; ++i) *(LAS bf16_t*)(L + G2_KH + (r0 + i) * 144 + (r0 + c) * 2) = f2bf(t[i]);
            if (hf == 0) {
#pragma unroll
                for (int i = 0; i < 32; ++i) *(LAS bf16_t*)(L + G2_KH + i * 144 + (32 + c) * 2) = (bf16_t)0;
#pragma unroll
                for (int j8 = 0; j8 < 4; ++j8) { u32x4 o; o.x = pk(t[8 * j8], t[8 * j8 + 1]); o.y = pk(t[8 * j8 + 2], t[8 * j8 + 3]); o.z = pk(t[8 * j8 + 4], t[8 * j8 + 5]); o.w = pk(t[8 * j8 + 6], t[8 * j8 + 7]);
                    *(LAS u32x4*)(L + G2_WT + c * 144 + j8 * 16) = o; }
            }
        }
        __syncthreads();
        if (act) {
            const int tm = wl >> 1, tc = wl & 1;
            const f32x4 acc = mm16k32(L + G2_AB, 32 + 16 * tm, 0, L + G2_WT, 16 * tc, 0, lane);
            const int cc = 16 * tc + (lane & 15), m0 = 16 * tm + 4 * (lane >> 4);
            u32x2 w; w.x = pk(acc[0], acc[1]); w.y = pk(acc[2], acc[3]);
            *(LAS u32x2*)(L + G2_WT + (32 + cc) * 144 + m0 * 2) = w;
        }
        __syncthreads();
        if (act) {
            const int ti = wl >> 1, tc = wl & 1;
            const f32x4 acc = mm16k32(L + G2_KH, 32 + 16 * ti, 32, L + G2_WT, 32 + 16 * tc, 0, lane);
            const int cc = 16 * tc + (lane & 15), i0 = 32 + 16 * ti + 4 * (lane >> 4);
#pragma unroll
            for (int idx = 0; idx < 4; ++idx) *(LAS bf16_t*)(L + G2_KH + (i0 + idx) * 144 + cc * 2) = f2bf(-acc[idx]);
        }
        __syncthreads();
        if (act) {
            const int ti = wl;
            const Frag2 tfr = ldfrag(L + G2_KH, ti * 16, lane);
            Frag2 yv[8];
#pragma unroll
            for (int tt = 0; tt < 8; ++tt) yv[tt] = ldfrag(L + ((tt >> 2) ? G2_KBT : G2_VT), (tt & 3) * 16, lane);
#pragma unroll
            for (int tt = 0; tt < 8; ++tt) { const int mat = tt >> 2, te = tt & 3;
                const f32x4 acc = mmf(tfr, yv[tt]);
                const int y = te * 16 + (lane & 15), i0 = ti * 16 + 4 * (lane >> 4);
                u32x2 w; w.x = pk(acc[0], acc[1]); w.y = pk(acc[2], acc[3]);
                *(LAS u32x2*)(L + (mat ? G2_WT : G2_AB) + y * 144 + i0 * 2) = w; }
        }
        __syncthreads();
        if (act) {
            const int mi = wl;
            const LAS uchar* X = L + (mi == 1 ? G2_AB : (mi == 3 ? G2_KTT : G2_WT));
            const LAS uchar* Y = L + ((mi == 0 || mi == 1) ? G2_QKM : (mi == 2 ? G2_KTT : G2_AB));
            const float a63 = __expf(gam[63]);
            Frag2 xf[4], yf[4];
#pragma unroll
            for (int a = 0; a < 4; ++a) { xf[a] = ldfrag(X, a * 16, lane); yf[a] = ldfrag(Y, a * 16, lane); }
#pragma unroll
            for (int tt = 0; tt < 16; ++tt) { const int tx = tt >> 2, ty = tt & 3;
                const f32x4 acc = mmf(xf[tx], yf[ty]);
                const int y = ty * 16 + (lane & 15), x0 = tx * 16 + 4 * (lane >> 4);
                if (mi == 0) {
                    const u32x2 qq = *(const LAS u32x2*)(L + G2_QH + y * 144 + x0 * 2); const float eg = __expf(gam[y]);
                    u32x2 w; w.x = pk(bflo(qq.x) * eg - acc[0], bfhi(qq.x) * eg - acc[1]); w.y = pk(bflo(qq.y) * eg - acc[2], bfhi(qq.y) * eg - acc[3]);
                    const int ir = dir ? 63 - y : y; *(u32x2*)(M1g + slot * 4096 + ir * 64 + x0) = w;
                } else if (mi == 1) {
                    u32x2 w; w.x = pk(acc[0], acc[1]); w.y = pk(acc[2], acc[3]);
                    const int ir = dir ? 63 - y : y; *(u32x2*)(O0g + slot * 4096 + ir * 64 + x0) = w;
                } else if (mi == 2) {
                    u32x2 w; w.x = pk((y == x0 ? a63 : 0.f) - acc[0], (y == x0 + 1 ? a63 : 0.f) - acc[1]); w.y = pk((y == x0 + 2 ? a63 : 0.f) - acc[2], (y == x0 + 3 ? a63 : 0.f) - acc[3]);
                    *(u32x2*)(M2g + slot * 4096 + y * 64 + x0) = w;
                } else {
                    u32x2 w; w.x = pk(acc[0], acc[1]); w.y = pk(acc[2], acc[3]); *(u32x2*)(S0Tg + slot * 4096 + y * 64 + x0) = w;
                }
            }
        }
        __syncthreads();
        cur = nxt;
    }
}

struct ScanIn { u32x2 m[16]; u32x2 c[4]; };
__device__ __forceinline__ void scan_load(ScanIn& in, const bf16_t* M2g, const bf16_t* S0Tg, size_t so, int e, int r, int q) {
#pragma unroll
    for (int t = 0; t < 4; ++t) { in.c[t] = *(const u32x2*)(S0Tg + so + e * 64 + 16 * t + 4 * q);
        const bf16_t* mrow = M2g + so + (16 * t + r) * 64 + 4 * q;
        in.m[4 * t + 0] = *(const u32x2*)(mrow); in.m[4 * t + 1] = *(const u32x2*)(mrow + 16); in.m[4 * t + 2] = *(const u32x2*)(mrow + 32); in.m[4 * t + 3] = *(const u32x2*)(mrow + 48); }
}
__device__ __forceinline__ void phase_scan(uchar* ws, int lane, int wave) {
    const int first = gridDim.x >> 1, nsb = gridDim.x - first;
    if ((int)blockIdx.x < first || wave >= 4) return;
    const bf16_t* M2g = (const bf16_t*)(ws + OFF_M2); const bf16_t* S0Tg = (const bf16_t*)(ws + OFF_S0T); bf16_t* STg = (bf16_t*)(ws + OFF_ST);
    const int r = lane & 15, q = lane >> 4;
    for (int item = ((int)blockIdx.x - first) * 4 + wave; item < 512; item += nsb * 4) {
        const int chain = item >> 2, e = (item & 3) * 16 + r;
        f32x4 S[4];
#pragma unroll
        for (int t = 0; t < 4; ++t) S[t] = (f32x4){0.f, 0.f, 0.f, 0.f};
        ScanIn in0, in1, in2;
        const size_t cb0 = (size_t)chain * 36 * 4096;
        scan_load(in0, M2g, S0Tg, cb0, e, r, q); scan_load(in1, M2g, S0Tg, cb0 + 4096, e, r, q); scan_load(in2, M2g, S0Tg, cb0 + 2 * 4096, e, r, q);
#define SCAN_STEP(IN, n_) do { const size_t so = cb0 + (size_t)(n_) * 4096; \
            u32x4 y0, y1; \
            y0.x = pk(S[0][0], S[0][1]); y0.y = pk(S[0][2], S[0][3]); y0.z = pk(S[1][0], S[1][1]); y0.w = pk(S[1][2], S[1][3]); \
            y1.x = pk(S[2][0], S[2][1]); y1.y = pk(S[2][2], S[2][3]); y1.z = pk(S[3][0], S[3][1]); y1.w = pk(S[3][2], S[3][3]); \
            *(u32x2*)(STg + so + e * 64 + 4 * q) = (u32x2){y0.x, y0.y}; *(u32x2*)(STg + so + e * 64 + 16 + 4 * q) = (u32x2){y0.z, y0.w}; \
            *(u32x2*)(STg + so + e * 64 + 32 + 4 * q) = (u32x2){y1.x, y1.y}; *(u32x2*)(STg + so + e * 64 + 48 + 4 * q) = (u32x2){y1.z, y1.w}; \
            const bf16x8 yb0 = __builtin_bit_cast(bf16x8, y0), yb1 = __builtin_bit_cast(bf16x8, y1); \
            _Pragma("unroll") for (int t = 0; t < 4; ++t) { const u32x2 c = IN.c[t]; f32x4 C = {bflo(c.x), bfhi(c.x), bflo(c.y), bfhi(c.y)}; \
                const bf16x8 x0 = __builtin_bit_cast(bf16x8, (u32x4){IN.m[4 * t].x, IN.m[4 * t].y, IN.m[4 * t + 1].x, IN.m[4 * t + 1].y}); \
                const bf16x8 x1 = __builtin_bit_cast(bf16x8, (u32x4){IN.m[4 * t + 2].x, IN.m[4 * t + 2].y, IN.m[4 * t + 3].x, IN.m[4 * t + 3].y}); \
                C = mfma16(x0, yb0, C); C = mfma16(x1, yb1, C); S[t] = C; } \
            if ((n_) + 3 < 36) scan_load(IN, M2g, S0Tg, so + 3 * 4096, e, r, q); } while (0)
        for (int n = 0; n < 36; n += 3) { SCAN_STEP(in0, n); SCAN_STEP(in1, n + 1); SCAN_STEP(in2, n + 2); }
#undef SCAN_STEP
    }
}

__device__ __forceinline__ void phase_gdn_out(uchar* ws, const float* ong, bool need_ctx, int lane, int wave) {
    const bf16_t* M1g = (const bf16_t*)(ws + OFF_M1); const bf16_t* O0g = (const bf16_t*)(ws + OFF_O0T); const bf16_t* STg = (const bf16_t*)(ws + OFF_ST);
    const bf16_t* DZ = (const bf16_t*)(ws + OFF_DZ); bf16_t* CAT = (bf16_t*)(ws + OFF_CAT);
    const int r = lane & 15, q = lane >> 4, ti = wave & 3;
    for (int unit = blockIdx.x * 2 + (wave >> 2); unit < 2304; unit += gridDim.x * 2) {
        const int b = unit / 144, rem = unit % 144, h = rem / 36, cpos = rem % 36;
        const bool isctx = cpos < 4; if (isctx && !need_ctx) continue;
        const int cb = isctx ? 3 - cpos : 39 - cpos;
        const size_t sof = ((size_t)((0 * 16 + b) * 4 + h) * 36 + cpos) * 4096, sob = ((size_t)((16 + b) * 4 + h) * 36 + cb) * 4096;
        const int i = 16 * ti + r;
        f32x4 acc[4];
#pragma unroll
        for (int te = 0; te < 4; ++te) { const int e0 = te * 16 + 4 * q;
            const u32x2 cf = *(const u32x2*)(O0g + sof + i * 64 + e0), cbk = *(const u32x2*)(O0g + sob + i * 64 + e0);
            acc[te] = (f32x4){bflo(cf.x) + bflo(cbk.x), bfhi(cf.x) + bfhi(cbk.x), bflo(cf.y) + bflo(cbk.y), bfhi(cf.y) + bfhi(cbk.y)}; }
#pragma unroll
        for (int dn = 0; dn < 2; ++dn) { const size_t so = dn ? sob : sof;
#pragma unroll
            for (int ks = 0; ks < 2; ++ks) { const bf16x8 y = *(const bf16x8*)(M1g + so + i * 64 + 32 * ks + 8 * q);
#pragma unroll
                for (int te = 0; te < 4; ++te) { const bf16x8 x = *(const bf16x8*)(STg + so + (te * 16 + r) * 64 + 32 * ks + 8 * q); acc[te] = mfma16(x, y, acc[te]); } } }
        float ss = 0.f;
#pragma unroll
        for (int te = 0; te < 4; ++te) ss += (acc[te][0] * acc[te][0] + acc[te][1] * acc[te][1]) + (acc[te][2] * acc[te][2] + acc[te][3] * acc[te][3]);
        ss += sxor<16>(ss); ss = sum32(ss);
        const float rinv = rsqrtf(ss * (1.f / 64.f) + 1e-6f);
        const size_t tok = (isctx ? (size_t)TL + b * 256 + cpos * 64 : (size_t)b * 2048 + (cpos - 4) * 64) + i;
#pragma unroll
        for (int te = 0; te < 4; ++te) { const int e0 = te * 16 + 4 * q;
            const u32x2 dz = *(const u32x2*)(DZ + tok * 256 + h * 64 + e0); const f32x4 og = *(const f32x4*)(ong + e0);
            u32x2 w; w.x = pk(acc[te][0] * rinv * og[0] * silu_f(bflo(dz.x)), acc[te][1] * rinv * og[1] * silu_f(bfhi(dz.x)));
            w.y = pk(acc[te][2] * rinv * og[2] * silu_f(bflo(dz.y)), acc[te][3] * rinv * og[3] * silu_f(bfhi(dz.y)));
            *(u32x2*)(CAT + tok * 1024 + 768 + h * 64 + e0) = w; }
    }
}

constexpr int AL_K = 0, AL_V = 18432;
__device__ __forceinline__ void attn_unit(LAS uchar* L, const bf16_t* Qb, const bf16_t* Kb, const bf16_t* VTl, const bf16_t* VTc, bf16_t* CAT,
                                          int b, int head, size_t qrow0, bool lat, int tid, int lane, int wave) {
    const int kvh = head >> 2, ntile = lat ? 36 : 4;
    const int r32 = lane & 31, hi = lane >> 5;
    const size_t qrow = qrow0 + wave * 32 + r32;
    bf16x8 qf[4];
#pragma unroll
    for (int ks = 0; ks < 4; ++ks) qf[ks] = *(const bf16x8*)(Qb + qrow * 512 + head * 64 + 16 * ks + 8 * hi);
    f32x16 o0, o1;
#pragma unroll
    for (int i = 0; i < 16; ++i) { o0[i] = 0.f; o1[i] = 0.f; }
    float mrun = -INFINITY, lsum = 0.f;
    const int lrow = tid >> 3, lch = tid & 7;
    const float LOG2E = 1.4426950408889634f;
    const bf16_t* kl = Kb + ((size_t)b * 2048 + lrow) * 128 + kvh * 64 + 8 * lch;
    const bf16_t* kc = Kb + ((size_t)TL + b * 256 + lrow) * 128 + kvh * 64 + 8 * lch;
    const bf16_t* vl = VTl + ((size_t)(b * 2 + kvh) * 64 + lrow) * 2048 + 8 * lch;
    const bf16_t* vc = VTc + ((size_t)(b * 2 + kvh) * 64 + lrow) * 256 + 8 * lch;
    u32x4 kreg, vreg;
#define ATT_LOAD(t) do { const int t_ = (t); if (lat && t_ < 32) { kreg = *(const u32x4*)(kl + (size_t)t_ * 64 * 128); vreg = *(const u32x4*)(vl + t_ * 64); } \
        else { const int tc_ = lat ? t_ - 32 : t_; kreg = *(const u32x4*)(kc + (size_t)tc_ * 64 * 128); vreg = *(const u32x4*)(vc + tc_ * 64); } } while (0)
#define ATT_STORE(buf) do { *(LAS u32x4*)(L + AL_K + (buf) * 9216 + lrow * 144 + lch * 16) = kreg; *(LAS u32x2*)(L + AL_V + (buf) * 9216 + lrow * 136 + lch * 16) = (u32x2){vreg.x, vreg.y}; *(LAS u32x2*)(L + AL_V + (buf) * 9216 + lrow * 136 + lch * 16 + 8) = (u32x2){vreg.z, vreg.w}; } while (0)
    __syncthreads();
    ATT_LOAD(0); ATT_STORE(0);
    __syncthreads();
    for (int t = 0; t < ntile; ++t) {
        const int buf = t & 1;
        if (t + 1 < ntile) ATT_LOAD(t + 1);
        const LAS uchar* Kt = L + AL_K + buf * 9216; const LAS uchar* Vt = L + AL_V + buf * 9216;
        f32x16 s0, s1;
#pragma unroll
        for (int i = 0; i < 16; ++i) { s0[i] = 0.f; s1[i] = 0.f; }
#pragma unroll
        for (int ks = 0; ks < 4; ++ks) {
            const bf16x8 k0 = *(const LAS bf16x8*)(Kt + r32 * 144 + ks * 32 + hi * 16);
            const bf16x8 k1 = *(const LAS bf16x8*)(Kt + (32 + r32) * 144 + ks * 32 + hi * 16);
            s0 = mfma32(k0, qf[ks], s0); s1 = mfma32(k1, qf[ks], s1);
        }
        float mx = s0[0];
#pragma unroll
        for (int i = 1; i < 16; ++i) mx = fmaxf(mx, s0[i]);
#pragma unroll
        for (int i = 0; i < 16; ++i) mx = fmaxf(mx, s1[i]);
        mx = max32(mx);
        const float mnew = fmaxf(mrun, mx * LOG2E);
        const float alpha = __builtin_amdgcn_exp2f(mrun - mnew);
        mrun = mnew;
        float ps = 0.f;
#pragma unroll
        for (int i = 0; i < 16; ++i) { s0[i] = __builtin_amdgcn_exp2f(s0[i] * LOG2E - mnew); s1[i] = __builtin_amdgcn_exp2f(s1[i] * LOG2E - mnew); ps += s0[i] + s1[i]; }
        lsum = lsum * alpha + ps;
        if (__any(alpha != 1.f)) {
#pragma unroll
            for (int i = 0; i < 16; ++i) { o0[i] *= alpha; o1[i] *= alpha; } }
#pragma unroll
        for (int kk = 0; kk < 2; ++kk)
#pragma unroll
            for (int kst = 0; kst < 2; ++kst) {
                u32x4 pw;
                if (kk == 0) { pw.x = pk(s0[8 * kst + 0], s0[8 * kst + 1]); pw.y = pk(s0[8 * kst + 2], s0[8 * kst + 3]); pw.z = pk(s0[8 * kst + 4], s0[8 * kst + 5]); pw.w = pk(s0[8 * kst + 6], s0[8 * kst + 7]); }
                else         { pw.x = pk(s1[8 * kst + 0], s1[8 * kst + 1]); pw.y = pk(s1[8 * kst + 2], s1[8 * kst + 3]); pw.z = pk(s1[8 * kst + 4], s1[8 * kst + 5]); pw.w = pk(s1[8 * kst + 6], s1[8 * kst + 7]); }
                const bf16x8 pf = __builtin_bit_cast(bf16x8, pw);
                const int kof = (32 * kk + 16 * kst + 4 * hi) * 2;
                const u32x2 a0 = *(const LAS u32x2*)(Vt + r32 * 136 + kof), a1 = *(const LAS u32x2*)(Vt + r32 * 136 + kof + 16);
                const u32x2 c0 = *(const LAS u32x2*)(Vt + (32 + r32) * 136 + kof), c1 = *(const LAS u32x2*)(Vt + (32 + r32) * 136 + kof + 16);
                o0 = mfma32(__builtin_bit_cast(bf16x8, (u32x4){a0.x, a0.y, a1.x, a1.y}), pf, o0);
                o1 = mfma32(__builtin_bit_cast(bf16x8, (u32x4){c0.x, c0.y, c1.x, c1.y}), pf, o1);
            }
        if (t + 1 < ntile) ATT_STORE(buf ^ 1);
        __syncthreads();
    }
#undef ATT_LOAD
#undef ATT_STORE
    lsum = sum32(lsum);
    const float inv = __builtin_amdgcn_rcpf(lsum);
    bf16_t* dst = CAT + qrow * 1024 + 256 + head * 64 + 4 * hi;
#pragma unroll
    for (int g = 0; g < 4; ++g) {
        u32x2 w0, w1; w0.x = pk(o0[4 * g] * inv, o0[4 * g + 1] * inv); w0.y = pk(o0[4 * g + 2] * inv, o0[4 * g + 3] * inv);
        w1.x = pk(o1[4 * g] * inv, o1[4 * g + 1] * inv); w1.y = pk(o1[4 * g + 2] * inv, o1[4 * g + 3] * inv);
        *(u32x2*)(dst + 8 * g) = w0; *(u32x2*)(dst + 32 + 8 * g) = w1;
    }
}

__device__ __forceinline__ void phase_attn(uchar* ws, unsigned* counter, bool need_ctx, LAS uchar* L, int tid, int lane, int wave) {
    const bf16_t* Qb = (const bf16_t*)(ws + OFF_Q); const bf16_t* Kb = (const bf16_t*)(ws + OFF_K);
    const bf16_t* VTl = (const bf16_t*)(ws + OFF_VTL); const bf16_t* VTc = (const bf16_t*)(ws + OFF_VTC); bf16_t* CAT = (bf16_t*)(ws + OFF_CAT);
    const int nunits = 1024 + (need_ctx ? 128 : 0);
    volatile LAS int* ubox = (volatile LAS int*)(L + LDS_MISC + 1040);
    for (;;) {
        __syncthreads();
        if (tid == 0) *ubox = (int)atomicAdd(counter, 1u);
        __syncthreads();
        const int u = *ubox;
        if (u >= nunits) break;
        if (u < 1024) { const int b = u >> 6, head = (u >> 3) & 7, qb = u & 7; attn_unit(L, Qb, Kb, VTl, VTc, CAT, b, head, (size_t)b * 2048 + qb * 256, true, tid, lane, wave); }
        else { const int v = u - 1024, b = v >> 3, head = v & 7; attn_unit(L, Qb, Kb, VTl, VTc, CAT, b, head, (size_t)TL + b * 256, false, tid, lane, wave); }
    }
}

#define GAS __attribute__((address_space(1)))
typedef GAS unsigned gu32;
typedef GAS unsigned long long gu64;
#define RLX_AGENT __ATOMIC_RELAXED, __HIP_MEMORY_SCOPE_AGENT
#define LDS_WAIT() asm volatile("s_waitcnt lgkmcnt(0)" ::: "memory")
#define VM_WAIT() asm volatile("s_waitcnt vmcnt(0)" ::: "memory")
__device__ __forceinline__ unsigned long long rt() { return __builtin_amdgcn_s_memrealtime(); }
#define XB_TMO      128
#define XB_XCNT(j)  (256  + 64 * (j))
#define XB_XSUB(j)  (1280 + 64 * (j))
#define XB_XGEN(j)  (2304 + 64 * (j))
#define XB_TOP      3328
#define XB_TOPGEN   3392
#define XCD_BAR_WORDS 3456
#define XB_SPIN_CAP (1u << 18)

__device__ __forceinline__ unsigned xb_ld(unsigned* p)              { return __hip_atomic_load(p, __ATOMIC_RELAXED, __HIP_MEMORY_SCOPE_AGENT); }
__device__ __forceinline__ unsigned xb_add(unsigned* p, unsigned v) { return __hip_atomic_fetch_add(p, v, __ATOMIC_RELAXED, __HIP_MEMORY_SCOPE_AGENT); }
__device__ __forceinline__ unsigned xb_xcc_id() { return (unsigned)__builtin_amdgcn_s_getreg((3 << 11) | 20) & 0xFu; }
#define XB_SPIN(cond, bar) do { unsigned _sp = 0; while (cond) { __builtin_amdgcn_s_sleep(1); \
    if ((++_sp & 255u) == 0u) { if (xb_ld(&(bar)[XB_TMO])) break; if (_sp > XB_SPIN_CAP) { atomicAdd(&(bar)[XB_TMO], 1u); break; } } } } while (0)

struct XcdBarrier {
    unsigned* bar; unsigned x;
    volatile LAS unsigned* st;
};

__device__ __forceinline__ XcdBarrier xcd_barrier_post(unsigned* bar, volatile LAS unsigned* st, bool leader) {
    XcdBarrier b; b.bar = bar; b.x = xb_xcc_id(); b.st = st;
    if (leader) (void)xb_add(&bar[XB_XCNT(b.x)], 1u);
    return b;
}
__device__ __forceinline__ void xcd_barrier_complete(unsigned* bar, unsigned x, unsigned& nloc, unsigned& nx) {
    const unsigned G = gridDim.x * gridDim.y * gridDim.z;
    unsigned sum, cnt, mine, sp = 0u;
    for (;;) {
        sum = 0u; cnt = 0u; mine = 0u;
#pragma unroll
        for (unsigned j = 0; j < 16; ++j) { const unsigned c = xb_ld(&bar[XB_XCNT(j)]); sum += c; cnt += (c > 0u) ? 1u : 0u; mine = (j == x) ? c : mine; }
        if (sum == G) break;
        __builtin_amdgcn_s_sleep(1);
        if ((++sp & 255u) == 0u) { if (xb_ld(&bar[XB_TMO])) break; if (sp > XB_SPIN_CAP) { atomicAdd(&bar[XB_TMO], 1u); break; } }
    }
    nloc = mine > 0u ? mine : 1u; nx = cnt > 0u ? cnt : 1u;
}

__device__ __forceinline__ void xcd_barrier(const XcdBarrier& b, bool leader) {
    asm volatile("s_waitcnt vmcnt(0)" ::: "memory");
    __syncthreads();
    if (leader) {
        unsigned* bar = b.bar;
        __builtin_amdgcn_s_waitcnt(0);
        unsigned nloc = b.st[0], nx = b.st[1];
        if (nloc == 0u) { xcd_barrier_complete(bar, b.x, nloc, nx); b.st[0] = nloc; b.st[1] = nx; }
        const unsigned old = xb_add(&bar[XB_XSUB(b.x)], 1u);
        const unsigned gen = old / nloc;
        if (old + 1u == (gen + 1u) * nloc) {
            __builtin_amdgcn_fence(__ATOMIC_RELEASE, "agent");
            asm volatile("s_waitcnt vmcnt(0)" ::: "memory");
            const unsigned og = xb_add(&bar[XB_TOP], 1u);
            const unsigned tg = og / nx;
            if (og + 1u == (tg + 1u) * nx) xb_add(&bar[XB_TOPGEN], 1u);
            else XB_SPIN(xb_ld(&bar[XB_TOPGEN]) == tg, bar);
            __builtin_amdgcn_fence(__ATOMIC_ACQUIRE, "agent");
            xb_add(&bar[XB_XGEN(b.x)], 1u);
            asm volatile("s_waitcnt vmcnt(0)" ::: "memory");
        } else {
            XB_SPIN(xb_ld(&bar[XB_XGEN(b.x)]) == gen, bar);
            __builtin_amdgcn_fence(__ATOMIC_ACQUIRE, "agent");
            asm volatile("s_waitcnt vmcnt(0)" ::: "memory");
        }
    }
    __syncthreads();
}

#ifndef REP_PRE
#define REP_PRE 1
#endif
#ifndef REP_SCAN
#define REP_SCAN 1
#endif
#ifndef REP_ATTN
#define REP_ATTN 1
#endif
#ifndef REP_OUT
#define REP_OUT 1
#endif
#ifndef REP_NORM
#define REP_NORM 1
#endif
#ifndef REP_PRO
#define REP_PRO 1
#endif
#ifndef REP_G1
#define REP_G1 1
#endif
#ifndef REP_FOUR
#define REP_FOUR 1
#endif
#ifndef REP_F1
#define REP_F1 1
#endif
#ifndef REP_SYNC
#define REP_SYNC 1
#endif
typedef const __attribute__((address_space(4))) Params CParams;
#define PH_BEGIN { CParams* kp = (CParams*)__builtin_amdgcn_kernarg_segment_ptr(); int w0_ = wave0; unsigned on_ = ~0u; asm volatile("" : "+s"(w0_), "+s"(on_)); int tid = w0_ * 64 + (int)__builtin_amdgcn_mbcnt_hi(on_, __builtin_amdgcn_mbcnt_lo(on_, 0u)); LAS uchar* Lv = L; asm volatile("" : "+s"(kp), "+v"(tid), "+v"(Lv)); (void)Lv; \
    uchar* ws = kp->ws; const int lane = tid & 63, wave = __builtin_amdgcn_readfirstlane(tid >> 6); const int G = gridDim.x, bid = blockIdx.x; \
    const float* mod = (const float*)(ws + OFF_MOD); float* XC = (float*)(ws + OFF_XC); bf16_t* H = (bf16_t*)(ws + OFF_H); bf16_t* CAT = (bf16_t*)(ws + OFF_CAT); bf16_t* U = (bf16_t*)(ws + OFF_U); \
    const float* modl = mod + (size_t)l * 17 * 6144; uchar* wb = ws + OFF_WB + (size_t)l * WB_LAYER; float* OUT = kp->out; \
    (void)lane; (void)wave; (void)XC; (void)H; (void)CAT; (void)U; (void)modl; (void)wb; (void)G; (void)bid; (void)OUT;
#define PH_END }
#define GSYNC() do { CParams* kq_ = (CParams*)__builtin_amdgcn_kernarg_segment_ptr(); asm volatile("" : "+s"(kq_)); XcdBarrier xb_; xb_.bar = (unsigned*)(kq_->ws + 8192); xb_.x = xb_xcc_id(); \
    xb_.st = (volatile LAS unsigned*)(L + LDS_MISC + 1024); unsigned on2_ = ~0u; asm volatile("" : "+s"(on2_)); const bool ld_ = (wave0 == 0) && (__builtin_amdgcn_mbcnt_hi(on2_, __builtin_amdgcn_mbcnt_lo(on2_, 0u)) == 0u); for (int rs_ = 0; rs_ < REP_SYNC; ++rs_) xcd_barrier(xb_, ld_); } while (0)
#define IN(k) (kp->in[k])

__global__ void __launch_bounds__(512) mega(Params p) {
    extern __shared__ __attribute__((aligned(16))) unsigned char lds[];
    cg::grid_group grid = cg::this_grid();
    LAS uchar* L = (LAS uchar*)lds;
    const int wave0 = __builtin_amdgcn_readfirstlane(threadIdx.x >> 6);
    if (blockIdx.x == 0) { unsigned* bw = (unsigned*)(p.ws + 8192); for (int i = threadIdx.x; i < XCD_BAR_WORDS; i += 512) bw[i] = 0u; if (threadIdx.x < 128) ((unsigned*)(p.ws + 8192 + 16384))[threadIdx.x] = 0u; }
    if (threadIdx.x < 2) ((volatile LAS unsigned*)(L + LDS_MISC + 1024))[threadIdx.x] = 0u;
    if (blockIdx.x == 0) __threadfence();
    grid.sync();
    (void)xcd_barrier_post((unsigned*)(p.ws + 8192), (volatile LAS unsigned*)(L + LDS_MISC + 1024), threadIdx.x == 0);
    { const int l = 0;
    for (int rep_ = 0; rep_ < REP_PRO; ++rep_) { PH_BEGIN phase_prologue(kp, Lv, tid, lane, wave); PH_END __syncthreads(); }
    GSYNC();
    PH_BEGIN phase_norm<true, false>(IN(0), IN(2), TT, IN(4), mod, 0, 1, H, IN(8), IN(12), IN(13), (float*)(ws + OFF_GB), Lv, tid, lane, wave); PH_END
    GSYNC();
    }
#pragma unroll
    for (int l = 0; l < 2; ++l) {
        const bool last = (l == 1);
        const int Mrows = last ? TL : TT;
        PH_BEGIN {
            pg8::Gemm g{H, (const bf16_t*)(wb + WB_W1), TT, 2304, 1024, 1024};
            EpiProj E{ws, IN(10) + l * 64, IN(11) + l * 64};
            if (!last) { pg8::StaticOrder S; S.init(TT, 2304, G, bid); pg8::gemm_phase<EpiProj, pg8::StaticOrder, true, true>(L, g, S, E, tid); }
            else { OrderL1 S; S.init(G, bid); pg8::gemm_phase<EpiProj, OrderL1, true, true>(L, g, S, E, tid); }
        } PH_END
        GSYNC();
        for (int rep_ = 0; rep_ < REP_PRE; ++rep_) { PH_BEGIN phase_gdn_pre2(ws, IN(9) + (size_t)l * 3 * 768, Lv, tid, wave); PH_END if (rep_ + 1 < REP_PRE) GSYNC(); }
        GSYNC();
        for (int rep_ = 0; rep_ < REP_SCAN; ++rep_) { PH_BEGIN phase_scan(ws, lane, wave); PH_END __syncthreads(); }
        __syncthreads();
        PH_BEGIN {
            pg8::Gemm g{(const bf16_t*)(ws + OFF_DFTL), (const bf16_t*)(ws + OFF_GTL), 2048, 4096, 4096, 4096}; pg8::StaticOrder S; S.init(2048, 4096, G, bid);
            EpiFourier E{CAT, 0, 2048};
            for (int rep_ = 0; rep_ < REP_FOUR; ++rep_) { pg8::gemm_phase<EpiFourier, pg8::StaticOrder, true, true>(L, g, S, E, tid); __syncthreads(); }
        } PH_END
        if (!last) PH_BEGIN {
            __syncthreads();
            pg8::Gemm g{(const bf16_t*)(ws + OFF_DFTC), (const bf16_t*)(ws + OFF_GTC), 256, 4096, 512, 512}; pg8::StaticOrder S; S.init(256, 4096, G, bid);
            EpiFourier E{CAT, TL, 256};
            pg8::gemm_phase<EpiFourier, pg8::StaticOrder, true, true>(L, g, S, E, tid);
        } PH_END
        __syncthreads();
        for (int rep_ = 0; rep_ < REP_ATTN; ++rep_) { PH_BEGIN phase_attn(ws, (unsigned*)(ws + 8192 + 16384) + l * 64, !last, Lv, tid, lane, wave); PH_END __syncthreads(); }
        GSYNC();
        for (int rep_ = 0; rep_ < REP_OUT; ++rep_) { PH_BEGIN phase_gdn_out(ws, IN(14) + l * 64, !last, lane, wave); PH_END __syncthreads(); }
        GSYNC();
        PH_BEGIN {
            const bool split = false;
            pg8::Gemm g{CAT, (const bf16_t*)(wb + WB_WO), split ? TL : Mrows, 1024, 1024, 1024}; pg8::StaticOrder S; S.init(split ? TL : Mrows, 1024, G, bid);
            EpiResid E{last ? (const float*)OUT : IN(0), OUT, last ? (const float*)XC : IN(2), XC, modl + 2 * 1024};
            pg8::gemm_phase<EpiResid, pg8::StaticOrder, true, true>(L, g, S, E, tid);
            if (split) {
                __syncthreads();
                const int kq = bid >> 6;
                pg8::Gemm g2{CAT + (size_t)TL * 1024 + kq * 256, (const bf16_t*)(wb + WB_WO) + kq * 256, TC, 1024, 256, 1024}; pg8::StaticOrder S2; S2.init(TC, 1024, 64, bid & 63);
                EpiSplit E2{kq == 0 ? IN(2) : nullptr, kq == 0 ? XC : (float*)(ws + OFF_PART2) + (size_t)(kq - 1) * TC * 1024, modl + 2 * 1024 + 16 * 6144};
                pg8::gemm_phase<EpiSplit, pg8::StaticOrder, true, true>(L, g2, S2, E2, tid);
            }
        } PH_END
        GSYNC();
        for (int rep_ = 0; rep_ < REP_NORM; ++rep_) { PH_BEGIN if (false) phase_norm<false, true>(OUT, XC, Mrows, IN(5) + l * 1024, modl, 3, 4, H, nullptr, nullptr, nullptr, nullptr, Lv, tid, lane, wave, (const float*)(ws + OFF_PART2), XC); else phase_norm<false, false>(OUT, XC, Mrows, IN(5) + l * 1024, modl, 3, 4, H, nullptr, nullptr, nullptr, nullptr, Lv, tid, lane, wave); PH_END __syncthreads(); }
        GSYNC();
        PH_BEGIN {
            pg8::Gemm g{H, (const bf16_t*)(wb + WB_F1), Mrows, 4096, 1024, 1024}; pg8::StaticOrder S; S.init(Mrows, 4096, G, bid);
            EpiRelu2P E{U};
for (int rep_ = 0; rep_ < REP_F1; ++rep_) { pg8::gemm_phase<EpiRelu2P, pg8::StaticOrder, true, true>(L, g, S, E, tid); __syncthreads(); }
        } PH_END
        GSYNC();
        PH_BEGIN {
            const bool split = false;
            pg8::Gemm g{U, (const bf16_t*)(wb + WB_F2), split ? TL : Mrows, 1024, 4096, 4096}; RevOrder S; S.init(split ? TL : Mrows, 1024, G, bid);
            EpiResid E{OUT, OUT, XC, XC, modl + 5 * 1024};
            pg8::gemm_phase<EpiResid, RevOrder, true, true>(L, g, S, E, tid);
            if (split) {
                __syncthreads();
                const int kq = bid >> 6;
                pg8::Gemm g2{U + (size_t)TL * 4096 + kq * 1024, (const bf16_t*)(wb + WB_F2) + kq * 1024, TC, 1024, 1024, 4096}; pg8::StaticOrder S2; S2.init(TC, 1024, 64, bid & 63);
                EpiSplit E2{kq == 0 ? (const float*)XC : nullptr, kq == 0 ? XC : (float*)(ws + OFF_PARTF) + (size_t)(kq - 1) * TC * 1024, modl + 5 * 1024 + 16 * 6144};
                pg8::gemm_phase<EpiSplit, pg8::StaticOrder, true, true>(L, g2, S2, E2, tid);
            }
        } PH_END
#if NAN_SCRUB
        if (last) {
            GSYNC();
            PH_BEGIN for (size_t i = (size_t)bid * 512 + tid; i < (size_t)TL * 1024; i += (size_t)G * 512) { float v = OUT[i]; if (!(fabsf(v) < 1e30f)) OUT[i] = 0.f; } PH_END
        }
#endif
        if (!last) {
            GSYNC();
            for (int rep_ = 0; rep_ < REP_NORM; ++rep_) { PH_BEGIN if (false) phase_norm<true, true>(OUT, XC, TT, IN(4) + 1024, mod + (size_t)17 * 6144, 0, 1, H, IN(8) + (size_t)1024 * 2064, IN(12) + 8, IN(13) + 8, (float*)(ws + OFF_GB), Lv, tid, lane, wave, (const float*)(ws + OFF_PARTF), nullptr); else phase_norm<true, false>(OUT, XC, TT, IN(4) + 1024, mod + (size_t)17 * 6144, 0, 1, H, IN(8) + (size_t)1024 * 2064, IN(12) + 8, IN(13) + 8, (float*)(ws + OFF_GB), Lv, tid, lane, wave); PH_END __syncthreads(); }
            GSYNC();
        }
    }
}

extern "C" void kernel_launch(void* const* d_in, const int* in_sizes, int n_in, void* d_out, int out_size, void* d_ws, size_t ws_size, hipStream_t stream) {
    static int grid = 0;
    if (!grid) {
        int dev = 0, cus = 0, per_cu = 0;
        (void)hipGetDevice(&dev);
        (void)hipDeviceGetAttribute(&cus, hipDeviceAttributeMultiprocessorCount, dev);
        (void)hipFuncSetAttribute((const void*)mega, hipFuncAttributeMaxDynamicSharedMemorySize, LDS_BYTES);
        (void)hipOccupancyMaxActiveBlocksPerMultiprocessor(&per_cu, (const void*)mega, 512, LDS_BYTES);
        if (per_cu < 1) per_cu = 1;
        grid = cus * per_cu;
        if (ws_size < WS_END) { fprintf(stderr, "kernel_launch: workspace too small: %zu < %zu\n", ws_size, (size_t)WS_END); grid = -1; }
    }
    if (grid < 0) return;
    Params p{};
    for (int i = 0; i < 18; ++i) p.in[i] = (const float*)d_in[i];
    p.out = (float*)d_out; p.ws = (unsigned char*)d_ws;
    void* args[] = {&p};
    hipError_t e = hipLaunchCooperativeKernel((const void*)mega, dim3(grid), dim3(512), args, LDS_BYTES, stream);
    if (e != hipSuccess) fprintf(stderr, "cooperative launch failed: %s (grid %d)\n", hipGetErrorString(e), grid);
}
```
